# Optimizing an MI355X kernel written in HIP

```python
import jax, jax.numpy as jnp
from jax import lax
import numpy as np

D_MODEL = 2048
BATCH = 2
SEQ = 4096
DEPTH = 1

N_META = 16
EPS = 1e-6
D_MIX = D_MODEL
D_CONV = 1024
CONV_GROUPS = 16
CONV_WIDTH = 3
N_HEADS = 8
QK_NOPE = 128
QK_ROPE = 64
V_DIM = 128
Q_LORA = 512
KV_LORA = 256
ROPE_THETA = 10000.0
Q_BLOCK = 128
D_IN = 3 * D_CONV + Q_LORA + KV_LORA + QK_ROPE
N_EXPERTS = 32
TOP_K = 4
D_FF = D_MODEL
SWIGLU_LIMIT = 7.0
SWIGLU_ALPHA = 1.702
MOE_BLOCK = 128

kernel_name = "hymba_shortconv_mla_moe_layer"


def rmsnorm(x, g):
    xf = x.astype(jnp.float32)
    y = xf * lax.rsqrt(jnp.mean(xf * xf, axis=-1, keepdims=True) + EPS)
    return (y * g.astype(jnp.float32)).astype(x.dtype)


def group_rmsnorm(x, g, n_groups):
    shp = x.shape
    xf = x.astype(jnp.float32).reshape(shp[:-1] + (n_groups, shp[-1] // n_groups))
    y = xf * lax.rsqrt(jnp.mean(xf * xf, axis=-1, keepdims=True) + EPS)
    return (y.reshape(shp) * g.astype(jnp.float32)).astype(x.dtype)


def short_conv(b_gate, c_gate, u_in, conv_w):
    u = c_gate * u_in
    L = u.shape[1]
    u_pad = jnp.pad(u, ((0, 0), (CONV_WIDTH - 1, 0), (0, 0)))
    y = conv_w[CONV_WIDTH - 1] * u_pad[:, CONV_WIDTH - 1:CONV_WIDTH - 1 + L]
    for j in range(CONV_WIDTH - 1):
        y = y + conv_w[j] * u_pad[:, j:j + L]
    return b_gate * y


def rope_cos_sin(L):
    half = QK_ROPE // 2
    pos = jnp.arange(L, dtype=jnp.float32)
    inv_freq = ROPE_THETA ** (-jnp.arange(half, dtype=jnp.float32) / half)
    ang = pos[:, None] * inv_freq[None, :]
    return jnp.cos(ang), jnp.sin(ang)


def apply_rope(x, cos, sin):
    half = x.shape[-1] // 2
    xf = x.astype(jnp.float32)
    x1, x2 = xf[..., :half], xf[..., half:]
    out = jnp.concatenate([x1 * cos - x2 * sin, x1 * sin + x2 * cos], axis=-1)
    return out.astype(x.dtype)


def pad_seq(t, n):
    widths = [(0, 0)] * t.ndim
    widths[1] = (0, n)
    return jnp.pad(t, widths)


def mla_attention(q_lat, kv_lat, k_rope, g_q, w_q_up, g_kv, w_kv_up):
    B, L, _ = q_lat.shape
    q = (rmsnorm(q_lat, g_q) @ w_q_up).reshape(B, L, N_HEADS, QK_NOPE + QK_ROPE)
    q_nope, q_pe = q[..., :QK_NOPE], q[..., QK_NOPE:]
    kv = (rmsnorm(kv_lat, g_kv) @ w_kv_up).reshape(B, L, N_HEADS, QK_NOPE + V_DIM)
    k_nope, v = kv[..., :QK_NOPE], kv[..., QK_NOPE:]
    cos, sin = rope_cos_sin(L)
    q_pe = apply_rope(q_pe, cos[:, None, :], sin[:, None, :])
    k_pe = apply_rope(k_rope, cos, sin)

    n_blk = -(-L // Q_BLOCK)
    Lp = n_blk * Q_BLOCK
    extra = Lp - L
    q_nope, q_pe = pad_seq(q_nope, extra), pad_seq(q_pe, extra)
    k_nope, k_pe, v = pad_seq(k_nope, extra), pad_seq(k_pe, extra), pad_seq(v, extra)
    qn_blk = q_nope.reshape(B, n_blk, Q_BLOCK, N_HEADS, QK_NOPE).transpose(1, 0, 2, 3, 4)
    qr_blk = q_pe.reshape(B, n_blk, Q_BLOCK, N_HEADS, QK_ROPE).transpose(1, 0, 2, 3, 4)
    q_pos = jnp.arange(Lp).reshape(n_blk, Q_BLOCK)
    k_pos = jnp.arange(Lp)
    scale = (QK_NOPE + QK_ROPE) ** -0.5

    def one_block(args):
        qn, qr, qp = args
        s = jnp.einsum("bqhd,bkhd->bhqk", qn, k_nope) + jnp.einsum("bqhr,bkr->bhqk", qr, k_pe)
        s = s.astype(jnp.float32) * scale
        causal = k_pos[None, :] <= qp[:, None]
        s = jnp.where(causal[None, None], s, -jnp.inf)
        p = jax.nn.softmax(s, axis=-1).astype(v.dtype)
        return jnp.einsum("bhqk,bkhd->bqhd", p, v)

    o = lax.map(one_block, (qn_blk, qr_blk, q_pos))
    o = o.transpose(1, 0, 2, 3, 4).reshape(B, Lp, N_HEADS * V_DIM)
    return o[:, :L]


def moe_ffn(xn, w_router, b_router, w_gate_up, b_gate_up, w_down, b_down):
    B, L, D = xn.shape
    T = B * L
    xf = xn.reshape(T, D)
    logits = xf.astype(jnp.float32) @ w_router.astype(jnp.float32) + b_router.astype(jnp.float32)
    top_v, top_i = lax.top_k(logits, TOP_K)
    gates = jax.nn.softmax(top_v, axis=-1)

    A = T * TOP_K
    flat_e = top_i.reshape(A)
    flat_tok = jnp.arange(A) // TOP_K
    flat_g = gates.reshape(A)
    order = jnp.argsort(flat_e)
    s_e, s_tok, s_g = flat_e[order], flat_tok[order], flat_g[order]

    counts = jnp.bincount(flat_e, length=N_EXPERTS)
    padded = (counts + MOE_BLOCK - 1) // MOE_BLOCK * MOE_BLOCK
    pad_end = jnp.cumsum(padded)
    pad_start = pad_end - padded
    grp_start = jnp.cumsum(counts) - counts
    rank = jnp.arange(A) - grp_start[s_e]
    dest = pad_start[s_e] + rank
    n_blocks = (A + N_EXPERTS * (MOE_BLOCK - 1) + MOE_BLOCK - 1) // MOE_BLOCK
    rows = jnp.zeros((n_blocks * MOE_BLOCK, D), xn.dtype).at[dest].set(xf[s_tok])
    blk_start = jnp.arange(n_blocks) * MOE_BLOCK
    blk_e = jnp.minimum(jnp.sum(pad_end[None, :] <= blk_start[:, None], axis=1), N_EXPERTS - 1)

    def expert_block(args):
        xb, e = args
        gu = xb @ w_gate_up[e] + b_gate_up[e]
        x_glu = jnp.minimum(gu[:, :D_FF], SWIGLU_LIMIT)
        x_lin = jnp.clip(gu[:, D_FF:], -SWIGLU_LIMIT, SWIGLU_LIMIT)
        act = (x_lin + 1.0) * (x_glu * jax.nn.sigmoid(SWIGLU_ALPHA * x_glu))
        return act @ w_down[e] + b_down[e]

    y_rows = lax.map(expert_block, (rows.reshape(n_blocks, MOE_BLOCK, D), blk_e)).reshape(-1, D)
    y = y_rows[dest] * s_g[:, None].astype(xn.dtype)
    out = jnp.zeros((T, D), xn.dtype).at[s_tok].add(y)
    return out.reshape(B, L, D)


def setup_inputs(seed: int = 0) -> dict:
    key = jax.random.key(seed)
    ks = jax.random.split(key, 24)

    def nrm(k, shape, scale):
        return jax.random.normal(k, shape, jnp.float32) * scale

    def gain(k, shape):
        return 1.0 + 0.02 * jax.random.normal(k, shape, jnp.float32)

    Ld = DEPTH
    return {
        "x": nrm(ks[0], (BATCH, SEQ, D_MODEL), 1.0),
        "meta_tokens": nrm(ks[1], (N_META, D_MODEL), 1.0),
        "g_mix": gain(ks[2], (Ld, D_MODEL)),
        "w_in": nrm(ks[3], (Ld, D_MODEL, D_IN), D_MODEL ** -0.5),
        "conv_w": nrm(ks[4], (Ld, CONV_WIDTH, D_CONV), CONV_WIDTH ** -0.5),
        "g_q": gain(ks[5], (Ld, Q_LORA)),
        "w_q_up": nrm(ks[6], (Ld, Q_LORA, N_HEADS * (QK_NOPE + QK_ROPE)), Q_LORA ** -0.5),
        "g_kv": gain(ks[7], (Ld, KV_LORA)),
        "w_kv_up": nrm(ks[8], (Ld, KV_LORA, N_HEADS * (QK_NOPE + V_DIM)), KV_LORA ** -0.5),
        "g_conv_out": gain(ks[9], (Ld, D_CONV)),
        "g_attn_out": gain(ks[10], (Ld, N_HEADS * V_DIM)),
        "w_out": nrm(ks[11], (Ld, D_MIX, D_MODEL), D_MIX ** -0.5),
        "g_ffn": gain(ks[12], (Ld, D_MODEL)),
        "w_router": nrm(ks[13], (Ld, D_MODEL, N_EXPERTS), D_MODEL ** -0.5),
        "b_router": nrm(ks[14], (Ld, N_EXPERTS), 0.01),
        "w_gate_up": nrm(ks[15], (Ld, N_EXPERTS, D_MODEL, 2 * D_FF), D_MODEL ** -0.5),
        "b_gate_up": nrm(ks[16], (Ld, N_EXPERTS, 2 * D_FF), 0.02),
        "w_down": nrm(ks[17], (Ld, N_EXPERTS, D_FF, D_MODEL), D_FF ** -0.5),
        "b_down": nrm(ks[18], (Ld, N_EXPERTS, D_MODEL), 0.02),
        "g_final": gain(ks[19], (D_MODEL,)),
    }


def reference(x, meta_tokens, g_mix, w_in, conv_w, g_q, w_q_up, g_kv, w_kv_up, g_conv_out, g_attn_out,
              w_out, g_ffn, w_router, b_router, w_gate_up, b_gate_up, w_down, b_down, g_final):
    B = x.shape[0]
    meta = jnp.broadcast_to(meta_tokens[None].astype(x.dtype), (B, N_META, D_MODEL))
    h = jnp.concatenate([meta, x], axis=1)

    o_b, o_c, o_u = D_CONV, 2 * D_CONV, 3 * D_CONV
    o_q = o_u + Q_LORA
    o_kv = o_q + KV_LORA
    for l in range(DEPTH):
        hn = rmsnorm(h, g_mix[l])
        proj = hn @ w_in[l]
        conv_out = short_conv(proj[..., :o_b], proj[..., o_b:o_c], proj[..., o_c:o_u], conv_w[l])
        attn_out = mla_attention(proj[..., o_u:o_q], proj[..., o_q:o_kv], proj[..., o_kv:],
                                 g_q[l], w_q_up[l], g_kv[l], w_kv_up[l])
        mixed = jnp.concatenate([group_rmsnorm(conv_out, g_conv_out[l], CONV_GROUPS),
                                 group_rmsnorm(attn_out, g_attn_out[l], N_HEADS)], axis=-1)
        h = h + mixed @ w_out[l]
        h = h + moe_ffn(rmsnorm(h, g_ffn[l]), w_router[l], b_router[l], w_gate_up[l], b_gate_up[l],
                        w_down[l], b_down[l])

    y = rmsnorm(h, g_final)
    return y[:, N_META:]
```

```cpp
#include <hip/hip_runtime.h>
#include <cstdint>
#include <cstdio>

typedef unsigned short bf16;
typedef short bf16x8 __attribute__((ext_vector_type(8)));
typedef float f32x4 __attribute__((ext_vector_type(4)));
typedef unsigned u32x4 __attribute__((ext_vector_type(4)));
typedef unsigned u32x2 __attribute__((ext_vector_type(2)));

constexpr int D = 2048, NB = 2, S = 4096, NMETA = 16, M = NB * S;
constexpr int MR = M + NMETA;
constexpr int MRP = 8256;
constexpr int DCONV = 1024, QL = 512, KVL = 256, ROPE = 64, NH = 8, DN = 128, DV = 128, DQK = 192;
constexpr int DIN = 3904, DINP = 4096;
constexpr int O_C = 1024, O_U = 2048, O_Q = 3072, O_KV = 3584, O_R = 3840;
constexpr int NE = 32, TOPK = 4, DFF = 2048;
constexpr int LP = 4224;
constexpr int RP = 41216;
constexpr float EPS = 1e-6f;

constexpr size_t MiB = 1u << 20;
constexpr size_t WS_CTL = 0, CTL_BYTES = 1 * MiB;
constexpr size_t WS_WIN = 2 * MiB;
constexpr size_t WS_WQ = WS_WIN + 16 * MiB;
constexpr size_t WS_WKV = WS_WQ + 2 * MiB;
constexpr size_t WS_WOUT = WS_WKV + 2 * MiB;
constexpr size_t WS_WGU = WS_WOUT + 8 * MiB;
constexpr size_t WS_WD = WS_WGU + 512 * MiB;
constexpr size_t WS_HN = WS_WD + 256 * MiB;
constexpr size_t WS_PROJ = WS_HN + 34 * MiB;
constexpr size_t WS_MIXED = WS_PROJ + 66 * MiB;
constexpr size_t WS_QN = WS_MIXED + 32 * MiB;
constexpr size_t WS_KVN = WS_QN + 8 * MiB;
constexpr size_t WS_QRAW = WS_KVN + 6 * MiB;
constexpr size_t WS_Q = WS_QRAW + 48 * MiB;
constexpr size_t WS_KN = WS_Q + 24 * MiB;
constexpr size_t WS_V = WS_KN + 18 * MiB;
constexpr size_t WS_KPE = WS_V + 18 * MiB;
constexpr size_t WS_H1 = WS_KPE + 2 * MiB;
constexpr size_t WS_XN = WS_H1 + 64 * MiB;
constexpr size_t WS_TOKE = WS_XN + 32 * MiB;
constexpr size_t WS_TOKP = WS_TOKE + 1 * MiB;
constexpr size_t WS_GATE = WS_TOKP + 1 * MiB;
constexpr size_t WS_ROWTOK = WS_GATE + 1 * MiB;
constexpr size_t WS_ACT = WS_ROWTOK + 1 * MiB;
constexpr size_t WS_Y = WS_ACT + 162 * MiB;
constexpr size_t WS_END = WS_Y + 162 * MiB;
constexpr int CW_CNT = 64;

__device__ __forceinline__ float bf2f(bf16 v) { return __uint_as_float((unsigned)v << 16); }
__device__ __forceinline__ bf16 f2bf(float f) { unsigned u = __float_as_uint(f); return (bf16)((u + 0x7fffu + ((u >> 16) & 1u)) >> 16); }
__device__ __forceinline__ float wave_sum(float v) {
#pragma unroll
    for (int o = 1; o < 64; o <<= 1) v += __shfl_xor(v, o);
    return v;
}
__device__ __forceinline__ float wave_max(float v) {
#pragma unroll
    for (int o = 1; o < 64; o <<= 1) v = fmaxf(v, __shfl_xor(v, o));
    return v;
}
__device__ __forceinline__ void unpack8(const u32x4 w, float (&f)[8]) {
    f[0] = __uint_as_float(w.x << 16); f[1] = __uint_as_float(w.x & 0xffff0000u);
    f[2] = __uint_as_float(w.y << 16); f[3] = __uint_as_float(w.y & 0xffff0000u);
    f[4] = __uint_as_float(w.z << 16); f[5] = __uint_as_float(w.z & 0xffff0000u);
    f[6] = __uint_as_float(w.w << 16); f[7] = __uint_as_float(w.w & 0xffff0000u);
}
__device__ __forceinline__ unsigned pk2(float lo, float hi) { return (unsigned)f2bf(lo) | ((unsigned)f2bf(hi) << 16); }

template <int MODE>
__global__ void __launch_bounds__(256) cvt_transpose(const float* __restrict__ W, bf16* __restrict__ WT, int K, int N, int NOUT) {
    __shared__ float tile[32][33];
    const int e = blockIdx.z;
    W += (size_t)e * K * N; WT += (size_t)e * NOUT * K;
    const int n0 = blockIdx.x * 32, k0 = blockIdx.y * 32, tx = threadIdx.x & 31, ty = threadIdx.x >> 5;
#pragma unroll
    for (int i = 0; i < 4; ++i) tile[ty + 8 * i][tx] = W[(size_t)(k0 + ty + 8 * i) * N + n0 + tx];
    __syncthreads();
#pragma unroll
    for (int i = 0; i < 4; ++i) {
        const int n = n0 + ty + 8 * i;
        int dr = n;
        if (MODE == 1) { const int bj = n / 2048, c = n % 2048; dr = 256 * (c / 128) + 128 * bj + (c % 128); }
        WT[(size_t)dr * K + k0 + tx] = f2bf(tile[tx][ty + 8 * i]);
    }
}

__global__ void __launch_bounds__(256) norm1(const float* __restrict__ x, const float* __restrict__ meta, const float* __restrict__ g, bf16* __restrict__ hn) {
    const int lane = threadIdx.x & 63, R = blockIdx.x * 4 + (threadIdx.x >> 6);
    if (R >= MR) return;
    const float* src = R < M ? x + (size_t)R * D : meta + (size_t)(R - M) * D;
    f32x4 v[8]; float ss = 0.f;
#pragma unroll
    for (int j = 0; j < 8; ++j) { v[j] = *(const f32x4*)(src + j * 256 + lane * 4); ss += v[j].x * v[j].x + v[j].y * v[j].y + v[j].z * v[j].z + v[j].w * v[j].w; }
    const float rstd = rsqrtf(wave_sum(ss) * (1.f / D) + EPS);
#pragma unroll
    for (int j = 0; j < 8; ++j) {
        const f32x4 gg = *(const f32x4*)(g + j * 256 + lane * 4);
        u32x2 o; o.x = pk2(v[j].x * rstd * gg.x, v[j].y * rstd * gg.y); o.y = pk2(v[j].z * rstd * gg.z, v[j].w * rstd * gg.w);
        *(u32x2*)(hn + (size_t)R * D + j * 256 + lane * 4) = o;
    }
}

struct EpiProj { bf16* proj; __device__ void operator()(int m, int n, float v) const { proj[(size_t)m * DINP + n] = f2bf(v); } };
struct EpiQraw { float* q; __device__ void operator()(int m, int n, float v) const { if (m < M) q[(size_t)m * 1536 + n] = v; } };
struct EpiKV {
    bf16* kn; bf16* vv;
    __device__ void operator()(int R, int n, float v) const {
        if (R >= MR) return;
        const int h = n >> 8, part = (n >> 7) & 1, d = n & 127;
        bf16* dst = part ? vv : kn; const bf16 o = f2bf(v);
        if (R < M) { const int b = R / S, pos = (R % S) + NMETA; dst[((size_t)(b * LP + pos) * NH + h) * 128 + d] = o; }
        else { const int pos = R - M; dst[((size_t)(0 * LP + pos) * NH + h) * 128 + d] = o; dst[((size_t)(1 * LP + pos) * NH + h) * 128 + d] = o; }
    }
};
struct EpiWout { const float* x; float* h1; __device__ void operator()(int m, int n, float v) const { h1[(size_t)m * D + n] = x[(size_t)m * D + n] + v; } };

template <class Epi>
__global__ void __launch_bounds__(256) gemm_simple(const bf16* __restrict__ A, int lda, const bf16* __restrict__ Bt, int ldb, int K, Epi epi) {
    const int wave = threadIdx.x >> 6, lane = threadIdx.x & 63, r = lane & 15, q = lane >> 4;
    const int m0 = blockIdx.y * 64 + (wave >> 1) * 32, n0 = blockIdx.x * 64 + (wave & 1) * 32;
    f32x4 acc[2][2];
#pragma unroll
    for (int i = 0; i < 2; ++i)
#pragma unroll
        for (int j = 0; j < 2; ++j) acc[i][j] = (f32x4){0.f, 0.f, 0.f, 0.f};
    const bf16* a0 = A + (size_t)(m0 + r) * lda + 8 * q; const bf16* b0 = Bt + (size_t)(n0 + r) * ldb + 8 * q;
    for (int k0 = 0; k0 < K; k0 += 32) {
        bf16x8 a[2], b[2];
#pragma unroll
        for (int i = 0; i < 2; ++i) { a[i] = *(const bf16x8*)(a0 + (size_t)i * 16 * lda + k0); b[i] = *(const bf16x8*)(b0 + (size_t)i * 16 * ldb + k0); }
#pragma unroll
        for (int i = 0; i < 2; ++i)
#pragma unroll
            for (int j = 0; j < 2; ++j) acc[i][j] = __builtin_amdgcn_mfma_f32_16x16x32_bf16(a[i], b[j], acc[i][j], 0, 0, 0);
    }
#pragma unroll
    for (int i = 0; i < 2; ++i)
#pragma unroll
        for (int j = 0; j < 2; ++j)
#pragma unroll
            for (int t = 0; t < 4; ++t) epi(m0 + i * 16 + q * 4 + t, n0 + j * 16 + r, acc[i][j][t]);
}

__device__ __forceinline__ float inv_freq(int i) { return powf(10000.0f, -(float)i / 32.0f); }

__global__ void __launch_bounds__(256) postproj(const bf16* __restrict__ proj, const float* __restrict__ conv_w, const float* __restrict__ g_conv,
                                                const float* __restrict__ g_q, const float* __restrict__ g_kv,
                                                bf16* __restrict__ mixed, bf16* __restrict__ qn, bf16* __restrict__ kvn, bf16* __restrict__ kpe) {
    const int lane = threadIdx.x & 63, R = blockIdx.x * 4 + (threadIdx.x >> 6);
    if (R >= MR) return;
    const bf16* pr = proj + (size_t)R * DINP;
    const bool meta = R >= M; const int b = meta ? 0 : R / S, t = meta ? 0 : R % S, pos = meta ? R - M : t + NMETA;
    {
        const u32x2 w = *(const u32x2*)(pr + O_KV + lane * 4);
        float f[4] = {__uint_as_float(w.x << 16), __uint_as_float(w.x & 0xffff0000u), __uint_as_float(w.y << 16), __uint_as_float(w.y & 0xffff0000u)};
        const float ss = wave_sum(f[0] * f[0] + f[1] * f[1] + f[2] * f[2] + f[3] * f[3]);
        const float rstd = rsqrtf(ss * (1.f / KVL) + EPS);
        const f32x4 g = *(const f32x4*)(g_kv + lane * 4);
        u32x2 o; o.x = pk2(f[0] * rstd * g.x, f[1] * rstd * g.y); o.y = pk2(f[2] * rstd * g.z, f[3] * rstd * g.w);
        *(u32x2*)(kvn + (size_t)R * KVL + lane * 4) = o;
    }
    if (lane < 32) {
        const float x1 = bf2f(pr[O_R + lane]), x2 = bf2f(pr[O_R + 32 + lane]);
        const float ang = (float)pos * inv_freq(lane); const float c = cosf(ang), s = sinf(ang);
        const bf16 o1 = f2bf(x1 * c - x2 * s), o2 = f2bf(x1 * s + x2 * c);
        if (!meta) { bf16* d = kpe + (size_t)(b * LP + pos) * ROPE; d[lane] = o1; d[32 + lane] = o2; }
        else { bf16* d0 = kpe + (size_t)(0 * LP + pos) * ROPE; bf16* d1 = kpe + (size_t)(1 * LP + pos) * ROPE; d0[lane] = o1; d0[32 + lane] = o2; d1[lane] = o1; d1[32 + lane] = o2; }
    }
    if (meta) return;
    {
        float f[8]; unpack8(*(const u32x4*)(pr + O_Q + lane * 8), f);
        float ss = 0.f;
#pragma unroll
        for (int i = 0; i < 8; ++i) ss += f[i] * f[i];
        const float rstd = rsqrtf(wave_sum(ss) * (1.f / QL) + EPS);
        const f32x4 g0 = *(const f32x4*)(g_q + lane * 8), g1 = *(const f32x4*)(g_q + lane * 8 + 4);
        u32x4 o; o.x = pk2(f[0] * rstd * g0.x, f[1] * rstd * g0.y); o.y = pk2(f[2] * rstd * g0.z, f[3] * rstd * g0.w);
        o.z = pk2(f[4] * rstd * g1.x, f[5] * rstd * g1.y); o.w = pk2(f[6] * rstd * g1.z, f[7] * rstd * g1.w);
        *(u32x4*)(qn + (size_t)R * QL + lane * 8) = o;
    }
    {
        const int r1 = (t >= 1) ? R - 1 : M + 15, r2 = (t >= 2) ? R - 2 : (t == 1 ? M + 15 : M + 14);
        const bf16* p1 = proj + (size_t)r1 * DINP; const bf16* p2 = proj + (size_t)r2 * DINP;
        const int c0 = lane * 16;
        float v[16]; float ss = 0.f;
#pragma unroll
        for (int hh = 0; hh < 2; ++hh) {
            const int c = c0 + hh * 8;
            float bg[8], cg0[8], ui0[8], cg1[8], ui1[8], cg2[8], ui2[8];
            unpack8(*(const u32x4*)(pr + c), bg); unpack8(*(const u32x4*)(pr + O_C + c), cg0); unpack8(*(const u32x4*)(pr + O_U + c), ui0);
            unpack8(*(const u32x4*)(p1 + O_C + c), cg1); unpack8(*(const u32x4*)(p1 + O_U + c), ui1);
            unpack8(*(const u32x4*)(p2 + O_C + c), cg2); unpack8(*(const u32x4*)(p2 + O_U + c), ui2);
#pragma unroll
            for (int i = 0; i < 8; ++i) {
                const float y = conv_w[2 * DCONV + c + i] * (cg0[i] * ui0[i]) + conv_w[1 * DCONV + c + i] * (cg1[i] * ui1[i]) + conv_w[0 * DCONV + c + i] * (cg2[i] * ui2[i]);
                const float o = bg[i] * y; v[hh * 8 + i] = o; ss += o * o;
            }
        }
        ss += __shfl_xor(ss, 1); ss += __shfl_xor(ss, 2);
        const float rstd = rsqrtf(ss * (1.f / 64.f) + EPS);
#pragma unroll
        for (int hh = 0; hh < 2; ++hh) {
            const int c = c0 + hh * 8;
            const f32x4 g0 = *(const f32x4*)(g_conv + c), g1 = *(const f32x4*)(g_conv + c + 4);
            u32x4 o; o.x = pk2(v[hh * 8 + 0] * rstd * g0.x, v[hh * 8 + 1] * rstd * g0.y); o.y = pk2(v[hh * 8 + 2] * rstd * g0.z, v[hh * 8 + 3] * rstd * g0.w);
            o.z = pk2(v[hh * 8 + 4] * rstd * g1.x, v[hh * 8 + 5] * rstd * g1.y); o.w = pk2(v[hh * 8 + 6] * rstd * g1.z, v[hh * 8 + 7] * rstd * g1.w);
            *(u32x4*)(mixed + (size_t)R * D + c) = o;
        }
    }
}

__global__ void __launch_bounds__(256) rope_q(const float* __restrict__ qraw, bf16* __restrict__ Q) {
    const int lane = threadIdx.x & 63, m = blockIdx.x * 4 + (threadIdx.x >> 6);
    if (m >= M) return;
    const int pos = (m % S) + NMETA;
    float c = 0.f, s = 0.f;
    if (lane < 32) { const float ang = (float)pos * inv_freq(lane); c = cosf(ang); s = sinf(ang); }
    for (int h = 0; h < NH; ++h) {
        const float* src = qraw + (size_t)m * 1536 + h * DQK; bf16* dst = Q + ((size_t)m * NH + h) * DQK;
        dst[lane] = f2bf(src[lane]); dst[64 + lane] = f2bf(src[64 + lane]);
        if (lane < 32) { const float x1 = src[128 + lane], x2 = src[160 + lane]; dst[128 + lane] = f2bf(x1 * c - x2 * s); dst[160 + lane] = f2bf(x1 * s + x2 * c); }
    }
}

__global__ void __launch_bounds__(256) attn_simple(const bf16* __restrict__ Q, const bf16* __restrict__ Kn, const bf16* __restrict__ Kpe, const bf16* __restrict__ V,
                                                   const float* __restrict__ g_attn, bf16* __restrict__ mixed) {
    const int lane = threadIdx.x & 63, wid = blockIdx.x * 4 + (threadIdx.x >> 6);
    if (wid >= M * NH) return;
    const int m = wid / NH, h = wid % NH, b = m / S, pos = (m % S) + NMETA;
    const bf16* q = Q + ((size_t)m * NH + h) * DQK;
    const float scale = 0.07216878364870322f;
    const float q0 = bf2f(q[lane]) * scale, q1 = bf2f(q[64 + lane]) * scale, q2 = bf2f(q[128 + lane]) * scale;
    const bf16* kn = Kn + ((size_t)b * LP * NH + h) * 128; const bf16* vv = V + ((size_t)b * LP * NH + h) * 128; const bf16* kp = Kpe + (size_t)b * LP * ROPE;
    float mx = -INFINITY, sum = 0.f, o0 = 0.f, o1 = 0.f;
    for (int j = 0; j <= pos; j += 4) {
        float s[4], v0[4], v1[4];
#pragma unroll
        for (int u = 0; u < 4; ++u) {
            const size_t ro = (size_t)(j + u) * NH * 128;
            float p = q0 * bf2f(kn[ro + lane]) + q1 * bf2f(kn[ro + 64 + lane]) + q2 * bf2f(kp[(size_t)(j + u) * ROPE + lane]);
            v0[u] = bf2f(vv[ro + lane]); v1[u] = bf2f(vv[ro + 64 + lane]);
            s[u] = p;
        }
#pragma unroll
        for (int o = 1; o < 64; o <<= 1) {
#pragma unroll
            for (int u = 0; u < 4; ++u) s[u] += __shfl_xor(s[u], o);
        }
#pragma unroll
        for (int u = 0; u < 4; ++u) if (j + u > pos) s[u] = -INFINITY;
        const float mn = fmaxf(fmaxf(mx, fmaxf(s[0], s[1])), fmaxf(s[2], s[3]));
        const float corr = __expf(mx - mn);
        sum *= corr; o0 *= corr; o1 *= corr;
#pragma unroll
        for (int u = 0; u < 4; ++u) { const float p = __expf(s[u] - mn); sum += p; o0 += p * v0[u]; o1 += p * v1[u]; }
        mx = mn;
    }
    const float inv = 1.f / sum; o0 *= inv; o1 *= inv;
    const float ss = wave_sum(o0 * o0 + o1 * o1);
    const float rstd = rsqrtf(ss * (1.f / 128.f) + EPS);
    bf16* dst = mixed + (size_t)m * D + DCONV + h * DV;
    dst[lane] = f2bf(o0 * rstd * g_attn[h * DV + lane]); dst[64 + lane] = f2bf(o1 * rstd * g_attn[h * DV + 64 + lane]);
}

__global__ void __launch_bounds__(256) router(const float* __restrict__ h1, const float* __restrict__ g_ffn, const float* __restrict__ w_r, const float* __restrict__ b_r,
                                              bf16* __restrict__ xn, unsigned* __restrict__ cnt, int* __restrict__ rowtok, int* __restrict__ tok_e, int* __restrict__ tok_p, float* __restrict__ gate) {
    const int lane = threadIdx.x & 63, m = blockIdx.x * 4 + (threadIdx.x >> 6);
    if (m >= M) return;
    const float* src = h1 + (size_t)m * D;
    float ss = 0.f;
#pragma unroll
    for (int j = 0; j < 8; ++j) { const f32x4 t = *(const f32x4*)(src + j * 256 + lane * 4); ss += t.x * t.x + t.y * t.y + t.z * t.z + t.w * t.w; }
    const float rstd = rsqrtf(wave_sum(ss) * (1.f / D) + EPS);
    float acc[32];
#pragma unroll
    for (int e = 0; e < 32; ++e) acc[e] = 0.f;
#pragma unroll 1
    for (int j = 0; j < 8; ++j) {
        const f32x4 vv = *(const f32x4*)(src + j * 256 + lane * 4);
        const f32x4 gg = *(const f32x4*)(g_ffn + j * 256 + lane * 4);
        const float xv[4] = {vv.x * rstd * gg.x, vv.y * rstd * gg.y, vv.z * rstd * gg.z, vv.w * rstd * gg.w};
        u32x2 o; o.x = pk2(xv[0], xv[1]); o.y = pk2(xv[2], xv[3]);
        *(u32x2*)(xn + (size_t)m * D + j * 256 + lane * 4) = o;
#pragma unroll
        for (int i = 0; i < 4; ++i) {
            const float* wr = w_r + (size_t)(j * 256 + lane * 4 + i) * NE;
#pragma unroll
            for (int e4 = 0; e4 < 8; ++e4) { const f32x4 w = *(const f32x4*)(wr + e4 * 4);
                acc[e4 * 4 + 0] += xv[i] * w.x; acc[e4 * 4 + 1] += xv[i] * w.y; acc[e4 * 4 + 2] += xv[i] * w.z; acc[e4 * 4 + 3] += xv[i] * w.w; }
        }
    }
    float logit = -INFINITY;
#pragma unroll
    for (int e = 0; e < 32; ++e) { const float tot = wave_sum(acc[e]) + b_r[e]; if (lane == e) logit = tot; }
    float tv[4]; int ti[4];
#pragma unroll
    for (int k = 0; k < 4; ++k) {
        const float mxv = wave_max(logit);
        const unsigned long long mask = __ballot(logit == mxv);
        const int idx = __ffsll((long long)mask) - 1;
        tv[k] = mxv; ti[k] = idx;
        if (lane == idx) logit = -INFINITY;
    }
    float ex[4]; float es = 0.f;
#pragma unroll
    for (int k = 0; k < 4; ++k) { ex[k] = expf(tv[k] - tv[0]); es += ex[k]; }
    if (lane == 0) {
#pragma unroll
        for (int k = 0; k < 4; ++k) {
            const unsigned p = atomicAdd(&cnt[ti[k]], 1u);
            rowtok[ti[k] * M + p] = m; tok_e[m * 4 + k] = ti[k]; tok_p[m * 4 + k] = (int)p; gate[m * 4 + k] = ex[k] / es;
        }
    }
}

__device__ __forceinline__ bool expert_of_row(const unsigned* cnt, int row0, int& e_out, int& local0, int& n_out, int& off_out) {
    int off = 0;
    for (int e = 0; e < NE; ++e) { const int n = (int)cnt[e], p = (n + 255) / 256 * 256; if (row0 < off + p) { e_out = e; local0 = row0 - off; n_out = n; off_out = off; return true; } off += p; }
    return false;
}
__global__ void __launch_bounds__(256) moe1(const bf16* __restrict__ xn, const bf16* __restrict__ Wgu, const float* __restrict__ b_gu, const unsigned* __restrict__ cnt,
                                            const int* __restrict__ rowtok, bf16* __restrict__ act) {
    int e, local0, n, off;
    if (!expert_of_row(cnt, blockIdx.y * 64, e, local0, n, off)) return;
    if (local0 >= n) return;
    const int wave = threadIdx.x >> 6, lane = threadIdx.x & 63, r = lane & 15, q = lane >> 4;
    const int lm0 = local0 + (wave >> 1) * 32, c0 = blockIdx.x * 64 + (wave & 1) * 32;
    const bf16* Wt = Wgu + (size_t)e * 4096 * D;
    const bf16* ap[2]; const bf16* bg[2];
#pragma unroll
    for (int i = 0; i < 2; ++i) { const int li = lm0 + i * 16 + r; const int tok = li < n ? rowtok[e * M + li] : rowtok[e * M]; ap[i] = xn + (size_t)tok * D + 8 * q; }
#pragma unroll
    for (int j = 0; j < 2; ++j) { const int c = c0 + j * 16 + r; const int ng = 256 * (c >> 7) + (c & 127); bg[j] = Wt + (size_t)ng * D + 8 * q; }
    f32x4 ag[2][2], al[2][2];
#pragma unroll
    for (int i = 0; i < 2; ++i)
#pragma unroll
        for (int j = 0; j < 2; ++j) { ag[i][j] = (f32x4){0.f, 0.f, 0.f, 0.f}; al[i][j] = (f32x4){0.f, 0.f, 0.f, 0.f}; }
    for (int k0 = 0; k0 < D; k0 += 32) {
        bf16x8 a[2], wg[2], wl[2];
#pragma unroll
        for (int i = 0; i < 2; ++i) { a[i] = *(const bf16x8*)(ap[i] + k0); wg[i] = *(const bf16x8*)(bg[i] + k0); wl[i] = *(const bf16x8*)(bg[i] + (size_t)128 * D + k0); }
#pragma unroll
        for (int i = 0; i < 2; ++i)
#pragma unroll
            for (int j = 0; j < 2; ++j) { ag[i][j] = __builtin_amdgcn_mfma_f32_16x16x32_bf16(a[i], wg[j], ag[i][j], 0, 0, 0); al[i][j] = __builtin_amdgcn_mfma_f32_16x16x32_bf16(a[i], wl[j], al[i][j], 0, 0, 0); }
    }
    const float* bias = b_gu + (size_t)e * 4096;
#pragma unroll
    for (int i = 0; i < 2; ++i)
#pragma unroll
        for (int j = 0; j < 2; ++j)
#pragma unroll
            for (int t = 0; t < 4; ++t) {
                const int li = lm0 + i * 16 + q * 4 + t, c = c0 + j * 16 + r;
                if (li < n) {
                    const float g = fminf(ag[i][j][t] + bias[c], 7.0f);
                    const float l = fminf(fmaxf(al[i][j][t] + bias[2048 + c], -7.0f), 7.0f);
                    const float a = (l + 1.0f) * (g / (1.0f + expf(-1.702f * g)));
                    act[(size_t)(off + li) * DFF + c] = f2bf(a);
                }
            }
}
__global__ void __launch_bounds__(256) moe2(const bf16* __restrict__ act, const bf16* __restrict__ Wd, const float* __restrict__ b_d, const unsigned* __restrict__ cnt, bf16* __restrict__ y) {
    int e, local0, n, off;
    if (!expert_of_row(cnt, blockIdx.y * 64, e, local0, n, off)) return;
    if (local0 >= n) return;
    const int wave = threadIdx.x >> 6, lane = threadIdx.x & 63, r = lane & 15, q = lane >> 4;
    const int lm0 = local0 + (wave >> 1) * 32, n0 = blockIdx.x * 64 + (wave & 1) * 32;
    const bf16* Wt = Wd + (size_t)e * D * DFF;
    const bf16* a0 = act + (size_t)(off + lm0 + r) * DFF + 8 * q; const bf16* b0 = Wt + (size_t)(n0 + r) * DFF + 8 * q;
    f32x4 acc[2][2];
#pragma unroll
    for (int i = 0; i < 2; ++i)
#pragma unroll
        for (int j = 0; j < 2; ++j) acc[i][j] = (f32x4){0.f, 0.f, 0.f, 0.f};
    for (int k0 = 0; k0 < DFF; k0 += 32) {
        bf16x8 a[2], b[2];
#pragma unroll
        for (int i = 0; i < 2; ++i) { a[i] = *(const bf16x8*)(a0 + (size_t)i * 16 * DFF + k0); b[i] = *(const bf16x8*)(b0 + (size_t)i * 16 * DFF + k0); }
#pragma unroll
        for (int i = 0; i < 2; ++i)
#pragma unroll
            for (int j = 0; j < 2; ++j) acc[i][j] = __builtin_amdgcn_mfma_f32_16x16x32_bf16(a[i], b[j], acc[i][j], 0, 0, 0);
    }
    const float* bias = b_d + (size_t)e * D;
#pragma unroll
    for (int i = 0; i < 2; ++i)
#pragma unroll
        for (int j = 0; j < 2; ++j)
#pragma unroll
            for (int t = 0; t < 4; ++t) { const int li = lm0 + i * 16 + q * 4 + t, c = n0 + j * 16 + r; if (li < n) y[(size_t)(off + li) * D + c] = f2bf(acc[i][j][t] + bias[c]); }
}

__global__ void __launch_bounds__(256) combine(const float* __restrict__ h1, const bf16* __restrict__ y, const unsigned* __restrict__ cnt, const int* __restrict__ tok_e, const int* __restrict__ tok_p,
                                               const float* __restrict__ gate, const float* __restrict__ g_final, float* __restrict__ out) {
    const int lane = threadIdx.x & 63, m = blockIdx.x * 4 + (threadIdx.x >> 6);
    if (m >= M) return;
    size_t yrow[4]; float gk[4];
#pragma unroll
    for (int k = 0; k < 4; ++k) {
        const int e = tok_e[m * 4 + k]; int off = 0;
        for (int e2 = 0; e2 < e; ++e2) off += ((int)cnt[e2] + 255) / 256 * 256;
        yrow[k] = (size_t)(off + tok_p[m * 4 + k]) * D; gk[k] = gate[m * 4 + k];
    }
    f32x4 v[8]; float ss = 0.f;
#pragma unroll
    for (int j = 0; j < 8; ++j) {
        const int idx = j * 256 + lane * 4;
        f32x4 a = *(const f32x4*)(h1 + (size_t)m * D + idx);
#pragma unroll
        for (int k = 0; k < 4; ++k) { const u32x2 w = *(const u32x2*)(y + yrow[k] + idx);
            a.x += gk[k] * __uint_as_float(w.x << 16); a.y += gk[k] * __uint_as_float(w.x & 0xffff0000u); a.z += gk[k] * __uint_as_float(w.y << 16); a.w += gk[k] * __uint_as_float(w.y & 0xffff0000u); }
        v[j] = a; ss += a.x * a.x + a.y * a.y + a.z * a.z + a.w * a.w;
    }
    const float rstd = rsqrtf(wave_sum(ss) * (1.f / D) + EPS);
#pragma unroll
    for (int j = 0; j < 8; ++j) { const int idx = j * 256 + lane * 4; const f32x4 gg = *(const f32x4*)(g_final + idx);
        *(f32x4*)(out + (size_t)m * D + idx) = (f32x4){v[j].x * rstd * gg.x, v[j].y * rstd * gg.y, v[j].z * rstd * gg.z, v[j].w * rstd * gg.w}; }
}

extern "C" void kernel_launch(void* const* d_in, const int* in_sizes, int n_in, void* d_out, int out_size, void* d_ws, size_t ws_size, hipStream_t stream) {
    if (n_in != 20 || ws_size < WS_END) { fprintf(stderr, "kernel_launch: unexpected n_in %d / ws %zu (need %zu)\n", n_in, ws_size, (size_t)WS_END); return; }
    const float* x = (const float*)d_in[0]; const float* meta = (const float*)d_in[1]; const float* g_mix = (const float*)d_in[2]; const float* w_in = (const float*)d_in[3];
    const float* conv_w = (const float*)d_in[4]; const float* g_q = (const float*)d_in[5]; const float* w_q_up = (const float*)d_in[6]; const float* g_kv = (const float*)d_in[7];
    const float* w_kv_up = (const float*)d_in[8]; const float* g_conv = (const float*)d_in[9]; const float* g_attn = (const float*)d_in[10]; const float* w_out = (const float*)d_in[11];
    const float* g_ffn = (const float*)d_in[12]; const float* w_router = (const float*)d_in[13]; const float* b_router = (const float*)d_in[14]; const float* w_gu = (const float*)d_in[15];
    const float* b_gu = (const float*)d_in[16]; const float* w_d = (const float*)d_in[17]; const float* b_d = (const float*)d_in[18]; const float* g_final = (const float*)d_in[19];
    unsigned char* ws = (unsigned char*)d_ws;
    unsigned* ctl = (unsigned*)(ws + WS_CTL);
    bf16* Win = (bf16*)(ws + WS_WIN); bf16* Wq = (bf16*)(ws + WS_WQ); bf16* Wkv = (bf16*)(ws + WS_WKV); bf16* Wout = (bf16*)(ws + WS_WOUT); bf16* Wgu = (bf16*)(ws + WS_WGU); bf16* Wd = (bf16*)(ws + WS_WD);
    bf16* hn = (bf16*)(ws + WS_HN); bf16* proj = (bf16*)(ws + WS_PROJ); bf16* mixed = (bf16*)(ws + WS_MIXED); bf16* qn = (bf16*)(ws + WS_QN); bf16* kvn = (bf16*)(ws + WS_KVN);
    float* qraw = (float*)(ws + WS_QRAW); bf16* Q = (bf16*)(ws + WS_Q); bf16* Kn = (bf16*)(ws + WS_KN); bf16* V = (bf16*)(ws + WS_V); bf16* Kpe = (bf16*)(ws + WS_KPE);
    float* h1 = (float*)(ws + WS_H1); bf16* xn = (bf16*)(ws + WS_XN); int* tok_e = (int*)(ws + WS_TOKE); int* tok_p = (int*)(ws + WS_TOKP); float* gate = (float*)(ws + WS_GATE);
    int* rowtok = (int*)(ws + WS_ROWTOK); bf16* act = (bf16*)(ws + WS_ACT); bf16* y = (bf16*)(ws + WS_Y);

    hipMemsetAsync(ws + WS_CTL, 0, CTL_BYTES, stream);
    hipMemsetAsync(Win + (size_t)DIN * D, 0, (size_t)(DINP - DIN) * D * 2, stream);
    cvt_transpose<0><<<dim3(DIN / 32, D / 32, 1), 256, 0, stream>>>(w_in, Win, D, DIN, DINP);
    cvt_transpose<0><<<dim3(1536 / 32, QL / 32, 1), 256, 0, stream>>>(w_q_up, Wq, QL, 1536, 1536);
    cvt_transpose<0><<<dim3(2048 / 32, KVL / 32, 1), 256, 0, stream>>>(w_kv_up, Wkv, KVL, 2048, 2048);
    cvt_transpose<0><<<dim3(D / 32, D / 32, 1), 256, 0, stream>>>(w_out, Wout, D, D, D);
    cvt_transpose<1><<<dim3(4096 / 32, D / 32, NE), 256, 0, stream>>>(w_gu, Wgu, D, 4096, 4096);
    cvt_transpose<0><<<dim3(D / 32, DFF / 32, NE), 256, 0, stream>>>(w_d, Wd, DFF, D, D);
    norm1<<<(MR + 3) / 4, 256, 0, stream>>>(x, meta, g_mix, hn);
    gemm_simple<EpiProj><<<dim3(DINP / 64, MRP / 64), 256, 0, stream>>>(hn, D, Win, D, D, EpiProj{proj});
    postproj<<<(MR + 3) / 4, 256, 0, stream>>>(proj, conv_w, g_conv, g_q, g_kv, mixed, qn, kvn, Kpe);
    gemm_simple<EpiQraw><<<dim3(1536 / 64, M / 64), 256, 0, stream>>>(qn, QL, Wq, QL, QL, EpiQraw{qraw});
    rope_q<<<M / 4, 256, 0, stream>>>(qraw, Q);
    gemm_simple<EpiKV><<<dim3(2048 / 64, MRP / 64), 256, 0, stream>>>(kvn, KVL, Wkv, KVL, KVL, EpiKV{Kn, V});
    attn_simple<<<M * NH / 4, 256, 0, stream>>>(Q, Kn, Kpe, V, g_attn, mixed);
    gemm_simple<EpiWout><<<dim3(D / 64, M / 64), 256, 0, stream>>>(mixed, D, Wout, D, D, EpiWout{x, h1});
    router<<<M / 4, 256, 0, stream>>>(h1, g_ffn, w_router, b_router, xn, ctl + CW_CNT, rowtok, tok_e, tok_p, gate);
    moe1<<<dim3(DFF / 64, RP / 64), 256, 0, stream>>>(xn, Wgu, b_gu, ctl + CW_CNT, rowtok, act);
    moe2<<<dim3(D / 64, RP / 64), 256, 0, stream>>>(act, Wd, b_d, ctl + CW_CNT, y);
    combine<<<M / 4, 256, 0, stream>>>(h1, y, ctl + CW_CNT, tok_e, tok_p, gate, g_final, (float*)d_out);
}
```

```cpp
#include <hip/hip_runtime.h>
#include <cstdint>
#include <cstdio>

typedef unsigned short bf16;
typedef short bf16x8 __attribute__((ext_vector_type(8)));
typedef float f32x4 __attribute__((ext_vector_type(4)));
typedef unsigned u32x4 __attribute__((ext_vector_type(4)));
typedef unsigned u32x2 __attribute__((ext_vector_type(2)));

constexpr int D = 2048, NB = 2, S = 4096, NMETA = 16, M = NB * S;
constexpr int MR = M + NMETA;
constexpr int MRP = 8256;
constexpr int DCONV = 1024, QL = 512, KVL = 256, ROPE = 64, NH = 8, DN = 128, DV = 128, DQK = 192;
constexpr int DIN = 3904, DINP = 4096;
constexpr int O_C = 1024, O_U = 2048, O_Q = 3072, O_KV = 3584, O_R = 3840;
constexpr int NE = 32, TOPK = 4, DFF = 2048;
constexpr int LP = 4224;
constexpr int RP = 41216;
constexpr float EPS = 1e-6f;

constexpr size_t MiB = 1u << 20;
constexpr size_t WS_CTL = 0, CTL_BYTES = 1 * MiB;
constexpr size_t WS_WIN = 2 * MiB;
constexpr size_t WS_WQ = WS_WIN + 16 * MiB;
constexpr size_t WS_WKV = WS_WQ + 2 * MiB;
constexpr size_t WS_WOUT = WS_WKV + 2 * MiB;
constexpr size_t WS_WGU = WS_WOUT + 8 * MiB;
constexpr size_t WS_WD = WS_WGU + 512 * MiB;
constexpr size_t WS_HN = WS_WD + 256 * MiB;
constexpr size_t WS_PROJ = WS_HN + 34 * MiB;
constexpr size_t WS_MIXED = WS_PROJ + 66 * MiB;
constexpr size_t WS_QN = WS_MIXED + 32 * MiB;
constexpr size_t WS_KVN = WS_QN + 8 * MiB;
constexpr size_t WS_QRAW = WS_KVN + 6 * MiB;
constexpr size_t WS_Q = WS_QRAW + 48 * MiB;
constexpr size_t WS_KN = WS_Q + 24 * MiB;
constexpr size_t WS_V = WS_KN + 18 * MiB;
constexpr size_t WS_KPE = WS_V + 18 * MiB;
constexpr size_t WS_H1 = WS_KPE + 2 * MiB;
constexpr size_t WS_XN = WS_H1 + 64 * MiB;
constexpr size_t WS_TOKE = WS_XN + 32 * MiB;
constexpr size_t WS_TOKP = WS_TOKE + 1 * MiB;
constexpr size_t WS_GATE = WS_TOKP + 1 * MiB;
constexpr size_t WS_ROWTOK = WS_GATE + 1 * MiB;
constexpr size_t WS_ACT = WS_ROWTOK + 1 * MiB;
constexpr size_t WS_Y = WS_ACT + 162 * MiB;
constexpr size_t WS_END = WS_Y + 162 * MiB;
constexpr int CW_CNT = 64;
constexpr int CW_BAR = 4096;

__device__ __forceinline__ float bf2f(bf16 v) { return __uint_as_float((unsigned)v << 16); }
__device__ __forceinline__ bf16 f2bf(float f) { unsigned u = __float_as_uint(f); return (bf16)((u + 0x7fffu + ((u >> 16) & 1u)) >> 16); }
__device__ __forceinline__ float wave_sum(float v) {
#pragma unroll
    for (int o = 1; o < 64; o <<= 1) v += __shfl_xor(v, o);
    return v;
}
__device__ __forceinline__ float wave_max(float v) {
#pragma unroll
    for (int o = 1; o < 64; o <<= 1) v = fmaxf(v, __shfl_xor(v, o));
    return v;
}
__device__ __forceinline__ void unpack8(const u32x4 w, float (&f)[8]) {
    f[0] = __uint_as_float(w.x << 16); f[1] = __uint_as_float(w.x & 0xffff0000u);
    f[2] = __uint_as_float(w.y << 16); f[3] = __uint_as_float(w.y & 0xffff0000u);
    f[4] = __uint_as_float(w.z << 16); f[5] = __uint_as_float(w.z & 0xffff0000u);
    f[6] = __uint_as_float(w.w << 16); f[7] = __uint_as_float(w.w & 0xffff0000u);
}
__device__ __forceinline__ unsigned pk2(float lo, float hi) { return (unsigned)f2bf(lo) | ((unsigned)f2bf(hi) << 16); }


#define GAS __attribute__((address_space(1)))
#define LAS __attribute__((address_space(3)))
#define LDS_WAIT() asm volatile("s_waitcnt lgkmcnt(0)" ::: "memory")
#define VM_WAIT() asm volatile("s_waitcnt vmcnt(0)" ::: "memory")
constexpr int NWAVES = 8;
constexpr int LDS_BYTES = 147456;
constexpr int RING_BYTES = 131072, MISC_OFF = RING_BYTES + 320;

#define XB_TMO      128
#define XB_XCNT(j)  (256  + 64 * (j))
#define XB_XSUB(j)  (1280 + 64 * (j))
#define XB_XGEN(j)  (2304 + 64 * (j))
#define XB_TOP      3328
#define XB_TOPGEN   3392
#define XCD_BAR_WORDS 3456
#define XB_SPIN_CAP (1u << 18)

__device__ __forceinline__ unsigned xb_ld(unsigned* p)              { return __hip_atomic_load(p, __ATOMIC_RELAXED, __HIP_MEMORY_SCOPE_AGENT); }
__device__ __forceinline__ unsigned xb_add(unsigned* p, unsigned v) { return __hip_atomic_fetch_add(p, v, __ATOMIC_RELAXED, __HIP_MEMORY_SCOPE_AGENT); }
__device__ __forceinline__ unsigned xb_xcc_id() { return (unsigned)__builtin_amdgcn_s_getreg((3 << 11) | 20) & 0xFu; }
#define XB_SPIN(cond, bar) do { unsigned _sp = 0; while (cond) { __builtin_amdgcn_s_sleep(1); \
    if ((++_sp & 255u) == 0u) { if (xb_ld(&(bar)[XB_TMO])) break; if (_sp > XB_SPIN_CAP) { atomicAdd(&(bar)[XB_TMO], 1u); break; } } } } while (0)

struct XcdBarrier {
    unsigned* bar; unsigned x;
    volatile LAS unsigned* st;
};
__device__ __forceinline__ XcdBarrier xcd_barrier_post(unsigned* bar, volatile LAS unsigned* st) {
    XcdBarrier b; b.bar = bar; b.x = xb_xcc_id(); b.st = st;
    if (threadIdx.x == 0) (void)xb_add(&bar[XB_XCNT(b.x)], 1u);
    return b;
}
__device__ __forceinline__ void xcd_barrier_complete(unsigned* bar, unsigned x, unsigned& nloc, unsigned& nx) {
    const unsigned G = gridDim.x * gridDim.y * gridDim.z;
    unsigned sum, cnt, mine, sp = 0u;
    for (;;) {
        sum = 0u; cnt = 0u; mine = 0u;
#pragma unroll
        for (unsigned j = 0; j < 16; ++j) { const unsigned c = xb_ld(&bar[XB_XCNT(j)]); sum += c; cnt += (c > 0u) ? 1u : 0u; mine = (j == x) ? c : mine; }
        if (sum == G) break;
        __builtin_amdgcn_s_sleep(1);
        if ((++sp & 255u) == 0u) { if (xb_ld(&bar[XB_TMO])) break; if (sp > XB_SPIN_CAP) { atomicAdd(&bar[XB_TMO], 1u); break; } }
    }
    nloc = mine > 0u ? mine : 1u; nx = cnt > 0u ? cnt : 1u;
}
__device__ __forceinline__ void xcd_barrier(const XcdBarrier& b) {
    asm volatile("s_waitcnt vmcnt(0)" ::: "memory");
    __syncthreads();
    if (threadIdx.x == 0) {
        unsigned* bar = b.bar;
        __builtin_amdgcn_s_waitcnt(0);
        unsigned nloc = b.st[0], nx = b.st[1];
        if (nloc == 0u) { xcd_barrier_complete(bar, b.x, nloc, nx); b.st[0] = nloc; b.st[1] = nx; }
        const unsigned old = xb_add(&bar[XB_XSUB(b.x)], 1u);
        const unsigned gen = old / nloc;
        if (old + 1u == (gen + 1u) * nloc) {
            __builtin_amdgcn_fence(__ATOMIC_RELEASE, "agent");
            asm volatile("s_waitcnt vmcnt(0)" ::: "memory");
            const unsigned og = xb_add(&bar[XB_TOP], 1u);
            const unsigned tg = og / nx;
            if (og + 1u == (tg + 1u) * nx) xb_add(&bar[XB_TOPGEN], 1u);
            else XB_SPIN(xb_ld(&bar[XB_TOPGEN]) == tg, bar);
            __builtin_amdgcn_fence(__ATOMIC_ACQUIRE, "agent");
            xb_add(&bar[XB_XGEN(b.x)], 1u);
            asm volatile("s_waitcnt vmcnt(0)" ::: "memory");
        } else {
            XB_SPIN(xb_ld(&bar[XB_XGEN(b.x)]) == gen, bar);
            __builtin_amdgcn_fence(__ATOMIC_ACQUIRE, "agent");
            asm volatile("s_waitcnt vmcnt(0)" ::: "memory");
        }
    }
    __syncthreads();
}

struct Ctx { int lane, wave, tid, gw, NGW, wg, G; LAS unsigned char* lds; };

template <int MODE>
__device__ __forceinline__ void transpose_item(const float* W, int K, int N, bf16* WT, LAS float* scr, int item, int lane) {
    const int nblk = N / 32, kb = item / nblk, nb = item % nblk, k0 = 64 * kb, n0 = 32 * nb;
    int dr0 = n0;
    if (MODE == 1) { const int bj = n0 / 2048, c = n0 % 2048; dr0 = 256 * (c / 128) + 128 * bj + (c % 128); }
#pragma unroll 8
    for (int i = 0; i < 32; ++i) { const int kk = 2 * i + (lane >> 5); scr[kk * 33 + (lane & 31)] = W[(size_t)(k0 + kk) * N + n0 + (lane & 31)]; }
    LDS_WAIT(); asm volatile("" ::: "memory");
    const int c = lane & 7;
#pragma unroll
    for (int j = 0; j < 4; ++j) { const int n = (lane >> 3) + 8 * j; const LAS float* s = scr + (8 * c) * 33 + n;
        u32x4 o; o.x = pk2(s[0 * 33], s[1 * 33]); o.y = pk2(s[2 * 33], s[3 * 33]); o.z = pk2(s[4 * 33], s[5 * 33]); o.w = pk2(s[6 * 33], s[7 * 33]);
        *(u32x4*)(WT + (size_t)(dr0 + n) * K + k0 + 8 * c) = o; }
    LDS_WAIT(); asm volatile("" ::: "memory");
}
template <int MODE>
__device__ __forceinline__ void transpose_all(const Ctx& c, const float* W, int K, int N, int NOUT, int NEXP, bf16* WT) {
    LAS float* scr = (LAS float*)(c.lds + c.wave * 16384);
    const int per = (K / 64) * (N / 32), total = per * NEXP;
    for (int it = c.gw; it < total; it += c.NGW) { const int e = it / per, r = it % per;
        transpose_item<MODE>(W + (size_t)e * K * N, K, N, WT + (size_t)e * NOUT * K, scr, r, c.lane); }
}

__device__ __forceinline__ void norm1_row(int R, int lane, const float* x, const float* meta, const float* g, bf16* hn) {
    const float* src = R < M ? x + (size_t)R * D : meta + (size_t)(R - M) * D;
    f32x4 v[8]; float ss = 0.f;
#pragma unroll
    for (int j = 0; j < 8; ++j) { v[j] = *(const f32x4*)(src + j * 256 + lane * 4); ss += v[j].x * v[j].x + v[j].y * v[j].y + v[j].z * v[j].z + v[j].w * v[j].w; }
    const float rstd = rsqrtf(wave_sum(ss) * (1.f / D) + EPS);
#pragma unroll
    for (int j = 0; j < 8; ++j) {
        const f32x4 gg = *(const f32x4*)(g + j * 256 + lane * 4);
        u32x2 o; o.x = pk2(v[j].x * rstd * gg.x, v[j].y * rstd * gg.y); o.y = pk2(v[j].z * rstd * gg.z, v[j].w * rstd * gg.w);
        *(u32x2*)(hn + (size_t)R * D + j * 256 + lane * 4) = o;
    }
}

struct EpiProj { bf16* proj; __device__ void operator()(int m, int n, float v) const { proj[(size_t)m * DINP + n] = f2bf(v); } };
struct EpiQraw { float* q; __device__ void operator()(int m, int n, float v) const { if (m < M) q[(size_t)m * 1536 + n] = v; } };
struct EpiKV {
    bf16* kn; bf16* vv;
    __device__ void operator()(int R, int n, float v) const {
        if (R >= MR) return;
        const int h = n >> 8, part = (n >> 7) & 1, d = n & 127;
        bf16* dst = kn + (size_t)part * ((WS_V - WS_KN) / 2); const bf16 o = f2bf(v);
        if (R < M) { const int b = R / S, pos = (R % S) + NMETA; dst[((size_t)(b * LP + pos) * NH + h) * 128 + d] = o; }
        else { const int pos = R - M; dst[((size_t)(0 * LP + pos) * NH + h) * 128 + d] = o; dst[((size_t)(1 * LP + pos) * NH + h) * 128 + d] = o; }
    }
};
struct EpiWout { const float* x; float* h1; __device__ void operator()(int m, int n, float v) const { h1[(size_t)m * D + n] = x[(size_t)m * D + n] + v; } };

template <class Epi>
__device__ __forceinline__ void gemm_simple(const Ctx& c, const bf16* __restrict__ A, int lda, const bf16* __restrict__ Bt, int ldb, int K, int nMt, int nNt, const Epi& epi) {
    const int r = c.lane & 15, q = c.lane >> 4;
    for (int wt = c.gw; wt < nMt * nNt; wt += c.NGW) {
        const int m0 = (wt / nNt) * 32, n0 = (wt % nNt) * 32;
        f32x4 acc[2][2];
#pragma unroll
        for (int i = 0; i < 2; ++i)
#pragma unroll
            for (int j = 0; j < 2; ++j) acc[i][j] = (f32x4){0.f, 0.f, 0.f, 0.f};
        const bf16* a0 = A + (size_t)(m0 + r) * lda + 8 * q; const bf16* b0 = Bt + (size_t)(n0 + r) * ldb + 8 * q;
#pragma unroll 2
        for (int k0 = 0; k0 < K; k0 += 32) {
            bf16x8 a[2], b[2];
#pragma unroll
            for (int i = 0; i < 2; ++i) { a[i] = *(const bf16x8*)(a0 + (size_t)i * 16 * lda + k0); b[i] = *(const bf16x8*)(b0 + (size_t)i * 16 * ldb + k0); }
#pragma unroll
            for (int i = 0; i < 2; ++i)
#pragma unroll
                for (int j = 0; j < 2; ++j) acc[i][j] = __builtin_amdgcn_mfma_f32_16x16x32_bf16(a[i], b[j], acc[i][j], 0, 0, 0);
        }
#pragma unroll
        for (int i = 0; i < 2; ++i)
#pragma unroll
            for (int j = 0; j < 2; ++j)
#pragma unroll
                for (int t = 0; t < 4; ++t) epi(m0 + i * 16 + q * 4 + t, n0 + j * 16 + r, acc[i][j][t]);
    }
}

__device__ __forceinline__ float inv_freq(int i) { return powf(10000.0f, -(float)i / 32.0f); }

__device__ __forceinline__ void postproj_row(int R, int lane, const bf16* __restrict__ proj, const float* __restrict__ conv_w, const float* __restrict__ g_conv,
                                             const float* __restrict__ g_q, const float* __restrict__ g_kv,
                                             bf16* __restrict__ mixed, bf16* __restrict__ qn, bf16* __restrict__ kvn, bf16* __restrict__ kpe) {
    const bf16* pr = proj + (size_t)R * DINP;
    const bool meta = R >= M; const int b = meta ? 0 : R / S, t = meta ? 0 : R % S, pos = meta ? R - M : t + NMETA;
    {
        const u32x2 w = *(const u32x2*)(pr + O_KV + lane * 4);
        float f[4] = {__uint_as_float(w.x << 16), __uint_as_float(w.x & 0xffff0000u), __uint_as_float(w.y << 16), __uint_as_float(w.y & 0xffff0000u)};
        const float ss = wave_sum(f[0] * f[0] + f[1] * f[1] + f[2] * f[2] + f[3] * f[3]);
        const float rstd = rsqrtf(ss * (1.f / KVL) + EPS);
        const f32x4 g = *(const f32x4*)(g_kv + lane * 4);
        u32x2 o; o.x = pk2(f[0] * rstd * g.x, f[1] * rstd * g.y); o.y = pk2(f[2] * rstd * g.z, f[3] * rstd * g.w);
        *(u32x2*)(kvn + (size_t)R * KVL + lane * 4) = o;
    }
    if (lane < 32) {
        const float x1 = bf2f(pr[O_R + lane]), x2 = bf2f(pr[O_R + 32 + lane]);
        const float ang = (float)pos * inv_freq(lane); const float cs = cosf(ang), sn = sinf(ang);
        const bf16 o1 = f2bf(x1 * cs - x2 * sn), o2 = f2bf(x1 * sn + x2 * cs);
        if (!meta) { bf16* d = kpe + (size_t)(b * LP + pos) * ROPE; d[lane] = o1; d[32 + lane] = o2; }
        else { bf16* d0 = kpe + (size_t)(0 * LP + pos) * ROPE; bf16* d1 = kpe + (size_t)(1 * LP + pos) * ROPE; d0[lane] = o1; d0[32 + lane] = o2; d1[lane] = o1; d1[32 + lane] = o2; }
    }
    if (meta) return;
    {
        float f[8]; unpack8(*(const u32x4*)(pr + O_Q + lane * 8), f);
        float ss = 0.f;
#pragma unroll
        for (int i = 0; i < 8; ++i) ss += f[i] * f[i];
        const float rstd = rsqrtf(wave_sum(ss) * (1.f / QL) + EPS);
        const f32x4 g0 = *(const f32x4*)(g_q + lane * 8), g1 = *(const f32x4*)(g_q + lane * 8 + 4);
        u32x4 o; o.x = pk2(f[0] * rstd * g0.x, f[1] * rstd * g0.y); o.y = pk2(f[2] * rstd * g0.z, f[3] * rstd * g0.w);
        o.z = pk2(f[4] * rstd * g1.x, f[5] * rstd * g1.y); o.w = pk2(f[6] * rstd * g1.z, f[7] * rstd * g1.w);
        *(u32x4*)(qn + (size_t)R * QL + lane * 8) = o;
    }
    {
        const int r1 = (t >= 1) ? R - 1 : M + 15, r2 = (t >= 2) ? R - 2 : (t == 1 ? M + 15 : M + 14);
        const bf16* p1 = proj + (size_t)r1 * DINP; const bf16* p2 = proj + (size_t)r2 * DINP;
        const int c0 = lane * 16;
        float v[16]; float ss = 0.f;
#pragma unroll
        for (int hh = 0; hh < 2; ++hh) {
            const int c = c0 + hh * 8;
            float bg[8], cg0[8], ui0[8], cg1[8], ui1[8], cg2[8], ui2[8];
            unpack8(*(const u32x4*)(pr + c), bg); unpack8(*(const u32x4*)(pr + O_C + c), cg0); unpack8(*(const u32x4*)(pr + O_U + c), ui0);
            unpack8(*(const u32x4*)(p1 + O_C + c), cg1); unpack8(*(const u32x4*)(p1 + O_U + c), ui1);
            unpack8(*(const u32x4*)(p2 + O_C + c), cg2); unpack8(*(const u32x4*)(p2 + O_U + c), ui2);
#pragma unroll
            for (int i = 0; i < 8; ++i) {
                const float y = conv_w[2 * DCONV + c + i] * (cg0[i] * ui0[i]) + conv_w[1 * DCONV + c + i] * (cg1[i] * ui1[i]) + conv_w[0 * DCONV + c + i] * (cg2[i] * ui2[i]);
                const float o = bg[i] * y; v[hh * 8 + i] = o; ss += o * o;
            }
        }
        ss += __shfl_xor(ss, 1); ss += __shfl_xor(ss, 2);
        const float rstd = rsqrtf(ss * (1.f / 64.f) + EPS);
#pragma unroll
        for (int hh = 0; hh < 2; ++hh) {
            const int c = c0 + hh * 8;
            const f32x4 g0 = *(const f32x4*)(g_conv + c), g1 = *(const f32x4*)(g_conv + c + 4);
            u32x4 o; o.x = pk2(v[hh * 8 + 0] * rstd * g0.x, v[hh * 8 + 1] * rstd * g0.y); o.y = pk2(v[hh * 8 + 2] * rstd * g0.z, v[hh * 8 + 3] * rstd * g0.w);
            o.z = pk2(v[hh * 8 + 4] * rstd * g1.x, v[hh * 8 + 5] * rstd * g1.y); o.w = pk2(v[hh * 8 + 6] * rstd * g1.z, v[hh * 8 + 7] * rstd * g1.w);
            *(u32x4*)(mixed + (size_t)R * D + c) = o;
        }
    }
}

__device__ __forceinline__ void rope_q_row(int m, int lane, const float* __restrict__ qraw, bf16* __restrict__ Q) {
    const int pos = (m % S) + NMETA;
    float cs = 0.f, sn = 0.f;
    if (lane < 32) { const float ang = (float)pos * inv_freq(lane); cs = cosf(ang); sn = sinf(ang); }
    for (int h = 0; h < NH; ++h) {
        const float* src = qraw + (size_t)m * 1536 + h * DQK; bf16* dst = Q + ((size_t)m * NH + h) * DQK;
        dst[lane] = f2bf(src[lane]); dst[64 + lane] = f2bf(src[64 + lane]);
        if (lane < 32) { const float x1 = src[128 + lane], x2 = src[160 + lane]; dst[128 + lane] = f2bf(x1 * cs - x2 * sn); dst[160 + lane] = f2bf(x1 * sn + x2 * cs); }
    }
}

__device__ __forceinline__ void attn_simple_row(int wid, int lane, const bf16* __restrict__ Q, const bf16* __restrict__ Kn, const bf16* __restrict__ Kpe, const bf16* __restrict__ V,
                                                const float* __restrict__ g_attn, bf16* __restrict__ mixed) {
    const int m = wid / NH, h = wid % NH, b = m / S, pos = (m % S) + NMETA;
    const bf16* q = Q + ((size_t)m * NH + h) * DQK;
    const float scale = 0.07216878364870322f;
    const float q0 = bf2f(q[lane]) * scale, q1 = bf2f(q[64 + lane]) * scale, q2 = bf2f(q[128 + lane]) * scale;
    const bf16* kn = Kn + ((size_t)b * LP * NH + h) * 128; const bf16* vv = V + ((size_t)b * LP * NH + h) * 128; const bf16* kp = Kpe + (size_t)b * LP * ROPE;
    float mx = -INFINITY, sum = 0.f, o0 = 0.f, o1 = 0.f;
    for (int j = 0; j <= pos; j += 4) {
        float s[4], v0[4], v1[4];
#pragma unroll
        for (int u = 0; u < 4; ++u) {
            const size_t ro = (size_t)(j + u) * NH * 128;
            s[u] = q0 * bf2f(kn[ro + lane]) + q1 * bf2f(kn[ro + 64 + lane]) + q2 * bf2f(kp[(size_t)(j + u) * ROPE + lane]);
            v0[u] = bf2f(vv[ro + lane]); v1[u] = bf2f(vv[ro + 64 + lane]);
        }
#pragma unroll
        for (int o = 1; o < 64; o <<= 1) {
#pragma unroll
            for (int u = 0; u < 4; ++u) s[u] += __shfl_xor(s[u], o);
        }
#pragma unroll
        for (int u = 0; u < 4; ++u) if (j + u > pos) s[u] = -INFINITY;
        const float mn = fmaxf(fmaxf(mx, fmaxf(s[0], s[1])), fmaxf(s[2], s[3]));
        const float corr = __expf(mx - mn);
        sum *= corr; o0 *= corr; o1 *= corr;
#pragma unroll
        for (int u = 0; u < 4; ++u) { const float p = __expf(s[u] - mn); sum += p; o0 += p * v0[u]; o1 += p * v1[u]; }
        mx = mn;
    }
    const float inv = 1.f / sum; o0 *= inv; o1 *= inv;
    const float ss = wave_sum(o0 * o0 + o1 * o1);
    const float rstd = rsqrtf(ss * (1.f / 128.f) + EPS);
    bf16* dst = mixed + (size_t)m * D + DCONV + h * DV;
    dst[lane] = f2bf(o0 * rstd * g_attn[h * DV + lane]); dst[64 + lane] = f2bf(o1 * rstd * g_attn[h * DV + 64 + lane]);
}

__device__ __forceinline__ void router_row(int m, int lane, const float* __restrict__ h1, const float* __restrict__ g_ffn, const float* __restrict__ w_r, const float* __restrict__ b_r,
                                           bf16* __restrict__ xn, unsigned* __restrict__ cnt, int* __restrict__ rowtok, int* __restrict__ tok_e, int* __restrict__ tok_p, float* __restrict__ gate) {
    const float* src = h1 + (size_t)m * D;
    float ss = 0.f;
#pragma unroll
    for (int j = 0; j < 8; ++j) { const f32x4 t = *(const f32x4*)(src + j * 256 + lane * 4); ss += t.x * t.x + t.y * t.y + t.z * t.z + t.w * t.w; }
    const float rstd = rsqrtf(wave_sum(ss) * (1.f / D) + EPS);
    float acc[32];
#pragma unroll
    for (int e = 0; e < 32; ++e) acc[e] = 0.f;
#pragma unroll 1
    for (int j = 0; j < 8; ++j) {
        const f32x4 vv = *(const f32x4*)(src + j * 256 + lane * 4);
        const f32x4 gg = *(const f32x4*)(g_ffn + j * 256 + lane * 4);
        const float xv[4] = {vv.x * rstd * gg.x, vv.y * rstd * gg.y, vv.z * rstd * gg.z, vv.w * rstd * gg.w};
        u32x2 o; o.x = pk2(xv[0], xv[1]); o.y = pk2(xv[2], xv[3]);
        *(u32x2*)(xn + (size_t)m * D + j * 256 + lane * 4) = o;
#pragma unroll
        for (int i = 0; i < 4; ++i) {
            const float* wr = w_r + (size_t)(j * 256 + lane * 4 + i) * NE;
#pragma unroll
            for (int e4 = 0; e4 < 8; ++e4) { const f32x4 w = *(const f32x4*)(wr + e4 * 4);
                acc[e4 * 4 + 0] += xv[i] * w.x; acc[e4 * 4 + 1] += xv[i] * w.y; acc[e4 * 4 + 2] += xv[i] * w.z; acc[e4 * 4 + 3] += xv[i] * w.w; }
        }
    }
    float logit = -INFINITY;
#pragma unroll
    for (int e = 0; e < 32; ++e) { const float tot = wave_sum(acc[e]) + b_r[e]; if (lane == e) logit = tot; }
    float tv[4]; int ti[4];
#pragma unroll
    for (int k = 0; k < 4; ++k) {
        const float mxv = wave_max(logit);
        const unsigned long long mask = __ballot(logit == mxv);
        const int idx = __ffsll((long long)mask) - 1;
        tv[k] = mxv; ti[k] = idx;
        if (lane == idx) logit = -INFINITY;
    }
    float ex[4]; float es = 0.f;
#pragma unroll
    for (int k = 0; k < 4; ++k) { ex[k] = expf(tv[k] - tv[0]); es += ex[k]; }
    if (lane == 0) {
#pragma unroll
        for (int k = 0; k < 4; ++k) {
            const unsigned p = atomicAdd(&cnt[ti[k]], 1u);
            rowtok[ti[k] * M + p] = m; tok_e[m * 4 + k] = ti[k]; tok_p[m * 4 + k] = (int)p; gate[m * 4 + k] = ex[k] / es;
        }
    }
}

__device__ __forceinline__ bool expert_of_row(const unsigned* cnt, int row0, int& e_out, int& local0, int& n_out, int& off_out) {
    int off = 0;
    for (int e = 0; e < NE; ++e) { const int n = (int)cnt[e], p = (n + 255) / 256 * 256; if (row0 < off + p) { e_out = e; local0 = row0 - off; n_out = n; off_out = off; return true; } off += p; }
    return false;
}
__device__ __forceinline__ void moe1_simple(const Ctx& cx, const bf16* __restrict__ xn, const bf16* __restrict__ Wgu, const float* __restrict__ b_gu, const unsigned* __restrict__ cnt,
                                            const int* __restrict__ rowtok, bf16* __restrict__ act) {
    const int r = cx.lane & 15, q = cx.lane >> 4;
    constexpr int nNt = DFF / 32;
    for (int wt = cx.gw; wt < (RP / 32) * nNt; wt += cx.NGW) {
        int e, lm0, n, off;
        if (!expert_of_row(cnt, (wt / nNt) * 32, e, lm0, n, off)) break;
        if (lm0 >= n) continue;
        const int c0 = (wt % nNt) * 32;
        const bf16* Wt = Wgu + (size_t)e * 4096 * D;
        const bf16* ap[2]; const bf16* bg[2];
#pragma unroll
        for (int i = 0; i < 2; ++i) { const int li = lm0 + i * 16 + r; const int tok = li < n ? rowtok[e * M + li] : rowtok[e * M]; ap[i] = xn + (size_t)tok * D + 8 * q; }
#pragma unroll
        for (int j = 0; j < 2; ++j) { const int c = c0 + j * 16 + r; const int ng = 256 * (c >> 7) + (c & 127); bg[j] = Wt + (size_t)ng * D + 8 * q; }
        f32x4 ag[2][2], al[2][2];
#pragma unroll
        for (int i = 0; i < 2; ++i)
#pragma unroll
            for (int j = 0; j < 2; ++j) { ag[i][j] = (f32x4){0.f, 0.f, 0.f, 0.f}; al[i][j] = (f32x4){0.f, 0.f, 0.f, 0.f}; }
#pragma unroll 2
        for (int k0 = 0; k0 < D; k0 += 32) {
            bf16x8 a[2], wg[2], wl[2];
#pragma unroll
            for (int i = 0; i < 2; ++i) { a[i] = *(const bf16x8*)(ap[i] + k0); wg[i] = *(const bf16x8*)(bg[i] + k0); wl[i] = *(const bf16x8*)(bg[i] + (size_t)128 * D + k0); }
#pragma unroll
            for (int i = 0; i < 2; ++i)
#pragma unroll
                for (int j = 0; j < 2; ++j) { ag[i][j] = __builtin_amdgcn_mfma_f32_16x16x32_bf16(a[i], wg[j], ag[i][j], 0, 0, 0); al[i][j] = __builtin_amdgcn_mfma_f32_16x16x32_bf16(a[i], wl[j], al[i][j], 0, 0, 0); }
        }
        const float* bias = b_gu + (size_t)e * 4096;
#pragma unroll
        for (int i = 0; i < 2; ++i)
#pragma unroll
            for (int j = 0; j < 2; ++j)
#pragma unroll
                for (int t = 0; t < 4; ++t) {
                    const int li = lm0 + i * 16 + q * 4 + t, c = c0 + j * 16 + r;
                    if (li < n) {
                        const float g = fminf(ag[i][j][t] + bias[c], 7.0f);
                        const float l = fminf(fmaxf(al[i][j][t] + bias[2048 + c], -7.0f), 7.0f);
                        const float a = (l + 1.0f) * (g / (1.0f + expf(-1.702f * g)));
                        act[(size_t)(off + li) * DFF + c] = f2bf(a);
                    }
                }
    }
}
__device__ __forceinline__ void moe2_simple(const Ctx& cx, const bf16* __restrict__ act, const bf16* __restrict__ Wd, const float* __restrict__ b_d, const unsigned* __restrict__ cnt, bf16* __restrict__ y) {
    const int r = cx.lane & 15, q = cx.lane >> 4;
    constexpr int nNt = D / 32;
    for (int wt = cx.gw; wt < (RP / 32) * nNt; wt += cx.NGW) {
        int e, lm0, n, off;
        if (!expert_of_row(cnt, (wt / nNt) * 32, e, lm0, n, off)) break;
        if (lm0 >= n) continue;
        const int n0 = (wt % nNt) * 32;
        const bf16* Wt = Wd + (size_t)e * D * DFF;
        const bf16* a0 = act + (size_t)(off + lm0 + r) * DFF + 8 * q; const bf16* b0 = Wt + (size_t)(n0 + r) * DFF + 8 * q;
        f32x4 acc[2][2];
#pragma unroll
        for (int i = 0; i < 2; ++i)
#pragma unroll
            for (int j = 0; j < 2; ++j) acc[i][j] = (f32x4){0.f, 0.f, 0.f, 0.f};
#pragma unroll 2
        for (int k0 = 0; k0 < DFF; k0 += 32) {
            bf16x8 a[2], b[2];
#pragma unroll
            for (int i = 0; i < 2; ++i) { a[i] = *(const bf16x8*)(a0 + (size_t)i * 16 * DFF + k0); b[i] = *(const bf16x8*)(b0 + (size_t)i * 16 * DFF + k0); }
#pragma unroll
            for (int i = 0; i < 2; ++i)
#pragma unroll
                for (int j = 0; j < 2; ++j) acc[i][j] = __builtin_amdgcn_mfma_f32_16x16x32_bf16(a[i], b[j], acc[i][j], 0, 0, 0);
        }
        const float* bias = b_d + (size_t)e * D;
#pragma unroll
        for (int i = 0; i < 2; ++i)
#pragma unroll
            for (int j = 0; j < 2; ++j)
#pragma unroll
                for (int t = 0; t < 4; ++t) { const int li = lm0 + i * 16 + q * 4 + t, c = n0 + j * 16 + r; if (li < n) y[(size_t)(off + li) * D + c] = f2bf(acc[i][j][t] + bias[c]); }
    }
}

__device__ __forceinline__ void combine_row(int m, int lane, const float* __restrict__ h1, const bf16* __restrict__ y, const unsigned* __restrict__ cnt, const int* __restrict__ tok_e, const int* __restrict__ tok_p,
                                            const float* __restrict__ gate, const float* __restrict__ g_final, float* __restrict__ out) {
    size_t yrow[4]; float gk[4];
#pragma unroll
    for (int k = 0; k < 4; ++k) {
        const int e = tok_e[m * 4 + k]; int off = 0;
        for (int e2 = 0; e2 < e; ++e2) off += ((int)cnt[e2] + 255) / 256 * 256;
        yrow[k] = (size_t)(off + tok_p[m * 4 + k]) * D; gk[k] = gate[m * 4 + k];
    }
    f32x4 v[8]; float ss = 0.f;
#pragma unroll
    for (int j = 0; j < 8; ++j) {
        const int idx = j * 256 + lane * 4;
        f32x4 a = *(const f32x4*)(h1 + (size_t)m * D + idx);
#pragma unroll
        for (int k = 0; k < 4; ++k) { const u32x2 w = *(const u32x2*)(y + yrow[k] + idx);
            a.x += gk[k] * __uint_as_float(w.x << 16); a.y += gk[k] * __uint_as_float(w.x & 0xffff0000u); a.z += gk[k] * __uint_as_float(w.y << 16); a.w += gk[k] * __uint_as_float(w.y & 0xffff0000u); }
        v[j] = a; ss += a.x * a.x + a.y * a.y + a.z * a.z + a.w * a.w;
    }
    const float rstd = rsqrtf(wave_sum(ss) * (1.f / D) + EPS);
#pragma unroll
    for (int j = 0; j < 8; ++j) { const int idx = j * 256 + lane * 4; const f32x4 gg = *(const f32x4*)(g_final + idx);
        *(f32x4*)(out + (size_t)m * D + idx) = (f32x4){v[j].x * rstd * gg.x, v[j].y * rstd * gg.y, v[j].z * rstd * gg.z, v[j].w * rstd * gg.w}; }
}

constexpr int NPHASE = 10;
struct Args { const float* in[20]; float* out; unsigned char* ws; int ph_lo, ph_hi; };
__global__ void __launch_bounds__(NWAVES * 64, 2) mk_fwd(Args a) {
    extern __shared__ __attribute__((aligned(16))) unsigned char lds_raw[];
    Ctx c;
    c.lds = (LAS unsigned char*)lds_raw;
    c.tid = threadIdx.x; c.lane = c.tid & 63; c.wave = __builtin_amdgcn_readfirstlane(c.tid >> 6);
    c.G = gridDim.x; c.wg = blockIdx.x; c.gw = c.wg * NWAVES + c.wave; c.NGW = c.G * NWAVES;
    volatile LAS unsigned* MISC = (volatile LAS unsigned*)(c.lds + MISC_OFF);
    if (c.tid < 32) MISC[c.tid] = 0u;
    __syncthreads();
    unsigned char* ws = a.ws;
    unsigned* ctl = (unsigned*)(ws + WS_CTL);
    XcdBarrier bar = xcd_barrier_post(ctl + CW_BAR, MISC + 8);
    const float* x = a.in[0]; const float* meta = a.in[1]; const float* g_mix = a.in[2]; const float* w_in = a.in[3];
    const float* conv_w = a.in[4]; const float* g_q = a.in[5]; const float* w_q_up = a.in[6]; const float* g_kv = a.in[7];
    const float* w_kv_up = a.in[8]; const float* g_conv = a.in[9]; const float* g_attn = a.in[10]; const float* w_out = a.in[11];
    const float* g_ffn = a.in[12]; const float* w_router = a.in[13]; const float* b_router = a.in[14]; const float* w_gu = a.in[15];
    const float* b_gu = a.in[16]; const float* w_d = a.in[17]; const float* b_d = a.in[18]; const float* g_final = a.in[19];
    bf16* Win = (bf16*)(ws + WS_WIN); bf16* Wq = (bf16*)(ws + WS_WQ); bf16* Wkv = (bf16*)(ws + WS_WKV); bf16* Wout = (bf16*)(ws + WS_WOUT); bf16* Wgu = (bf16*)(ws + WS_WGU); bf16* Wd = (bf16*)(ws + WS_WD);
    bf16* hn = (bf16*)(ws + WS_HN); bf16* proj = (bf16*)(ws + WS_PROJ); bf16* mixed = (bf16*)(ws + WS_MIXED); bf16* qn = (bf16*)(ws + WS_QN); bf16* kvn = (bf16*)(ws + WS_KVN);
    float* qraw = (float*)(ws + WS_QRAW); bf16* Q = (bf16*)(ws + WS_Q); bf16* Kn = (bf16*)(ws + WS_KN); bf16* V = (bf16*)(ws + WS_V); bf16* Kpe = (bf16*)(ws + WS_KPE);
    float* h1 = (float*)(ws + WS_H1); bf16* xn = (bf16*)(ws + WS_XN); int* tok_e = (int*)(ws + WS_TOKE); int* tok_p = (int*)(ws + WS_TOKP); float* gate = (float*)(ws + WS_GATE);
    int* rowtok = (int*)(ws + WS_ROWTOK); bf16* act = (bf16*)(ws + WS_ACT); bf16* y = (bf16*)(ws + WS_Y);
    unsigned* cnt = ctl + CW_CNT;

    const int lo = a.ph_lo, hi = a.ph_hi;
#define IN(k) (lo <= (k) && (k) < hi)
#define SEAM(k) do { if (IN(k) && IN((k) + 1)) xcd_barrier(bar); } while (0)

    if (IN(0)) {
        transpose_all<0>(c, w_in, D, DIN, DINP, 1, Win);
        for (int i = c.gw * 64 + c.lane; i < (DINP - DIN) * D / 8; i += c.NGW * 64) ((u32x4*)(Win + (size_t)DIN * D))[i] = (u32x4){0u, 0u, 0u, 0u};
        transpose_all<0>(c, w_q_up, QL, 1536, 1536, 1, Wq);
        transpose_all<0>(c, w_kv_up, KVL, 2048, 2048, 1, Wkv);
        transpose_all<0>(c, w_out, D, D, D, 1, Wout);
        transpose_all<1>(c, w_gu, D, 4096, 4096, NE, Wgu);
        transpose_all<0>(c, w_d, DFF, D, D, NE, Wd);
        for (int R = c.gw; R < MR; R += c.NGW) norm1_row(R, c.lane, x, meta, g_mix, hn);
    }
    SEAM(0);
    if (IN(1)) gemm_simple(c, hn, D, Win, D, D, MRP / 32, DINP / 32, EpiProj{proj});
    SEAM(1);
    if (IN(2)) { for (int R = c.gw; R < MR; R += c.NGW) postproj_row(R, c.lane, proj, conv_w, g_conv, g_q, g_kv, mixed, qn, kvn, Kpe); }
    SEAM(2);
    if (IN(3)) { gemm_simple(c, qn, QL, Wq, QL, QL, M / 32, 1536 / 32, EpiQraw{qraw}); gemm_simple(c, kvn, KVL, Wkv, KVL, KVL, MRP / 32, 2048 / 32, EpiKV{Kn, V}); }
    SEAM(3);
    if (IN(4)) { for (int m = c.gw; m < M; m += c.NGW) rope_q_row(m, c.lane, qraw, Q); }
    SEAM(4);
    if (IN(5)) { for (int w = c.gw; w < M * NH; w += c.NGW) attn_simple_row(w, c.lane, Q, Kn, Kpe, V, g_attn, mixed); }
    SEAM(5);
    if (IN(6)) gemm_simple(c, mixed, D, Wout, D, D, M / 32, D / 32, EpiWout{x, h1});
    SEAM(6);
    if (IN(7)) { for (int m = c.gw; m < M; m += c.NGW) router_row(m, c.lane, h1, g_ffn, w_router, b_router, xn, cnt, rowtok, tok_e, tok_p, gate); }
    SEAM(7);
    if (IN(8)) moe1_simple(c, xn, Wgu, b_gu, cnt, rowtok, act);
    SEAM(8);
    if (IN(9)) moe2_simple(c, act, Wd, b_d, cnt, y);
    SEAM(9);
    if (IN(10)) { for (int m = c.gw; m < M; m += c.NGW) combine_row(m, c.lane, h1, y, cnt, tok_e, tok_p, gate, g_final, a.out); }
#undef IN
#undef SEAM
}

extern "C" void kernel_launch(void* const* d_in, const int* in_sizes, int n_in, void* d_out, int out_size, void* d_ws, size_t ws_size, hipStream_t stream) {
    static int grid = 0;
    if (grid == 0) {
        if (n_in != 20 || ws_size < WS_END) { fprintf(stderr, "kernel_launch: unexpected n_in %d / ws %zu (need %zu)\n", n_in, ws_size, (size_t)WS_END); grid = -1; return; }
        int dev = 0, cus = 0, per_cu = 0;
        if (hipGetDevice(&dev) != hipSuccess || hipDeviceGetAttribute(&cus, hipDeviceAttributeMultiprocessorCount, dev) != hipSuccess) { grid = -1; return; }
        if (hipFuncSetAttribute((const void*)mk_fwd, hipFuncAttributeMaxDynamicSharedMemorySize, LDS_BYTES) != hipSuccess) { fprintf(stderr, "kernel_launch: hipFuncSetAttribute failed\n"); grid = -1; return; }
        if (hipOccupancyMaxActiveBlocksPerMultiprocessor(&per_cu, (const void*)mk_fwd, NWAVES * 64, LDS_BYTES) != hipSuccess || per_cu < 1) { fprintf(stderr, "kernel_launch: occupancy query says %d\n", per_cu); (void)hipGetLastError(); grid = -1; return; }
        grid = cus;
    }
    if (grid < 0) return;
    if (hipMemsetAsync((char*)d_ws + WS_CTL, 0, CTL_BYTES, stream) != hipSuccess) return;
    Args a{};
    for (int i = 0; i < 20; ++i) a.in[i] = (const float*)d_in[i];
    a.out = (float*)d_out; a.ws = (unsigned char*)d_ws; a.ph_lo = 0; a.ph_hi = NPHASE + 1;
    hipLaunchKernelGGL(mk_fwd, dim3(grid), dim3(NWAVES * 64), LDS_BYTES, stream, a);
}
```

```cpp
#include <hip/hip_runtime.h>
#include <cstdint>
#include <cstdio>

typedef unsigned short bf16;
typedef short bf16x8 __attribute__((ext_vector_type(8)));
typedef float f32x4 __attribute__((ext_vector_type(4)));
typedef unsigned u32x4 __attribute__((ext_vector_type(4)));
typedef unsigned u32x2 __attribute__((ext_vector_type(2)));

constexpr int D = 2048, NB = 2, S = 4096, NMETA = 16, M = NB * S;
constexpr int MR = M + NMETA;
constexpr int MRP = 8256;
constexpr int DCONV = 1024, QL = 512, KVL = 256, ROPE = 64, NH = 8, DN = 128, DV = 128, DQK = 192;
constexpr int DIN = 3904, DINP = 4096;
constexpr int O_C = 1024, O_U = 2048, O_Q = 3072, O_KV = 3584, O_R = 3840;
constexpr int NE = 32, TOPK = 4, DFF = 2048;
constexpr int LP = 4224;
constexpr int RP = 41216;
constexpr float EPS = 1e-6f;

constexpr size_t MiB = 1u << 20;
constexpr size_t WS_CTL = 0, CTL_BYTES = 1 * MiB;
constexpr size_t WS_WIN = 2 * MiB;
constexpr size_t WS_WQ = WS_WIN + 16 * MiB;
constexpr size_t WS_WKV = WS_WQ + 2 * MiB;
constexpr size_t WS_WOUT = WS_WKV + 2 * MiB;
constexpr size_t WS_WGU = WS_WOUT + 8 * MiB;
constexpr size_t WS_WD = WS_WGU + 512 * MiB;
constexpr size_t WS_HN = WS_WD + 256 * MiB;
constexpr size_t WS_PROJ = WS_HN + 34 * MiB;
constexpr size_t WS_MIXED = WS_PROJ + 66 * MiB;
constexpr size_t WS_QN = WS_MIXED + 32 * MiB;
constexpr size_t WS_KVN = WS_QN + 8 * MiB;
constexpr size_t WS_QRAW = WS_KVN + 6 * MiB;
constexpr size_t WS_Q = WS_QRAW + 48 * MiB;
constexpr size_t WS_KN = WS_Q + 24 * MiB;
constexpr size_t WS_V = WS_KN + 18 * MiB;
constexpr size_t WS_KPE = WS_V + 18 * MiB;
constexpr size_t WS_H1 = WS_KPE + 2 * MiB;
constexpr size_t WS_XN = WS_H1 + 64 * MiB;
constexpr size_t WS_TOKE = WS_XN + 32 * MiB;
constexpr size_t WS_TOKP = WS_TOKE + 1 * MiB;
constexpr size_t WS_GATE = WS_TOKP + 1 * MiB;
constexpr size_t WS_ROWTOK = WS_GATE + 1 * MiB;
constexpr size_t WS_ACT = WS_ROWTOK + 1 * MiB;
constexpr size_t WS_Y = WS_ACT + 162 * MiB;
constexpr size_t WS_END = WS_Y + 162 * MiB;
constexpr int CW_CNT = 64;
constexpr int CW_BAR = 4096;

__device__ __forceinline__ float bf2f(bf16 v) { return __uint_as_float((unsigned)v << 16); }
__device__ __forceinline__ bf16 f2bf(float f) { unsigned u = __float_as_uint(f); return (bf16)((u + 0x7fffu + ((u >> 16) & 1u)) >> 16); }
__device__ __forceinline__ float wave_sum(float v) {
#pragma unroll
    for (int o = 1; o < 64; o <<= 1) v += __shfl_xor(v, o);
    return v;
}
__device__ __forceinline__ float wave_max(float v) {
#pragma unroll
    for (int o = 1; o < 64; o <<= 1) v = fmaxf(v, __shfl_xor(v, o));
    return v;
}
__device__ __forceinline__ void unpack8(const u32x4 w, float (&f)[8]) {
    f[0] = __uint_as_float(w.x << 16); f[1] = __uint_as_float(w.x & 0xffff0000u);
    f[2] = __uint_as_float(w.y << 16); f[3] = __uint_as_float(w.y & 0xffff0000u);
    f[4] = __uint_as_float(w.z << 16); f[5] = __uint_as_float(w.z & 0xffff0000u);
    f[6] = __uint_as_float(w.w << 16); f[7] = __uint_as_float(w.w & 0xffff0000u);
}
__device__ __forceinline__ unsigned pk2(float lo, float hi) { return (unsigned)f2bf(lo) | ((unsigned)f2bf(hi) << 16); }


#define GAS __attribute__((address_space(1)))
#define LAS __attribute__((address_space(3)))
#define LDS_WAIT() asm volatile("s_waitcnt lgkmcnt(0)" ::: "memory")
#define VM_WAIT() asm volatile("s_waitcnt vmcnt(0)" ::: "memory")
constexpr int NWAVES = 8;
constexpr int LDS_BYTES = 147456;
constexpr int RING_BYTES = 131072, MISC_OFF = RING_BYTES + 320;

#define XB_TMO      128
#define XB_XCNT(j)  (256  + 64 * (j))
#define XB_XSUB(j)  (1280 + 64 * (j))
#define XB_XGEN(j)  (2304 + 64 * (j))
#define XB_TOP      3328
#define XB_TOPGEN   3392
#define XCD_BAR_WORDS 3456
#define XB_SPIN_CAP (1u << 18)

__device__ __forceinline__ unsigned xb_ld(unsigned* p)              { return __hip_atomic_load(p, __ATOMIC_RELAXED, __HIP_MEMORY_SCOPE_AGENT); }
__device__ __forceinline__ unsigned xb_add(unsigned* p, unsigned v) { return __hip_atomic_fetch_add(p, v, __ATOMIC_RELAXED, __HIP_MEMORY_SCOPE_AGENT); }
__device__ __forceinline__ unsigned xb_xcc_id() { return (unsigned)__builtin_amdgcn_s_getreg((3 << 11) | 20) & 0xFu; }
#define XB_SPIN(cond, bar) do { unsigned _sp = 0; while (cond) { __builtin_amdgcn_s_sleep(1); \
    if ((++_sp & 255u) == 0u) { if (xb_ld(&(bar)[XB_TMO])) break; if (_sp > XB_SPIN_CAP) { atomicAdd(&(bar)[XB_TMO], 1u); break; } } } } while (0)

struct XcdBarrier {
    unsigned* bar; unsigned x;
    volatile LAS unsigned* st;
};
__device__ __forceinline__ XcdBarrier xcd_barrier_post(unsigned* bar, volatile LAS unsigned* st) {
    XcdBarrier b; b.bar = bar; b.x = xb_xcc_id(); b.st = st;
    if (threadIdx.x == 0) (void)xb_add(&bar[XB_XCNT(b.x)], 1u);
    return b;
}
__device__ __forceinline__ void xcd_barrier_complete(unsigned* bar, unsigned x, unsigned& nloc, unsigned& nx) {
    const unsigned G = gridDim.x * gridDim.y * gridDim.z;
    unsigned sum, cnt, mine, sp = 0u;
    for (;;) {
        sum = 0u; cnt = 0u; mine = 0u;
#pragma unroll
        for (unsigned j = 0; j < 16; ++j) { const unsigned c = xb_ld(&bar[XB_XCNT(j)]); sum += c; cnt += (c > 0u) ? 1u : 0u; mine = (j == x) ? c : mine; }
        if (sum == G) break;
        __builtin_amdgcn_s_sleep(1);
        if ((++sp & 255u) == 0u) { if (xb_ld(&bar[XB_TMO])) break; if (sp > XB_SPIN_CAP) { atomicAdd(&bar[XB_TMO], 1u); break; } }
    }
    nloc = mine > 0u ? mine : 1u; nx = cnt > 0u ? cnt : 1u;
}
__device__ __forceinline__ void xcd_barrier(const XcdBarrier& b) {
    asm volatile("s_waitcnt vmcnt(0)" ::: "memory");
    __syncthreads();
    if (threadIdx.x == 0) {
        unsigned* bar = b.bar;
        __builtin_amdgcn_s_waitcnt(0);
        unsigned nloc = b.st[0], nx = b.st[1];
        if (nloc == 0u) { xcd_barrier_complete(bar, b.x, nloc, nx); b.st[0] = nloc; b.st[1] = nx; }
        const unsigned old = xb_add(&bar[XB_XSUB(b.x)], 1u);
        const unsigned gen = old / nloc;
        if (old + 1u == (gen + 1u) * nloc) {
            __builtin_amdgcn_fence(__ATOMIC_RELEASE, "agent");
            asm volatile("s_waitcnt vmcnt(0)" ::: "memory");
            const unsigned og = xb_add(&bar[XB_TOP], 1u);
            const unsigned tg = og / nx;
            if (og + 1u == (tg + 1u) * nx) xb_add(&bar[XB_TOPGEN], 1u);
            else XB_SPIN(xb_ld(&bar[XB_TOPGEN]) == tg, bar);
            __builtin_amdgcn_fence(__ATOMIC_ACQUIRE, "agent");
            xb_add(&bar[XB_XGEN(b.x)], 1u);
            asm volatile("s_waitcnt vmcnt(0)" ::: "memory");
        } else {
            XB_SPIN(xb_ld(&bar[XB_XGEN(b.x)]) == gen, bar);
            __builtin_amdgcn_fence(__ATOMIC_ACQUIRE, "agent");
            asm volatile("s_waitcnt vmcnt(0)" ::: "memory");
        }
    }
    __syncthreads();
}

namespace pg8 {
constexpr int BM = 256, BK = 64, HALF = 128, HTB = HALF * BK * 2  , STAGE_BYTES = 8 * HTB, NXCD = 8, WGM = 8;
__host__ __device__ __forceinline__ int lds_byte(int r, int c) { const int st = (r >> 4) * 2 + (c >> 5), rr = r & 15, cc = c & 31, ob = rr * 64 + cc * 2; return st * 1024 + (ob ^ (((ob >> 9) & 1) << 5)); }
__host__ __device__ __forceinline__ void stage_rc(int b, int& R, int& C) { const int st = b / 1024, sb = b % 1024, swz = sb ^ (((sb >> 9) & 1) << 5); R = (st >> 1) * 16 + swz / 64; C = (st & 1) * 32 + (swz % 64) / 2; }
__host__ __device__ __forceinline__ int perm32(int rho) { const int n = rho >> 4, i = rho & 15; return 8 * (i >> 2) + 4 * n + (i & 3); }

struct Unit { int pm, pn, e, nrows; };
struct Gemm { const bf16* A; int K; };

__device__ __forceinline__ unsigned cvt_pk_bf16(float lo, float hi) { unsigned r; asm volatile("v_cvt_pk_bf16_f32 %0, %1, %2" : "=v"(r) : "v"(lo), "v"(hi)); return r; }

template <class Epi, class Sched, bool ALIGN_EPI>
__device__ __forceinline__ void gemm_phase(LAS unsigned char* lds, const Gemm g, const Sched& S, const Epi& E) {
    const int tid = threadIdx.x, wid = __builtin_amdgcn_readfirstlane(tid >> 6), lane = tid & 63, wr = wid >> 2, wc = wid & 3, fr = lane & 15, fq = lane >> 4;
    const int K = g.K, nt = K / BK;
    int sR[2], sC[2]; unsigned voffB[2];
#pragma unroll
    for (int i = 0; i < 2; ++i) { stage_rc(tid * 16 + i * 8192, sR[i], sC[i]); const int Rb = Epi::PERM ? ((sR[i] & ~31) + perm32(sR[i] & 31)) : sR[i]; voffB[i] = (unsigned)(Rb * K + sC[i]) * 2u; }
    const size_t kstep = (size_t)(BK * 2);
    const size_t hstep = (size_t)HALF * K * 2;
    const unsigned ldsw = (unsigned)wid * 1024u;
    const int aoff = lds_byte(wr * 64 + fr, fq * 8), boff = lds_byte(wc * 32 + fr, fq * 8);
    const char* Ab = (const char*)g.A;
#define PG8_SA(b, h) (((b) * 2 + (h)) * HTB)
#define PG8_SB(b, h) ((4 + (b) * 2 + (h)) * HTB)
#define PG8_STAGE(bufoff, gbase, voff) do { _Pragma("unroll") for (int _i = 0; _i < 2; ++_i) \
        __builtin_amdgcn_global_load_lds((const unsigned*)((const char*)(gbase) + (voff)[_i]), (LAS unsigned*)(lds + (bufoff) + ldsw + _i * 8192), 16, 0, 0); } while (0)
#define PG8_LDA(dst, b, h) do { _Pragma("unroll") for (int m = 0; m < 4; ++m) _Pragma("unroll") for (int k = 0; k < 2; ++k) dst[m][k] = *(const LAS bf16x8*)(lds + PG8_SA(b, h) + aoff + m * 2048 + k * 1024); } while (0)
#define PG8_LDB(dst, b, h) do { _Pragma("unroll") for (int n = 0; n < 2; ++n) _Pragma("unroll") for (int k = 0; k < 2; ++k) dst[n][k] = *(const LAS bf16x8*)(lds + PG8_SB(b, h) + boff + n * 2048 + k * 1024); } while (0)
#define PG8_MMA(ai, bj, At, Bt) do { __builtin_amdgcn_s_setprio(1); _Pragma("unroll") for (int m = 0; m < 4; ++m) _Pragma("unroll") for (int n = 0; n < 2; ++n) _Pragma("unroll") for (int k = 0; k < 2; ++k) \
        acc[ai][bj][m][n] = __builtin_amdgcn_mfma_f32_16x16x32_bf16(Bt[n][k], At[m][k], acc[ai][bj][m][n], 0, 0, 0); __builtin_amdgcn_s_setprio(0); } while (0)
#define PG8_WAIT_V(n) asm volatile("s_waitcnt vmcnt(" #n ")" ::: "memory")
#define PG8_WAIT_L(n) asm volatile("s_waitcnt lgkmcnt(" #n ")" ::: "memory")
#define PG8_BAR __builtin_amdgcn_s_barrier()
#define PG8_SCHED __builtin_amdgcn_sched_barrier(0)
    Unit cur, nxt; int ui = 0;
    if (!S.next(0, cur)) return;
    f32x4 acc[2][2][4][2];
#pragma unroll
    for (int a = 0; a < 2; ++a)
#pragma unroll
        for (int b = 0; b < 2; ++b)
#pragma unroll
            for (int m = 0; m < 4; ++m)
#pragma unroll
                for (int n = 0; n < 2; ++n) acc[a][b][m][n] = (f32x4){0.f, 0.f, 0.f, 0.f};
    bf16x8 At[4][2], B0[2][2], B1[2][2];
    unsigned ao[2][2], an[2][2];
    S.a_off(cur, sR, sC, ao);
    const char* cB = S.b_base(cur);
    PG8_STAGE(PG8_SB(0, 0), cB, voffB); PG8_STAGE(PG8_SB(0, 1), cB + hstep, voffB); PG8_STAGE(PG8_SA(0, 0), Ab, ao[0]); PG8_STAGE(PG8_SA(0, 1), Ab, ao[1]);
    if (wr == 1) PG8_BAR;
    PG8_WAIT_V(2); PG8_BAR;
    PG8_STAGE(PG8_SB(1, 0), cB + kstep, voffB); PG8_STAGE(PG8_SA(1, 0), Ab + kstep, ao[0]); PG8_STAGE(PG8_SB(1, 1), cB + hstep + kstep, voffB);
    PG8_WAIT_V(6); PG8_BAR;
    for (;;) {
        const bool has_next = S.next(ui + 1, nxt);
        const char* nB = cB;
        if (has_next) { S.a_off(nxt, sR, sC, an); nB = S.b_base(nxt); }
        else { an[0][0] = ao[0][0]; an[0][1] = ao[0][1]; an[1][0] = ao[1][0]; an[1][1] = ao[1][1]; }
        for (int t = 0; t < nt; t += 2) {
            const bool last = (t == nt - 2);
            const char* a1 = Ab + (size_t)(t + 1) * kstep;
            PG8_LDB(B0, 0, 0); PG8_LDB(B1, 0, 1); PG8_SCHED; PG8_LDA(At, 0, 0); PG8_STAGE(PG8_SA(1, 1), a1, ao[1]);
            PG8_WAIT_V(8); PG8_WAIT_L(0); PG8_BAR; PG8_MMA(0, 0, At, B0); PG8_MMA(0, 1, At, B1); PG8_BAR; PG8_SCHED;
            const char* a2 = last ? Ab : Ab + (size_t)(t + 2) * kstep; const char* b2 = last ? nB : cB + (size_t)(t + 2) * kstep;
            if (last) { ao[0][0] = an[0][0]; ao[0][1] = an[0][1]; ao[1][0] = an[1][0]; ao[1][1] = an[1][1]; }
            const char* a3 = a2 + kstep; const char* b3 = b2 + kstep;
            PG8_LDA(At, 0, 1); PG8_STAGE(PG8_SB(0, 0), b2, voffB); PG8_STAGE(PG8_SB(0, 1), b2 + hstep, voffB); PG8_STAGE(PG8_SA(0, 0), a2, ao[0]);
            PG8_WAIT_V(8); PG8_WAIT_L(0); PG8_BAR; PG8_MMA(1, 0, At, B0); PG8_MMA(1, 1, At, B1); PG8_BAR; PG8_SCHED;
            PG8_LDB(B0, 1, 0); PG8_LDB(B1, 1, 1); PG8_SCHED; PG8_LDA(At, 1, 0); PG8_STAGE(PG8_SA(0, 1), a2, ao[1]);
            PG8_WAIT_V(8); PG8_WAIT_L(0); PG8_BAR; PG8_MMA(0, 0, At, B0); PG8_MMA(0, 1, At, B1); PG8_BAR; PG8_SCHED;
            PG8_LDA(At, 1, 1); PG8_STAGE(PG8_SB(1, 0), b3, voffB); PG8_STAGE(PG8_SB(1, 1), b3 + hstep, voffB); PG8_STAGE(PG8_SA(1, 0), a3, ao[0]);
            PG8_WAIT_V(8); PG8_WAIT_L(0); PG8_BAR; PG8_MMA(1, 0, At, B0); PG8_MMA(1, 1, At, B1); PG8_BAR; PG8_SCHED;
        }
        if constexpr (ALIGN_EPI) { if (wr == 0) PG8_BAR; }
        E(acc, cur, wr, wc, fr, fq);
        if (!has_next) break;
#pragma unroll
        for (int a = 0; a < 2; ++a)
#pragma unroll
            for (int b = 0; b < 2; ++b)
#pragma unroll
                for (int m = 0; m < 4; ++m)
#pragma unroll
                    for (int n = 0; n < 2; ++n) acc[a][b][m][n] = (f32x4){0.f, 0.f, 0.f, 0.f};
        cur = nxt; cB = nB; ++ui;
        if constexpr (ALIGN_EPI) { if (wr == 1) PG8_BAR; }
    }
    PG8_WAIT_V(0);
    if constexpr (!ALIGN_EPI) { if (wr == 0) PG8_BAR; }
    PG8_BAR;
#undef PG8_SA
#undef PG8_SB
#undef PG8_STAGE
#undef PG8_LDA
#undef PG8_LDB
#undef PG8_MMA
#undef PG8_WAIT_V
#undef PG8_WAIT_L
#undef PG8_BAR
#undef PG8_SCHED
}

struct PlainSched {
    const bf16* Bt; int K, nM, nN, nwg, G, c;
    __device__ void init(const bf16* Bt_, int M_, int N_, int K_, int G_, int c_) { Bt = Bt_; K = K_; nM = M_ / BM; nN = N_ / BM; nwg = nM * nN; G = G_; c = c_; }
    __device__ __forceinline__ bool next(int i, Unit& u) const {
        const long L = (long)i * G + c; if (L >= nwg) return false;
        int wgid = (int)L; { const int q = nwg / NXCD, r = nwg % NXCD, xcd = wgid % NXCD, off = wgid / NXCD; wgid = (xcd < r ? xcd * (q + 1) : r * (q + 1) + (xcd - r) * q) + off; }
        const int nig = WGM * nN, gid = wgid / nig, fm = gid * WGM, gsz = (nM - fm) < WGM ? (nM - fm) : WGM;
        u.pm = fm + ((wgid % nig) % gsz); u.pn = (wgid % nig) / gsz; u.e = 0; u.nrows = BM; return true;
    }
    __device__ __forceinline__ void a_off(const Unit& u, const int (&R)[2], const int (&C)[2], unsigned (&off)[2][2]) const {
#pragma unroll
        for (int h = 0; h < 2; ++h)
#pragma unroll
            for (int i = 0; i < 2; ++i) off[h][i] = (unsigned)(((u.pm * BM + h * HALF + R[i]) * K + C[i]) * 2);
    }
    __device__ __forceinline__ const char* b_base(const Unit& u) const { return (const char*)Bt + (size_t)u.pn * BM * K * 2; }
};

struct EpiStoreBf16 {
    static constexpr bool PERM = true;
    bf16* O; int ldc;
    __device__ __forceinline__ void operator()(const f32x4 (&acc)[2][2][4][2], const Unit& u, int wr, int wc, int fr, int fq) const {
        const int row0 = u.pm * BM + wr * 64 + fr, col0 = u.pn * BM + wc * 32 + 8 * fq;
#pragma unroll
        for (int ai = 0; ai < 2; ++ai)
#pragma unroll
            for (int m = 0; m < 4; ++m) { bf16* rowp = O + (size_t)(row0 + ai * HALF + m * 16) * ldc + col0;
#pragma unroll
                for (int bj = 0; bj < 2; ++bj) { const f32x4 v0 = acc[ai][bj][m][0], v1 = acc[ai][bj][m][1];
                    u32x4 w; w.x = cvt_pk_bf16(v0[0], v0[1]); w.y = cvt_pk_bf16(v0[2], v0[3]); w.z = cvt_pk_bf16(v1[0], v1[1]); w.w = cvt_pk_bf16(v1[2], v1[3]);
                    *(u32x4*)(rowp + bj * HALF) = w; } }
    }
};
struct EpiResF32 {
    static constexpr bool PERM = false;
    const float* base; float* out; int ldc;
    __device__ __forceinline__ void operator()(const f32x4 (&acc)[2][2][4][2], const Unit& u, int wr, int wc, int fr, int fq) const {
        const int row0 = u.pm * BM + wr * 64 + fr, col0 = u.pn * BM + wc * 32 + 4 * fq;
#pragma unroll
        for (int ai = 0; ai < 2; ++ai)
#pragma unroll
            for (int m = 0; m < 4; ++m) { const size_t off = (size_t)(row0 + ai * HALF + m * 16) * ldc + col0;
#pragma unroll
                for (int bj = 0; bj < 2; ++bj)
#pragma unroll
                    for (int n = 0; n < 2; ++n) { const f32x4 b = *(const f32x4*)(base + off + bj * HALF + n * 16); *(f32x4*)(out + off + bj * HALF + n * 16) = b + acc[ai][bj][m][n]; } }
    }
};
template <bool GATHER>
struct MoeSched {
    const bf16* W; size_t wbytes;
    const unsigned* cnt; const int* rowtok; const LAS int* tab;
    int K, nN, G, c;
    __device__ __forceinline__ bool next(int i, Unit& u) const {
        const int total = tab[32] * nN; const int L = i * G + c; if (L >= total) return false;
        const int gt = L / nN; int e = 0;
#pragma unroll
        for (int j = 1; j < 32; ++j) e += (gt >= tab[j]) ? 1 : 0;
        e = __builtin_amdgcn_readfirstlane(e);
        u.pm = __builtin_amdgcn_readfirstlane(gt); u.pn = __builtin_amdgcn_readfirstlane(L % nN); u.e = e;
        u.nrows = __builtin_amdgcn_readfirstlane((int)cnt[e] - (gt - tab[e]) * BM);
        return true;
    }
    __device__ __forceinline__ void a_off(const Unit& u, const int (&R)[2], const int (&C)[2], unsigned (&off)[2][2]) const {
#pragma unroll
        for (int h = 0; h < 2; ++h)
#pragma unroll
            for (int i = 0; i < 2; ++i) {
                if (GATHER) { const int lt = (u.pm - tab[u.e]) * BM; int li = h * HALF + R[i]; li = li < u.nrows ? li : u.nrows - 1;
                    const int tok = rowtok[u.e * M + lt + li]; off[h][i] = (unsigned)((tok * K + C[i]) * 2); }
                else off[h][i] = (unsigned)(((u.pm * BM + h * HALF + R[i]) * K + C[i]) * 2);
            }
    }
    __device__ __forceinline__ const char* b_base(const Unit& u) const { return (const char*)W + (size_t)u.e * wbytes + (size_t)u.pn * BM * K * 2; }
};
struct EpiMoe1 {
    static constexpr bool PERM = true;
    bf16* act; const float* b_gu;
    __device__ __forceinline__ void operator()(const f32x4 (&acc)[2][2][4][2], const Unit& u, int wr, int wc, int fr, int fq) const {
        const int row0 = u.pm * BM + wr * 64 + fr, cc = u.pn * HALF + wc * 32 + 8 * fq;
        const float* bias = b_gu + (size_t)u.e * 4096 + cc;
        const f32x4 bg0 = *(const f32x4*)(bias), bg1 = *(const f32x4*)(bias + 4), bl0 = *(const f32x4*)(bias + 2048), bl1 = *(const f32x4*)(bias + 2048 + 4);
#pragma unroll
        for (int ai = 0; ai < 2; ++ai)
#pragma unroll
            for (int m = 0; m < 4; ++m) {
                f32x4 o[2];
#pragma unroll
                for (int n = 0; n < 2; ++n) { const f32x4 gv = acc[ai][0][m][n] + (n ? bg1 : bg0), lv = acc[ai][1][m][n] + (n ? bl1 : bl0);
#pragma unroll
                    for (int j = 0; j < 4; ++j) { const float g = fminf(gv[j], 7.0f), l = fminf(fmaxf(lv[j], -7.0f), 7.0f);
                        o[n][j] = (l + 1.0f) * g * __builtin_amdgcn_rcpf(1.0f + __builtin_amdgcn_exp2f(-1.702f * 1.4426950408889634f * g)); } }
                u32x4 w; w.x = cvt_pk_bf16(o[0][0], o[0][1]); w.y = cvt_pk_bf16(o[0][2], o[0][3]); w.z = cvt_pk_bf16(o[1][0], o[1][1]); w.w = cvt_pk_bf16(o[1][2], o[1][3]);
                *(u32x4*)(act + (size_t)(row0 + ai * HALF + m * 16) * DFF + cc) = w;
            }
    }
};
struct EpiMoe2 {
    static constexpr bool PERM = true;
    bf16* y; const float* b_d;
    __device__ __forceinline__ void operator()(const f32x4 (&acc)[2][2][4][2], const Unit& u, int wr, int wc, int fr, int fq) const {
        const int row0 = u.pm * BM + wr * 64 + fr, col0 = u.pn * BM + wc * 32 + 8 * fq;
        const float* bias = b_d + (size_t)u.e * D + col0;
        f32x4 bv[2][2];
#pragma unroll
        for (int bj = 0; bj < 2; ++bj)
#pragma unroll
            for (int n = 0; n < 2; ++n) bv[bj][n] = *(const f32x4*)(bias + bj * HALF + 4 * n);
#pragma unroll
        for (int ai = 0; ai < 2; ++ai)
#pragma unroll
            for (int m = 0; m < 4; ++m) { bf16* rowp = y + (size_t)(row0 + ai * HALF + m * 16) * D + col0;
#pragma unroll
                for (int bj = 0; bj < 2; ++bj) { const f32x4 v0 = acc[ai][bj][m][0] + bv[bj][0], v1 = acc[ai][bj][m][1] + bv[bj][1];
                    u32x4 w; w.x = cvt_pk_bf16(v0[0], v0[1]); w.y = cvt_pk_bf16(v0[2], v0[3]); w.z = cvt_pk_bf16(v1[0], v1[1]); w.w = cvt_pk_bf16(v1[2], v1[3]);
                    *(u32x4*)(rowp + bj * HALF) = w; } }
    }
};
}

struct Ctx { int lane, wave, tid, gw, NGW, wg, G; LAS unsigned char* lds; };

template <int MODE>
__device__ __forceinline__ void transpose_item(const float* W, int K, int N, bf16* WT, LAS float* scr, int item, int lane) {
    const int nblk = N / 32, kb = item / nblk, nb = item % nblk, k0 = 64 * kb, n0 = 32 * nb;
    int dr0 = n0;
    if (MODE == 1) { const int bj = n0 / 2048, c = n0 % 2048; dr0 = 256 * (c / 128) + 128 * bj + (c % 128); }
#pragma unroll 8
    for (int i = 0; i < 32; ++i) { const int kk = 2 * i + (lane >> 5); scr[kk * 33 + (lane & 31)] = W[(size_t)(k0 + kk) * N + n0 + (lane & 31)]; }
    LDS_WAIT(); asm volatile("" ::: "memory");
    const int c = lane & 7;
#pragma unroll
    for (int j = 0; j < 4; ++j) { const int n = (lane >> 3) + 8 * j; const LAS float* s = scr + (8 * c) * 33 + n;
        u32x4 o; o.x = pk2(s[0 * 33], s[1 * 33]); o.y = pk2(s[2 * 33], s[3 * 33]); o.z = pk2(s[4 * 33], s[5 * 33]); o.w = pk2(s[6 * 33], s[7 * 33]);
        *(u32x4*)(WT + (size_t)(dr0 + n) * K + k0 + 8 * c) = o; }
    LDS_WAIT(); asm volatile("" ::: "memory");
}
template <int MODE>
__device__ __forceinline__ void transpose_all(const Ctx& c, const float* W, int K, int N, int NOUT, int NEXP, bf16* WT) {
    LAS float* scr = (LAS float*)(c.lds + c.wave * 16384);
    const int per = (K / 64) * (N / 32), total = per * NEXP;
    for (int it = c.gw; it < total; it += c.NGW) { const int e = it / per, r = it % per;
        transpose_item<MODE>(W + (size_t)e * K * N, K, N, WT + (size_t)e * NOUT * K, scr, r, c.lane); }
}

__device__ __forceinline__ void norm1_row(int R, int lane, const float* x, const float* meta, const float* g, bf16* hn) {
    const float* src = R < M ? x + (size_t)R * D : meta + (size_t)(R - M) * D;
    f32x4 v[8]; float ss = 0.f;
#pragma unroll
    for (int j = 0; j < 8; ++j) { v[j] = *(const f32x4*)(src + j * 256 + lane * 4); ss += v[j].x * v[j].x + v[j].y * v[j].y + v[j].z * v[j].z + v[j].w * v[j].w; }
    const float rstd = rsqrtf(wave_sum(ss) * (1.f / D) + EPS);
#pragma unroll
    for (int j = 0; j < 8; ++j) {
        const f32x4 gg = *(const f32x4*)(g + j * 256 + lane * 4);
        u32x2 o; o.x = pk2(v[j].x * rstd * gg.x, v[j].y * rstd * gg.y); o.y = pk2(v[j].z * rstd * gg.z, v[j].w * rstd * gg.w);
        *(u32x2*)(hn + (size_t)R * D + j * 256 + lane * 4) = o;
    }
}

struct EpiProj { bf16* proj; int roff; __device__ void operator()(int m, int n, float v) const { proj[(size_t)(m + roff) * DINP + n] = f2bf(v); } };
struct EpiQraw { float* q; __device__ void operator()(int m, int n, float v) const { if (m < M) q[(size_t)m * 1536 + n] = v; } };
struct EpiKV {
    bf16* kn; bf16* vv;
    __device__ void operator()(int R, int n, float v) const {
        if (R >= MR) return;
        const int h = n >> 8, part = (n >> 7) & 1, d = n & 127;
        bf16* dst = kn + (size_t)part * ((WS_V - WS_KN) / 2); const bf16 o = f2bf(v);
        if (R < M) { const int b = R / S, pos = (R % S) + NMETA; dst[((size_t)(b * LP + pos) * NH + h) * 128 + d] = o; }
        else { const int pos = R - M; dst[((size_t)(0 * LP + pos) * NH + h) * 128 + d] = o; dst[((size_t)(1 * LP + pos) * NH + h) * 128 + d] = o; }
    }
};
struct EpiWout { const float* x; float* h1; __device__ void operator()(int m, int n, float v) const { h1[(size_t)m * D + n] = x[(size_t)m * D + n] + v; } };

template <class Epi>
__device__ __forceinline__ void gemm_simple(const Ctx& c, const bf16* __restrict__ A, int lda, const bf16* __restrict__ Bt, int ldb, int K, int nMt, int nNt, const Epi& epi) {
    const int r = c.lane & 15, q = c.lane >> 4;
    for (int wt = c.gw; wt < nMt * nNt; wt += c.NGW) {
        const int m0 = (wt / nNt) * 32, n0 = (wt % nNt) * 32;
        f32x4 acc[2][2];
#pragma unroll
        for (int i = 0; i < 2; ++i)
#pragma unroll
            for (int j = 0; j < 2; ++j) acc[i][j] = (f32x4){0.f, 0.f, 0.f, 0.f};
        const bf16* a0 = A + (size_t)(m0 + r) * lda + 8 * q; const bf16* b0 = Bt + (size_t)(n0 + r) * ldb + 8 * q;
#pragma unroll 2
        for (int k0 = 0; k0 < K; k0 += 32) {
            bf16x8 a[2], b[2];
#pragma unroll
            for (int i = 0; i < 2; ++i) { a[i] = *(const bf16x8*)(a0 + (size_t)i * 16 * lda + k0); b[i] = *(const bf16x8*)(b0 + (size_t)i * 16 * ldb + k0); }
#pragma unroll
            for (int i = 0; i < 2; ++i)
#pragma unroll
                for (int j = 0; j < 2; ++j) acc[i][j] = __builtin_amdgcn_mfma_f32_16x16x32_bf16(a[i], b[j], acc[i][j], 0, 0, 0);
        }
#pragma unroll
        for (int i = 0; i < 2; ++i)
#pragma unroll
            for (int j = 0; j < 2; ++j)
#pragma unroll
                for (int t = 0; t < 4; ++t) epi(m0 + i * 16 + q * 4 + t, n0 + j * 16 + r, acc[i][j][t]);
    }
}

__device__ __forceinline__ float inv_freq(int i) { return powf(10000.0f, -(float)i / 32.0f); }

__device__ __forceinline__ void postproj_row(int R, int lane, const bf16* __restrict__ proj, const float* __restrict__ conv_w, const float* __restrict__ g_conv,
                                             const float* __restrict__ g_q, const float* __restrict__ g_kv,
                                             bf16* __restrict__ mixed, bf16* __restrict__ qn, bf16* __restrict__ kvn, bf16* __restrict__ kpe) {
    const bf16* pr = proj + (size_t)R * DINP;
    const bool meta = R >= M; const int b = meta ? 0 : R / S, t = meta ? 0 : R % S, pos = meta ? R - M : t + NMETA;
    {
        const u32x2 w = *(const u32x2*)(pr + O_KV + lane * 4);
        float f[4] = {__uint_as_float(w.x << 16), __uint_as_float(w.x & 0xffff0000u), __uint_as_float(w.y << 16), __uint_as_float(w.y & 0xffff0000u)};
        const float ss = wave_sum(f[0] * f[0] + f[1] * f[1] + f[2] * f[2] + f[3] * f[3]);
        const float rstd = rsqrtf(ss * (1.f / KVL) + EPS);
        const f32x4 g = *(const f32x4*)(g_kv + lane * 4);
        u32x2 o; o.x = pk2(f[0] * rstd * g.x, f[1] * rstd * g.y); o.y = pk2(f[2] * rstd * g.z, f[3] * rstd * g.w);
        *(u32x2*)(kvn + (size_t)R * KVL + lane * 4) = o;
    }
    if (lane < 32) {
        const float x1 = bf2f(pr[O_R + lane]), x2 = bf2f(pr[O_R + 32 + lane]);
        const float ang = (float)pos * inv_freq(lane); const float cs = cosf(ang), sn = sinf(ang);
        const bf16 o1 = f2bf(x1 * cs - x2 * sn), o2 = f2bf(x1 * sn + x2 * cs);
        if (!meta) { bf16* d = kpe + (size_t)(b * LP + pos) * ROPE; d[lane] = o1; d[32 + lane] = o2; }
        else { bf16* d0 = kpe + (size_t)(0 * LP + pos) * ROPE; bf16* d1 = kpe + (size_t)(1 * LP + pos) * ROPE; d0[lane] = o1; d0[32 + lane] = o2; d1[lane] = o1; d1[32 + lane] = o2; }
    }
    if (meta) return;
    {
        float f[8]; unpack8(*(const u32x4*)(pr + O_Q + lane * 8), f);
        float ss = 0.f;
#pragma unroll
        for (int i = 0; i < 8; ++i) ss += f[i] * f[i];
        const float rstd = rsqrtf(wave_sum(ss) * (1.f / QL) + EPS);
        const f32x4 g0 = *(const f32x4*)(g_q + lane * 8), g1 = *(const f32x4*)(g_q + lane * 8 + 4);
        u32x4 o; o.x = pk2(f[0] * rstd * g0.x, f[1] * rstd * g0.y); o.y = pk2(f[2] * rstd * g0.z, f[3] * rstd * g0.w);
        o.z = pk2(f[4] * rstd * g1.x, f[5] * rstd * g1.y); o.w = pk2(f[6] * rstd * g1.z, f[7] * rstd * g1.w);
        *(u32x4*)(qn + (size_t)R * QL + lane * 8) = o;
    }
    {
        const int r1 = (t >= 1) ? R - 1 : M + 15, r2 = (t >= 2) ? R - 2 : (t == 1 ? M + 15 : M + 14);
        const bf16* p1 = proj + (size_t)r1 * DINP; const bf16* p2 = proj + (size_t)r2 * DINP;
        const int c0 = lane * 16;
        float v[16]; float ss = 0.f;
#pragma unroll
        for (int hh = 0; hh < 2; ++hh) {
            const int c = c0 + hh * 8;
            float bg[8], cg0[8], ui0[8], cg1[8], ui1[8], cg2[8], ui2[8];
            unpack8(*(const u32x4*)(pr + c), bg); unpack8(*(const u32x4*)(pr + O_C + c), cg0); unpack8(*(const u32x4*)(pr + O_U + c), ui0);
            unpack8(*(const u32x4*)(p1 + O_C + c), cg1); unpack8(*(const u32x4*)(p1 + O_U + c), ui1);
            unpack8(*(const u32x4*)(p2 + O_C + c), cg2); unpack8(*(const u32x4*)(p2 + O_U + c), ui2);
#pragma unroll
            for (int i = 0; i < 8; ++i) {
                const float y = conv_w[2 * DCONV + c + i] * (cg0[i] * ui0[i]) + conv_w[1 * DCONV + c + i] * (cg1[i] * ui1[i]) + conv_w[0 * DCONV + c + i] * (cg2[i] * ui2[i]);
                const float o = bg[i] * y; v[hh * 8 + i] = o; ss += o * o;
            }
        }
        ss += __shfl_xor(ss, 1); ss += __shfl_xor(ss, 2);
        const float rstd = rsqrtf(ss * (1.f / 64.f) + EPS);
#pragma unroll
        for (int hh = 0; hh < 2; ++hh) {
            const int c = c0 + hh * 8;
            const f32x4 g0 = *(const f32x4*)(g_conv + c), g1 = *(const f32x4*)(g_conv + c + 4);
            u32x4 o; o.x = pk2(v[hh * 8 + 0] * rstd * g0.x, v[hh * 8 + 1] * rstd * g0.y); o.y = pk2(v[hh * 8 + 2] * rstd * g0.z, v[hh * 8 + 3] * rstd * g0.w);
            o.z = pk2(v[hh * 8 + 4] * rstd * g1.x, v[hh * 8 + 5] * rstd * g1.y); o.w = pk2(v[hh * 8 + 6] * rstd * g1.z, v[hh * 8 + 7] * rstd * g1.w);
            *(u32x4*)(mixed + (size_t)R * D + c) = o;
        }
    }
}

__device__ __forceinline__ void rope_q_row(int m, int lane, const float* __restrict__ qraw, bf16* __restrict__ Q) {
    const int pos = (m % S) + NMETA;
    float cs = 0.f, sn = 0.f;
    if (lane < 32) { const float ang = (float)pos * inv_freq(lane); cs = cosf(ang); sn = sinf(ang); }
    for (int h = 0; h < NH; ++h) {
        const float* src = qraw + (size_t)m * 1536 + h * DQK; bf16* dst = Q + ((size_t)m * NH + h) * DQK;
        dst[lane] = f2bf(src[lane]); dst[64 + lane] = f2bf(src[64 + lane]);
        if (lane < 32) { const float x1 = src[128 + lane], x2 = src[160 + lane]; dst[128 + lane] = f2bf(x1 * cs - x2 * sn); dst[160 + lane] = f2bf(x1 * sn + x2 * cs); }
    }
}

__device__ __forceinline__ void attn_simple_row(int wid, int lane, const bf16* __restrict__ Q, const bf16* __restrict__ Kn, const bf16* __restrict__ Kpe, const bf16* __restrict__ V,
                                                const float* __restrict__ g_attn, bf16* __restrict__ mixed) {
    const int m = wid / NH, h = wid % NH, b = m / S, pos = (m % S) + NMETA;
    const bf16* q = Q + ((size_t)m * NH + h) * DQK;
    const float scale = 0.07216878364870322f;
    const float q0 = bf2f(q[lane]) * scale, q1 = bf2f(q[64 + lane]) * scale, q2 = bf2f(q[128 + lane]) * scale;
    const bf16* kn = Kn + ((size_t)b * LP * NH + h) * 128; const bf16* vv = V + ((size_t)b * LP * NH + h) * 128; const bf16* kp = Kpe + (size_t)b * LP * ROPE;
    float mx = -INFINITY, sum = 0.f, o0 = 0.f, o1 = 0.f;
    for (int j = 0; j <= pos; j += 4) {
        float s[4], v0[4], v1[4];
#pragma unroll
        for (int u = 0; u < 4; ++u) {
            const size_t ro = (size_t)(j + u) * NH * 128;
            s[u] = q0 * bf2f(kn[ro + lane]) + q1 * bf2f(kn[ro + 64 + lane]) + q2 * bf2f(kp[(size_t)(j + u) * ROPE + lane]);
            v0[u] = bf2f(vv[ro + lane]); v1[u] = bf2f(vv[ro + 64 + lane]);
        }
#pragma unroll
        for (int o = 1; o < 64; o <<= 1) {
#pragma unroll
            for (int u = 0; u < 4; ++u) s[u] += __shfl_xor(s[u], o);
        }
#pragma unroll
        for (int u = 0; u < 4; ++u) if (j + u > pos) s[u] = -INFINITY;
        const float mn = fmaxf(fmaxf(mx, fmaxf(s[0], s[1])), fmaxf(s[2], s[3]));
        const float corr = __expf(mx - mn);
        sum *= corr; o0 *= corr; o1 *= corr;
#pragma unroll
        for (int u = 0; u < 4; ++u) { const float p = __expf(s[u] - mn); sum += p; o0 += p * v0[u]; o1 += p * v1[u]; }
        mx = mn;
    }
    const float inv = 1.f / sum; o0 *= inv; o1 *= inv;
    const float ss = wave_sum(o0 * o0 + o1 * o1);
    const float rstd = rsqrtf(ss * (1.f / 128.f) + EPS);
    bf16* dst = mixed + (size_t)m * D + DCONV + h * DV;
    dst[lane] = f2bf(o0 * rstd * g_attn[h * DV + lane]); dst[64 + lane] = f2bf(o1 * rstd * g_attn[h * DV + 64 + lane]);
}

__device__ __forceinline__ void router_row(int m, int lane, const float* __restrict__ h1, const float* __restrict__ g_ffn, const float* __restrict__ w_r, const float* __restrict__ b_r,
                                           bf16* __restrict__ xn, unsigned* __restrict__ cnt, int* __restrict__ rowtok, int* __restrict__ tok_e, int* __restrict__ tok_p, float* __restrict__ gate) {
    const float* src = h1 + (size_t)m * D;
    float ss = 0.f;
#pragma unroll
    for (int j = 0; j < 8; ++j) { const f32x4 t = *(const f32x4*)(src + j * 256 + lane * 4); ss += t.x * t.x + t.y * t.y + t.z * t.z + t.w * t.w; }
    const float rstd = rsqrtf(wave_sum(ss) * (1.f / D) + EPS);
    float acc[32];
#pragma unroll
    for (int e = 0; e < 32; ++e) acc[e] = 0.f;
#pragma unroll 1
    for (int j = 0; j < 8; ++j) {
        const f32x4 vv = *(const f32x4*)(src + j * 256 + lane * 4);
        const f32x4 gg = *(const f32x4*)(g_ffn + j * 256 + lane * 4);
        const float xv[4] = {vv.x * rstd * gg.x, vv.y * rstd * gg.y, vv.z * rstd * gg.z, vv.w * rstd * gg.w};
        u32x2 o; o.x = pk2(xv[0], xv[1]); o.y = pk2(xv[2], xv[3]);
        *(u32x2*)(xn + (size_t)m * D + j * 256 + lane * 4) = o;
#pragma unroll
        for (int i = 0; i < 4; ++i) {
            const float* wr = w_r + (size_t)(j * 256 + lane * 4 + i) * NE;
#pragma unroll
            for (int e4 = 0; e4 < 8; ++e4) { const f32x4 w = *(const f32x4*)(wr + e4 * 4);
                acc[e4 * 4 + 0] += xv[i] * w.x; acc[e4 * 4 + 1] += xv[i] * w.y; acc[e4 * 4 + 2] += xv[i] * w.z; acc[e4 * 4 + 3] += xv[i] * w.w; }
        }
    }
    float logit = -INFINITY;
#pragma unroll
    for (int e = 0; e < 32; ++e) { const float tot = wave_sum(acc[e]) + b_r[e]; if (lane == e) logit = tot; }
    float tv[4]; int ti[4];
#pragma unroll
    for (int k = 0; k < 4; ++k) {
        const float mxv = wave_max(logit);
        const unsigned long long mask = __ballot(logit == mxv);
        const int idx = __ffsll((long long)mask) - 1;
        tv[k] = mxv; ti[k] = idx;
        if (lane == idx) logit = -INFINITY;
    }
    float ex[4]; float es = 0.f;
#pragma unroll
    for (int k = 0; k < 4; ++k) { ex[k] = expf(tv[k] - tv[0]); es += ex[k]; }
    if (lane == 0) {
#pragma unroll
        for (int k = 0; k < 4; ++k) {
            const unsigned p = atomicAdd(&cnt[ti[k]], 1u);
            rowtok[ti[k] * M + p] = m; tok_e[m * 4 + k] = ti[k]; tok_p[m * 4 + k] = (int)p; gate[m * 4 + k] = ex[k] / es;
        }
    }
}

__device__ __forceinline__ bool expert_of_row(const unsigned* cnt, int row0, int& e_out, int& local0, int& n_out, int& off_out) {
    int off = 0;
    for (int e = 0; e < NE; ++e) { const int n = (int)cnt[e], p = (n + 255) / 256 * 256; if (row0 < off + p) { e_out = e; local0 = row0 - off; n_out = n; off_out = off; return true; } off += p; }
    return false;
}
__device__ __forceinline__ void moe1_simple(const Ctx& cx, const bf16* __restrict__ xn, const bf16* __restrict__ Wgu, const float* __restrict__ b_gu, const unsigned* __restrict__ cnt,
                                            const int* __restrict__ rowtok, bf16* __restrict__ act) {
    const int r = cx.lane & 15, q = cx.lane >> 4;
    constexpr int nNt = DFF / 32;
    for (int wt = cx.gw; wt < (RP / 32) * nNt; wt += cx.NGW) {
        int e, lm0, n, off;
        if (!expert_of_row(cnt, (wt / nNt) * 32, e, lm0, n, off)) break;
        if (lm0 >= n) continue;
        const int c0 = (wt % nNt) * 32;
        const bf16* Wt = Wgu + (size_t)e * 4096 * D;
        const bf16* ap[2]; const bf16* bg[2];
#pragma unroll
        for (int i = 0; i < 2; ++i) { const int li = lm0 + i * 16 + r; const int tok = li < n ? rowtok[e * M + li] : rowtok[e * M]; ap[i] = xn + (size_t)tok * D + 8 * q; }
#pragma unroll
        for (int j = 0; j < 2; ++j) { const int c = c0 + j * 16 + r; const int ng = 256 * (c >> 7) + (c & 127); bg[j] = Wt + (size_t)ng * D + 8 * q; }
        f32x4 ag[2][2], al[2][2];
#pragma unroll
        for (int i = 0; i < 2; ++i)
#pragma unroll
            for (int j = 0; j < 2; ++j) { ag[i][j] = (f32x4){0.f, 0.f, 0.f, 0.f}; al[i][j] = (f32x4){0.f, 0.f, 0.f, 0.f}; }
#pragma unroll 2
        for (int k0 = 0; k0 < D; k0 += 32) {
            bf16x8 a[2], wg[2], wl[2];
#pragma unroll
            for (int i = 0; i < 2; ++i) { a[i] = *(const bf16x8*)(ap[i] + k0); wg[i] = *(const bf16x8*)(bg[i] + k0); wl[i] = *(const bf16x8*)(bg[i] + (size_t)128 * D + k0); }
#pragma unroll
            for (int i = 0; i < 2; ++i)
#pragma unroll
                for (int j = 0; j < 2; ++j) { ag[i][j] = __builtin_amdgcn_mfma_f32_16x16x32_bf16(a[i], wg[j], ag[i][j], 0, 0, 0); al[i][j] = __builtin_amdgcn_mfma_f32_16x16x32_bf16(a[i], wl[j], al[i][j], 0, 0, 0); }
        }
        const float* bias = b_gu + (size_t)e * 4096;
#pragma unroll
        for (int i = 0; i < 2; ++i)
#pragma unroll
            for (int j = 0; j < 2; ++j)
#pragma unroll
                for (int t = 0; t < 4; ++t) {
                    const int li = lm0 + i * 16 + q * 4 + t, c = c0 + j * 16 + r;
                    if (li < n) {
                        const float g = fminf(ag[i][j][t] + bias[c], 7.0f);
                        const float l = fminf(fmaxf(al[i][j][t] + bias[2048 + c], -7.0f), 7.0f);
                        const float a = (l + 1.0f) * (g / (1.0f + expf(-1.702f * g)));
                        act[(size_t)(off + li) * DFF + c] = f2bf(a);
                    }
                }
    }
}
__device__ __forceinline__ void moe2_simple(const Ctx& cx, const bf16* __restrict__ act, const bf16* __restrict__ Wd, const float* __restrict__ b_d, const unsigned* __restrict__ cnt, bf16* __restrict__ y) {
    const int r = cx.lane & 15, q = cx.lane >> 4;
    constexpr int nNt = D / 32;
    for (int wt = cx.gw; wt < (RP / 32) * nNt; wt += cx.NGW) {
        int e, lm0, n, off;
        if (!expert_of_row(cnt, (wt / nNt) * 32, e, lm0, n, off)) break;
        if (lm0 >= n) continue;
        const int n0 = (wt % nNt) * 32;
        const bf16* Wt = Wd + (size_t)e * D * DFF;
        const bf16* a0 = act + (size_t)(off + lm0 + r) * DFF + 8 * q; const bf16* b0 = Wt + (size_t)(n0 + r) * DFF + 8 * q;
        f32x4 acc[2][2];
#pragma unroll
        for (int i = 0; i < 2; ++i)
#pragma unroll
            for (int j = 0; j < 2; ++j) acc[i][j] = (f32x4){0.f, 0.f, 0.f, 0.f};
#pragma unroll 2
        for (int k0 = 0; k0 < DFF; k0 += 32) {
            bf16x8 a[2], b[2];
#pragma unroll
            for (int i = 0; i < 2; ++i) { a[i] = *(const bf16x8*)(a0 + (size_t)i * 16 * DFF + k0); b[i] = *(const bf16x8*)(b0 + (size_t)i * 16 * DFF + k0); }
#pragma unroll
            for (int i = 0; i < 2; ++i)
#pragma unroll
                for (int j = 0; j < 2; ++j) acc[i][j] = __builtin_amdgcn_mfma_f32_16x16x32_bf16(a[i], b[j], acc[i][j], 0, 0, 0);
        }
        const float* bias = b_d + (size_t)e * D;
#pragma unroll
        for (int i = 0; i < 2; ++i)
#pragma unroll
            for (int j = 0; j < 2; ++j)
#pragma unroll
                for (int t = 0; t < 4; ++t) { const int li = lm0 + i * 16 + q * 4 + t, c = n0 + j * 16 + r; if (li < n) y[(size_t)(off + li) * D + c] = f2bf(acc[i][j][t] + bias[c]); }
    }
}

__device__ __forceinline__ void combine_row(int m, int lane, const float* __restrict__ h1, const bf16* __restrict__ y, const unsigned* __restrict__ cnt, const int* __restrict__ tok_e, const int* __restrict__ tok_p,
                                            const float* __restrict__ gate, const float* __restrict__ g_final, float* __restrict__ out) {
    size_t yrow[4]; float gk[4];
#pragma unroll
    for (int k = 0; k < 4; ++k) {
        const int e = tok_e[m * 4 + k]; int off = 0;
        for (int e2 = 0; e2 < e; ++e2) off += ((int)cnt[e2] + 255) / 256 * 256;
        yrow[k] = (size_t)(off + tok_p[m * 4 + k]) * D; gk[k] = gate[m * 4 + k];
    }
    f32x4 v[8]; float ss = 0.f;
#pragma unroll
    for (int j = 0; j < 8; ++j) {
        const int idx = j * 256 + lane * 4;
        f32x4 a = *(const f32x4*)(h1 + (size_t)m * D + idx);
#pragma unroll
        for (int k = 0; k < 4; ++k) { const u32x2 w = *(const u32x2*)(y + yrow[k] + idx);
            a.x += gk[k] * __uint_as_float(w.x << 16); a.y += gk[k] * __uint_as_float(w.x & 0xffff0000u); a.z += gk[k] * __uint_as_float(w.y << 16); a.w += gk[k] * __uint_as_float(w.y & 0xffff0000u); }
        v[j] = a; ss += a.x * a.x + a.y * a.y + a.z * a.z + a.w * a.w;
    }
    const float rstd = rsqrtf(wave_sum(ss) * (1.f / D) + EPS);
#pragma unroll
    for (int j = 0; j < 8; ++j) { const int idx = j * 256 + lane * 4; const f32x4 gg = *(const f32x4*)(g_final + idx);
        *(f32x4*)(out + (size_t)m * D + idx) = (f32x4){v[j].x * rstd * gg.x, v[j].y * rstd * gg.y, v[j].z * rstd * gg.z, v[j].w * rstd * gg.w}; }
}


constexpr int TAB_OFF = MISC_OFF + 128;
__device__ __forceinline__ const LAS int* build_expert_table(const Ctx& c, const unsigned* cnt) {
    LAS int* tab = (LAS int*)(c.lds + TAB_OFF);
    if (c.tid < 64) {
        const int n = c.lane < NE ? (int)cnt[c.lane] : 0; int t = (n + 255) / 256, incl = t;
#pragma unroll
        for (int o = 1; o < 32; o <<= 1) { const int v = __shfl_up(incl, o); if (c.lane >= o) incl += v; }
        if (c.lane < NE) tab[c.lane + 1] = incl;
        if (c.lane == 0) tab[0] = 0;
    }
    __syncthreads();
    return tab;
}
constexpr int NPHASE = 10;
struct Args { const float* in[20]; float* out; unsigned char* ws; int ph_lo, ph_hi; };
__global__ void __launch_bounds__(NWAVES * 64, 2) mk_fwd(Args a) {
    extern __shared__ __attribute__((aligned(16))) unsigned char lds_raw[];
    Ctx c;
    c.lds = (LAS unsigned char*)lds_raw;
    c.tid = threadIdx.x; c.lane = c.tid & 63; c.wave = __builtin_amdgcn_readfirstlane(c.tid >> 6);
    c.G = gridDim.x; c.wg = blockIdx.x; c.gw = c.wg * NWAVES + c.wave; c.NGW = c.G * NWAVES;
    volatile LAS unsigned* MISC = (volatile LAS unsigned*)(c.lds + MISC_OFF);
    if (c.tid < 32) MISC[c.tid] = 0u;
    __syncthreads();
    unsigned char* ws = a.ws;
    unsigned* ctl = (unsigned*)(ws + WS_CTL);
    XcdBarrier bar = xcd_barrier_post(ctl + CW_BAR, MISC + 8);
    const float* x = a.in[0]; const float* meta = a.in[1]; const float* g_mix = a.in[2]; const float* w_in = a.in[3];
    const float* conv_w = a.in[4]; const float* g_q = a.in[5]; const float* w_q_up = a.in[6]; const float* g_kv = a.in[7];
    const float* w_kv_up = a.in[8]; const float* g_conv = a.in[9]; const float* g_attn = a.in[10]; const float* w_out = a.in[11];
    const float* g_ffn = a.in[12]; const float* w_router = a.in[13]; const float* b_router = a.in[14]; const float* w_gu = a.in[15];
    const float* b_gu = a.in[16]; const float* w_d = a.in[17]; const float* b_d = a.in[18]; const float* g_final = a.in[19];
    bf16* Win = (bf16*)(ws + WS_WIN); bf16* Wq = (bf16*)(ws + WS_WQ); bf16* Wkv = (bf16*)(ws + WS_WKV); bf16* Wout = (bf16*)(ws + WS_WOUT); bf16* Wgu = (bf16*)(ws + WS_WGU); bf16* Wd = (bf16*)(ws + WS_WD);
    bf16* hn = (bf16*)(ws + WS_HN); bf16* proj = (bf16*)(ws + WS_PROJ); bf16* mixed = (bf16*)(ws + WS_MIXED); bf16* qn = (bf16*)(ws + WS_QN); bf16* kvn = (bf16*)(ws + WS_KVN);
    float* qraw = (float*)(ws + WS_QRAW); bf16* Q = (bf16*)(ws + WS_Q); bf16* Kn = (bf16*)(ws + WS_KN); bf16* V = (bf16*)(ws + WS_V); bf16* Kpe = (bf16*)(ws + WS_KPE);
    float* h1 = (float*)(ws + WS_H1); bf16* xn = (bf16*)(ws + WS_XN); int* tok_e = (int*)(ws + WS_TOKE); int* tok_p = (int*)(ws + WS_TOKP); float* gate = (float*)(ws + WS_GATE);
    int* rowtok = (int*)(ws + WS_ROWTOK); bf16* act = (bf16*)(ws + WS_ACT); bf16* y = (bf16*)(ws + WS_Y);
    unsigned* cnt = ctl + CW_CNT;

    const int lo = a.ph_lo, hi = a.ph_hi;
#define IN(k) (lo <= (k) && (k) < hi)
#define SEAM(k) do { if (IN(k) && IN((k) + 1)) xcd_barrier(bar); } while (0)

    if (IN(0)) {
        transpose_all<0>(c, w_in, D, DIN, DINP, 1, Win);
        for (int i = c.gw * 64 + c.lane; i < (DINP - DIN) * D / 8; i += c.NGW * 64) ((u32x4*)(Win + (size_t)DIN * D))[i] = (u32x4){0u, 0u, 0u, 0u};
        transpose_all<0>(c, w_q_up, QL, 1536, 1536, 1, Wq);
        transpose_all<0>(c, w_kv_up, KVL, 2048, 2048, 1, Wkv);
        transpose_all<0>(c, w_out, D, D, D, 1, Wout);
        transpose_all<1>(c, w_gu, D, 4096, 4096, NE, Wgu);
        transpose_all<0>(c, w_d, DFF, D, D, NE, Wd);
        for (int R = c.gw; R < MR; R += c.NGW) norm1_row(R, c.lane, x, meta, g_mix, hn);
    }
    SEAM(0);
    if (IN(1)) {
        pg8::Gemm g{hn, D}; pg8::PlainSched Sc; Sc.init(Win, M, DINP, D, c.G, c.wg);
        pg8::gemm_phase<pg8::EpiStoreBf16, pg8::PlainSched, true>(c.lds, g, Sc, pg8::EpiStoreBf16{proj, DINP});
        gemm_simple(c, hn + (size_t)M * D, D, Win, D, D, 1, DINP / 32, EpiProj{proj, M});
    }
    SEAM(1);
    if (IN(2)) { for (int R = c.gw; R < MR; R += c.NGW) postproj_row(R, c.lane, proj, conv_w, g_conv, g_q, g_kv, mixed, qn, kvn, Kpe); }
    SEAM(2);
    if (IN(3)) { gemm_simple(c, qn, QL, Wq, QL, QL, M / 32, 1536 / 32, EpiQraw{qraw}); gemm_simple(c, kvn, KVL, Wkv, KVL, KVL, MRP / 32, 2048 / 32, EpiKV{Kn, V}); }
    SEAM(3);
    if (IN(4)) { for (int m = c.gw; m < M; m += c.NGW) rope_q_row(m, c.lane, qraw, Q); }
    SEAM(4);
    if (IN(5)) { for (int w = c.gw; w < M * NH; w += c.NGW) attn_simple_row(w, c.lane, Q, Kn, Kpe, V, g_attn, mixed); }
    SEAM(5);
    if (IN(6)) {
        pg8::Gemm g{mixed, D}; pg8::PlainSched Sc; Sc.init(Wout, M, D, D, c.G, c.wg);
        pg8::gemm_phase<pg8::EpiResF32, pg8::PlainSched, true>(c.lds, g, Sc, pg8::EpiResF32{x, h1, D});
    }
    SEAM(6);
    if (IN(7)) { for (int m = c.gw; m < M; m += c.NGW) router_row(m, c.lane, h1, g_ffn, w_router, b_router, xn, cnt, rowtok, tok_e, tok_p, gate); }
    SEAM(7);
    if (IN(8)) {
        const LAS int* tab = build_expert_table(c, cnt);
        pg8::Gemm g{xn, D}; pg8::MoeSched<true> Sc{Wgu, (size_t)4096 * D * 2, cnt, rowtok, tab, D, 16, c.G, c.wg};
        pg8::gemm_phase<pg8::EpiMoe1, pg8::MoeSched<true>, true>(c.lds, g, Sc, pg8::EpiMoe1{act, b_gu});
    }
    SEAM(8);
    if (IN(9)) {
        const LAS int* tab = build_expert_table(c, cnt);
        pg8::Gemm g{act, DFF}; pg8::MoeSched<false> Sc{Wd, (size_t)D * DFF * 2, cnt, rowtok, tab, DFF, 8, c.G, c.wg};
        pg8::gemm_phase<pg8::EpiMoe2, pg8::MoeSched<false>, true>(c.lds, g, Sc, pg8::EpiMoe2{y, b_d});
    }
    SEAM(9);
    if (IN(10)) { for (int m = c.gw; m < M; m += c.NGW) combine_row(m, c.lane, h1, y, cnt, tok_e, tok_p, gate, g_final, a.out); }
#undef IN
#undef SEAM
}

extern "C" void kernel_launch(void* const* d_in, const int* in_sizes, int n_in, void* d_out, int out_size, void* d_ws, size_t ws_size, hipStream_t stream) {
    static int grid = 0;
    if (grid == 0) {
        if (n_in != 20 || ws_size < WS_END) { fprintf(stderr, "kernel_launch: unexpected n_in %d / ws %zu (need %zu)\n", n_in, ws_size, (size_t)WS_END); grid = -1; return; }
        int dev = 0, cus = 0, per_cu = 0;
        if (hipGetDevice(&dev) != hipSuccess || hipDeviceGetAttribute(&cus, hipDeviceAttributeMultiprocessorCount, dev) != hipSuccess) { grid = -1; return; }
        if (hipFuncSetAttribute((const void*)mk_fwd, hipFuncAttributeMaxDynamicSharedMemorySize, LDS_BYTES) != hipSuccess) { fprintf(stderr, "kernel_launch: hipFuncSetAttribute failed\n"); grid = -1; return; }
        if (hipOccupancyMaxActiveBlocksPerMultiprocessor(&per_cu, (const void*)mk_fwd, NWAVES * 64, LDS_BYTES) != hipSuccess || per_cu < 1) { fprintf(stderr, "kernel_launch: occupancy query says %d\n", per_cu); (void)hipGetLastError(); grid = -1; return; }
        grid = cus;
    }
    if (grid < 0) return;
    if (hipMemsetAsync((char*)d_ws + WS_CTL, 0, CTL_BYTES, stream) != hipSuccess) return;
    Args a{};
    for (int i = 0; i < 20; ++i) a.in[i] = (const float*)d_in[i];
    a.out = (float*)d_out; a.ws = (unsigned char*)d_ws; a.ph_lo = 0; a.ph_hi = NPHASE + 1;
    hipLaunchKernelGGL(mk_fwd, dim3(grid), dim3(NWAVES * 64), LDS_BYTES, stream, a);
}
```

```cpp
#include <hip/hip_runtime.h>
#include <cstdint>
#include <cstdio>

typedef unsigned short bf16;
typedef short bf16x8 __attribute__((ext_vector_type(8)));
typedef float f32x4 __attribute__((ext_vector_type(4)));
typedef unsigned u32x4 __attribute__((ext_vector_type(4)));
typedef unsigned u32x2 __attribute__((ext_vector_type(2)));

constexpr int D = 2048, NB = 2, S = 4096, NMETA = 16, M = NB * S;
constexpr int MR = M + NMETA;
constexpr int MRP = 8256;
constexpr int DCONV = 1024, QL = 512, KVL = 256, ROPE = 64, NH = 8, DN = 128, DV = 128, DQK = 192;
constexpr int DIN = 3904, DINP = 4096;
constexpr int O_C = 1024, O_U = 2048, O_Q = 3072, O_KV = 3584, O_R = 3840;
constexpr int NE = 32, TOPK = 4, DFF = 2048;
constexpr int LP = 4224;
constexpr int RP = 41216;
constexpr float EPS = 1e-6f;

constexpr size_t MiB = 1u << 20;
constexpr size_t WS_CTL = 0, CTL_BYTES = 1 * MiB;
constexpr size_t WS_WIN = 2 * MiB;
constexpr size_t WS_WQ = WS_WIN + 16 * MiB;
constexpr size_t WS_WKV = WS_WQ + 2 * MiB;
constexpr size_t WS_WOUT = WS_WKV + 2 * MiB;
constexpr size_t WS_WGU = WS_WOUT + 8 * MiB;
constexpr size_t WS_WD = WS_WGU + 512 * MiB;
constexpr size_t WS_HN = WS_WD + 256 * MiB;
constexpr size_t WS_PROJ = WS_HN + 34 * MiB;
constexpr size_t WS_MIXED = WS_PROJ + 66 * MiB;
constexpr size_t WS_QN = WS_MIXED + 32 * MiB;
constexpr size_t WS_KVN = WS_QN + 8 * MiB;
constexpr size_t WS_QRAW = WS_KVN + 6 * MiB;
constexpr size_t WS_Q = WS_QRAW + 48 * MiB;
constexpr size_t WS_KN = WS_Q + 24 * MiB;
constexpr size_t WS_V = WS_KN + 18 * MiB;
constexpr size_t WS_KPE = WS_V + 18 * MiB;
constexpr size_t WS_H1 = WS_KPE + 2 * MiB;
constexpr size_t WS_XN = WS_H1 + 64 * MiB;
constexpr size_t WS_TOKE = WS_XN + 32 * MiB;
constexpr size_t WS_TOKP = WS_TOKE + 1 * MiB;
constexpr size_t WS_GATE = WS_TOKP + 1 * MiB;
constexpr size_t WS_ROWTOK = WS_GATE + 1 * MiB;
constexpr size_t WS_ACT = WS_ROWTOK + 1 * MiB;
constexpr size_t WS_Y = WS_ACT + 162 * MiB;
constexpr size_t WS_END = WS_Y + 162 * MiB;
constexpr int CW_CNT = 64;
constexpr int CW_BAR = 4096;

__device__ __forceinline__ float bf2f(bf16 v) { return __uint_as_float((unsigned)v << 16); }
__device__ __forceinline__ bf16 f2bf(float f) { unsigned u = __float_as_uint(f); return (bf16)((u + 0x7fffu + ((u >> 16) & 1u)) >> 16); }
__device__ __forceinline__ float wave_sum(float v) {
#pragma unroll
    for (int o = 1; o < 64; o <<= 1) v += __shfl_xor(v, o);
    return v;
}
__device__ __forceinline__ float wave_max(float v) {
#pragma unroll
    for (int o = 1; o < 64; o <<= 1) v = fmaxf(v, __shfl_xor(v, o));
    return v;
}
__device__ __forceinline__ void unpack8(const u32x4 w, float (&f)[8]) {
    f[0] = __uint_as_float(w.x << 16); f[1] = __uint_as_float(w.x & 0xffff0000u);
    f[2] = __uint_as_float(w.y << 16); f[3] = __uint_as_float(w.y & 0xffff0000u);
    f[4] = __uint_as_float(w.z << 16); f[5] = __uint_as_float(w.z & 0xffff0000u);
    f[6] = __uint_as_float(w.w << 16); f[7] = __uint_as_float(w.w & 0xffff0000u);
}
__device__ __forceinline__ unsigned pk2(float lo, float hi) { return (unsigned)f2bf(lo) | ((unsigned)f2bf(hi) << 16); }


#define GAS __attribute__((address_space(1)))
#define LAS __attribute__((address_space(3)))
#define LDS_WAIT() asm volatile("s_waitcnt lgkmcnt(0)" ::: "memory")
#define VM_WAIT() asm volatile("s_waitcnt vmcnt(0)" ::: "memory")
constexpr int NWAVES = 8;
constexpr int LDS_BYTES = 147456;
constexpr int RING_BYTES = 131072, MISC_OFF = RING_BYTES + 320;

#define XB_TMO      128
#define XB_XCNT(j)  (256  + 64 * (j))
#define XB_XSUB(j)  (1280 + 64 * (j))
#define XB_XGEN(j)  (2304 + 64 * (j))
#define XB_TOP      3328
#define XB_TOPGEN   3392
#define XCD_BAR_WORDS 3456
#define XB_SPIN_CAP (1u << 18)

__device__ __forceinline__ unsigned xb_ld(unsigned* p)              { return __hip_atomic_load(p, __ATOMIC_RELAXED, __HIP_MEMORY_SCOPE_AGENT); }
__device__ __forceinline__ unsigned xb_add(unsigned* p, unsigned v) { return __hip_atomic_fetch_add(p, v, __ATOMIC_RELAXED, __HIP_MEMORY_SCOPE_AGENT); }
__device__ __forceinline__ unsigned xb_xcc_id() { return (unsigned)__builtin_amdgcn_s_getreg((3 << 11) | 20) & 0xFu; }
#define XB_SPIN(cond, bar) do { unsigned _sp = 0; while (cond) { __builtin_amdgcn_s_sleep(1); \
    if ((++_sp & 255u) == 0u) { if (xb_ld(&(bar)[XB_TMO])) break; if (_sp > XB_SPIN_CAP) { atomicAdd(&(bar)[XB_TMO], 1u); break; } } } } while (0)

struct XcdBarrier {
    unsigned* bar; unsigned x;
    volatile LAS unsigned* st;
};
__device__ __forceinline__ XcdBarrier xcd_barrier_post(unsigned* bar, volatile LAS unsigned* st) {
    XcdBarrier b; b.bar = bar; b.x = xb_xcc_id(); b.st = st;
    if (threadIdx.x == 0) (void)xb_add(&bar[XB_XCNT(b.x)], 1u);
    return b;
}
__device__ __forceinline__ void xcd_barrier_complete(unsigned* bar, unsigned x, unsigned& nloc, unsigned& nx) {
    const unsigned G = gridDim.x * gridDim.y * gridDim.z;
    unsigned sum, cnt, mine, sp = 0u;
    for (;;) {
        sum = 0u; cnt = 0u; mine = 0u;
#pragma unroll
        for (unsigned j = 0; j < 16; ++j) { const unsigned c = xb_ld(&bar[XB_XCNT(j)]); sum += c; cnt += (c > 0u) ? 1u : 0u; mine = (j == x) ? c : mine; }
        if (sum == G) break;
        __builtin_amdgcn_s_sleep(1);
        if ((++sp & 255u) == 0u) { if (xb_ld(&bar[XB_TMO])) break; if (sp > XB_SPIN_CAP) { atomicAdd(&bar[XB_TMO], 1u); break; } }
    }
    nloc = mine > 0u ? mine : 1u; nx = cnt > 0u ? cnt : 1u;
}
__device__ __forceinline__ void xcd_barrier(const XcdBarrier& b) {
    asm volatile("s_waitcnt vmcnt(0)" ::: "memory");
    __syncthreads();
    if (threadIdx.x == 0) {
        unsigned* bar = b.bar;
        __builtin_amdgcn_s_waitcnt(0);
        unsigned nloc = b.st[0], nx = b.st[1];
        if (nloc == 0u) { xcd_barrier_complete(bar, b.x, nloc, nx); b.st[0] = nloc; b.st[1] = nx; }
        const unsigned old = xb_add(&bar[XB_XSUB(b.x)], 1u);
        const unsigned gen = old / nloc;
        if (old + 1u == (gen + 1u) * nloc) {
            __builtin_amdgcn_fence(__ATOMIC_RELEASE, "agent");
            asm volatile("s_waitcnt vmcnt(0)" ::: "memory");
            const unsigned og = xb_add(&bar[XB_TOP], 1u);
            const unsigned tg = og / nx;
            if (og + 1u == (tg + 1u) * nx) xb_add(&bar[XB_TOPGEN], 1u);
            else XB_SPIN(xb_ld(&bar[XB_TOPGEN]) == tg, bar);
            __builtin_amdgcn_fence(__ATOMIC_ACQUIRE, "agent");
            xb_add(&bar[XB_XGEN(b.x)], 1u);
            asm volatile("s_waitcnt vmcnt(0)" ::: "memory");
        } else {
            XB_SPIN(xb_ld(&bar[XB_XGEN(b.x)]) == gen, bar);
            __builtin_amdgcn_fence(__ATOMIC_ACQUIRE, "agent");
            asm volatile("s_waitcnt vmcnt(0)" ::: "memory");
        }
    }
    __syncthreads();
}

namespace pg8 {
constexpr int BM = 256, BK = 64, HALF = 128, HTB = HALF * BK * 2  , STAGE_BYTES = 8 * HTB, NXCD = 8, WGM = 8;
__host__ __device__ __forceinline__ int lds_byte(int r, int c) { const int st = (r >> 4) * 2 + (c >> 5), rr = r & 15, cc = c & 31, ob = rr * 64 + cc * 2; return st * 1024 + (ob ^ (((ob >> 9) & 1) << 5)); }
__host__ __device__ __forceinline__ void stage_rc(int b, int& R, int& C) { const int st = b / 1024, sb = b % 1024, swz = sb ^ (((sb >> 9) & 1) << 5); R = (st >> 1) * 16 + swz / 64; C = (st & 1) * 32 + (swz % 64) / 2; }
__host__ __device__ __forceinline__ int perm32(int rho) { const int n = rho >> 4, i = rho & 15; return 8 * (i >> 2) + 4 * n + (i & 3); }

struct Unit { int pm, pn, e, nrows; };
struct Gemm { const bf16* A; int K; };

__device__ __forceinline__ unsigned cvt_pk_bf16(float lo, float hi) { unsigned r; asm volatile("v_cvt_pk_bf16_f32 %0, %1, %2" : "=v"(r) : "v"(lo), "v"(hi)); return r; }

template <class Epi, class Sched, bool ALIGN_EPI>
__device__ __forceinline__ void gemm_phase(LAS unsigned char* lds, const Gemm g, const Sched& S, const Epi& E) {
    const int tid = threadIdx.x, wid = __builtin_amdgcn_readfirstlane(tid >> 6), lane = tid & 63, wr = wid >> 2, wc = wid & 3, fr = lane & 15, fq = lane >> 4;
    const int K = g.K, nt = K / BK;
    int sR[2], sC[2]; unsigned voffB[2];
#pragma unroll
    for (int i = 0; i < 2; ++i) { stage_rc(tid * 16 + i * 8192, sR[i], sC[i]); const int Rb = Epi::PERM ? ((sR[i] & ~31) + perm32(sR[i] & 31)) : sR[i]; voffB[i] = (unsigned)(Rb * K + sC[i]) * 2u; }
    const size_t kstep = (size_t)(BK * 2);
    const size_t hstep = (size_t)HALF * K * 2;
    const unsigned ldsw = (unsigned)wid * 1024u;
    const int aoff = lds_byte(wr * 64 + fr, fq * 8), boff = lds_byte(wc * 32 + fr, fq * 8);
    const char* Ab = (const char*)g.A;
#define PG8_SA(b, h) (((b) * 2 + (h)) * HTB)
#define PG8_SB(b, h) ((4 + (b) * 2 + (h)) * HTB)
#define PG8_STAGE(bufoff, gbase, voff) do { _Pragma("unroll") for (int _i = 0; _i < 2; ++_i) \
        __builtin_amdgcn_global_load_lds((const unsigned*)((const char*)(gbase) + (voff)[_i]), (LAS unsigned*)(lds + (bufoff) + ldsw + _i * 8192), 16, 0, 0); } while (0)
#define PG8_LDA(dst, b, h) do { _Pragma("unroll") for (int m = 0; m < 4; ++m) _Pragma("unroll") for (int k = 0; k < 2; ++k) dst[m][k] = *(const LAS bf16x8*)(lds + PG8_SA(b, h) + aoff + m * 2048 + k * 1024); } while (0)
#define PG8_LDB(dst, b, h) do { _Pragma("unroll") for (int n = 0; n < 2; ++n) _Pragma("unroll") for (int k = 0; k < 2; ++k) dst[n][k] = *(const LAS bf16x8*)(lds + PG8_SB(b, h) + boff + n * 2048 + k * 1024); } while (0)
#define PG8_MMA(ai, bj, At, Bt) do { __builtin_amdgcn_s_setprio(1); _Pragma("unroll") for (int m = 0; m < 4; ++m) _Pragma("unroll") for (int n = 0; n < 2; ++n) _Pragma("unroll") for (int k = 0; k < 2; ++k) \
        acc[ai][bj][m][n] = __builtin_amdgcn_mfma_f32_16x16x32_bf16(Bt[n][k], At[m][k], acc[ai][bj][m][n], 0, 0, 0); __builtin_amdgcn_s_setprio(0); } while (0)
#define PG8_WAIT_V(n) asm volatile("s_waitcnt vmcnt(" #n ")" ::: "memory")
#define PG8_WAIT_L(n) asm volatile("s_waitcnt lgkmcnt(" #n ")" ::: "memory")
#define PG8_BAR __builtin_amdgcn_s_barrier()
#define PG8_SCHED __builtin_amdgcn_sched_barrier(0)
    Unit cur, nxt; int ui = 0;
    if (!S.next(0, cur)) return;
    f32x4 acc[2][2][4][2];
#pragma unroll
    for (int a = 0; a < 2; ++a)
#pragma unroll
        for (int b = 0; b < 2; ++b)
#pragma unroll
            for (int m = 0; m < 4; ++m)
#pragma unroll
                for (int n = 0; n < 2; ++n) acc[a][b][m][n] = (f32x4){0.f, 0.f, 0.f, 0.f};
    bf16x8 At[4][2], B0[2][2], B1[2][2];
    unsigned ao[2][2], an[2][2];
    S.a_off(cur, sR, sC, ao);
    const char* cB = S.b_base(cur);
    PG8_STAGE(PG8_SB(0, 0), cB, voffB); PG8_STAGE(PG8_SB(0, 1), cB + hstep, voffB); PG8_STAGE(PG8_SA(0, 0), Ab, ao[0]); PG8_STAGE(PG8_SA(0, 1), Ab, ao[1]);
    if (wr == 1) PG8_BAR;
    PG8_WAIT_V(2); PG8_BAR;
    PG8_STAGE(PG8_SB(1, 0), cB + kstep, voffB); PG8_STAGE(PG8_SA(1, 0), Ab + kstep, ao[0]); PG8_STAGE(PG8_SB(1, 1), cB + hstep + kstep, voffB);
    PG8_WAIT_V(6); PG8_BAR;
    for (;;) {
        const bool has_next = S.next(ui + 1, nxt);
        const char* nB = cB;
        if (has_next) { S.a_off(nxt, sR, sC, an); nB = S.b_base(nxt); }
        else { an[0][0] = ao[0][0]; an[0][1] = ao[0][1]; an[1][0] = ao[1][0]; an[1][1] = ao[1][1]; }
        for (int t = 0; t < nt; t += 2) {
            const bool last = (t == nt - 2);
            const char* a1 = Ab + (size_t)(t + 1) * kstep;
            PG8_LDB(B0, 0, 0); PG8_LDB(B1, 0, 1); PG8_SCHED; PG8_LDA(At, 0, 0); PG8_STAGE(PG8_SA(1, 1), a1, ao[1]);
            PG8_WAIT_V(8); PG8_WAIT_L(0); PG8_BAR; PG8_MMA(0, 0, At, B0); PG8_MMA(0, 1, At, B1); PG8_BAR; PG8_SCHED;
            const char* a2 = last ? Ab : Ab + (size_t)(t + 2) * kstep; const char* b2 = last ? nB : cB + (size_t)(t + 2) * kstep;
            if (last) { ao[0][0] = an[0][0]; ao[0][1] = an[0][1]; ao[1][0] = an[1][0]; ao[1][1] = an[1][1]; }
            const char* a3 = a2 + kstep; const char* b3 = b2 + kstep;
            PG8_LDA(At, 0, 1); PG8_STAGE(PG8_SB(0, 0), b2, voffB); PG8_STAGE(PG8_SB(0, 1), b2 + hstep, voffB); PG8_STAGE(PG8_SA(0, 0), a2, ao[0]);
            PG8_WAIT_V(8); PG8_WAIT_L(0); PG8_BAR; PG8_MMA(1, 0, At, B0); PG8_MMA(1, 1, At, B1); PG8_BAR; PG8_SCHED;
            PG8_LDB(B0, 1, 0); PG8_LDB(B1, 1, 1); PG8_SCHED; PG8_LDA(At, 1, 0); PG8_STAGE(PG8_SA(0, 1), a2, ao[1]);
            PG8_WAIT_V(8); PG8_WAIT_L(0); PG8_BAR; PG8_MMA(0, 0, At, B0); PG8_MMA(0, 1, At, B1); PG8_BAR; PG8_SCHED;
            PG8_LDA(At, 1, 1); PG8_STAGE(PG8_SB(1, 0), b3, voffB); PG8_STAGE(PG8_SB(1, 1), b3 + hstep, voffB); PG8_STAGE(PG8_SA(1, 0), a3, ao[0]);
            PG8_WAIT_V(8); PG8_WAIT_L(0); PG8_BAR; PG8_MMA(1, 0, At, B0); PG8_MMA(1, 1, At, B1); PG8_BAR; PG8_SCHED;
        }
        if constexpr (ALIGN_EPI) { if (wr == 0) PG8_BAR; }
        E(acc, cur, wr, wc, fr, fq);
        if (!has_next) break;
#pragma unroll
        for (int a = 0; a < 2; ++a)
#pragma unroll
            for (int b = 0; b < 2; ++b)
#pragma unroll
                for (int m = 0; m < 4; ++m)
#pragma unroll
                    for (int n = 0; n < 2; ++n) acc[a][b][m][n] = (f32x4){0.f, 0.f, 0.f, 0.f};
        cur = nxt; cB = nB; ++ui;
        if constexpr (ALIGN_EPI) { if (wr == 1) PG8_BAR; }
    }
    PG8_WAIT_V(0);
    if constexpr (!ALIGN_EPI) { if (wr == 0) PG8_BAR; }
    PG8_BAR;
#undef PG8_SA
#undef PG8_SB
#undef PG8_STAGE
#undef PG8_LDA
#undef PG8_LDB
#undef PG8_MMA
#undef PG8_WAIT_V
#undef PG8_WAIT_L
#undef PG8_BAR
#undef PG8_SCHED
}

struct PlainSched {
    const bf16* Bt; int K, nM, nN, nwg, G, c;
    __device__ void init(const bf16* Bt_, int M_, int N_, int K_, int G_, int c_) { Bt = Bt_; K = K_; nM = M_ / BM; nN = N_ / BM; nwg = nM * nN; G = G_; c = c_; }
    __device__ __forceinline__ bool next(int i, Unit& u) const {
        const long L = (long)i * G + c; if (L >= nwg) return false;
        int wgid = (int)L; { const int q = nwg / NXCD, r = nwg % NXCD, xcd = wgid % NXCD, off = wgid / NXCD; wgid = (xcd < r ? xcd * (q + 1) : r * (q + 1) + (xcd - r) * q) + off; }
        const int nig = WGM * nN, gid = wgid / nig, fm = gid * WGM, gsz = (nM - fm) < WGM ? (nM - fm) : WGM;
        u.pm = fm + ((wgid % nig) % gsz); u.pn = (wgid % nig) / gsz; u.e = 0; u.nrows = BM; return true;
    }
    __device__ __forceinline__ void a_off(const Unit& u, const int (&R)[2], const int (&C)[2], unsigned (&off)[2][2]) const {
#pragma unroll
        for (int h = 0; h < 2; ++h)
#pragma unroll
            for (int i = 0; i < 2; ++i) off[h][i] = (unsigned)(((u.pm * BM + h * HALF + R[i]) * K + C[i]) * 2);
    }
    __device__ __forceinline__ const char* b_base(const Unit& u) const { return (const char*)Bt + (size_t)u.pn * BM * K * 2; }
};

struct EpiStoreBf16 {
    static constexpr bool PERM = true;
    bf16* O; int ldc;
    __device__ __forceinline__ void operator()(const f32x4 (&acc)[2][2][4][2], const Unit& u, int wr, int wc, int fr, int fq) const {
        const int row0 = u.pm * BM + wr * 64 + fr, col0 = u.pn * BM + wc * 32 + 8 * fq;
#pragma unroll
        for (int ai = 0; ai < 2; ++ai)
#pragma unroll
            for (int m = 0; m < 4; ++m) { bf16* rowp = O + (size_t)(row0 + ai * HALF + m * 16) * ldc + col0;
#pragma unroll
                for (int bj = 0; bj < 2; ++bj) { const f32x4 v0 = acc[ai][bj][m][0], v1 = acc[ai][bj][m][1];
                    u32x4 w; w.x = cvt_pk_bf16(v0[0], v0[1]); w.y = cvt_pk_bf16(v0[2], v0[3]); w.z = cvt_pk_bf16(v1[0], v1[1]); w.w = cvt_pk_bf16(v1[2], v1[3]);
                    *(u32x4*)(rowp + bj * HALF) = w; } }
    }
};
struct EpiResF32 {
    static constexpr bool PERM = false;
    const float* base; float* out; int ldc;
    __device__ __forceinline__ void operator()(const f32x4 (&acc)[2][2][4][2], const Unit& u, int wr, int wc, int fr, int fq) const {
        const int row0 = u.pm * BM + wr * 64 + fr, col0 = u.pn * BM + wc * 32 + 4 * fq;
#pragma unroll
        for (int ai = 0; ai < 2; ++ai)
#pragma unroll
            for (int m = 0; m < 4; ++m) { const size_t off = (size_t)(row0 + ai * HALF + m * 16) * ldc + col0;
#pragma unroll
                for (int bj = 0; bj < 2; ++bj)
#pragma unroll
                    for (int n = 0; n < 2; ++n) { const f32x4 b = *(const f32x4*)(base + off + bj * HALF + n * 16); *(f32x4*)(out + off + bj * HALF + n * 16) = b + acc[ai][bj][m][n]; } }
    }
};
template <bool GATHER>
struct MoeSched {
    const bf16* W; size_t wbytes;
    const unsigned* cnt; const int* rowtok; const LAS int* tab;
    int K, nN, G, c;
    __device__ __forceinline__ bool next(int i, Unit& u) const {
        const int total = tab[32] * nN; const int L = i * G + c; if (L >= total) return false;
        const int gt = L / nN; int e = 0;
#pragma unroll
        for (int j = 1; j < 32; ++j) e += (gt >= tab[j]) ? 1 : 0;
        e = __builtin_amdgcn_readfirstlane(e);
        u.pm = __builtin_amdgcn_readfirstlane(gt); u.pn = __builtin_amdgcn_readfirstlane(L % nN); u.e = e;
        u.nrows = __builtin_amdgcn_readfirstlane((int)cnt[e] - (gt - tab[e]) * BM);
        return true;
    }
    __device__ __forceinline__ void a_off(const Unit& u, const int (&R)[2], const int (&C)[2], unsigned (&off)[2][2]) const {
#pragma unroll
        for (int h = 0; h < 2; ++h)
#pragma unroll
            for (int i = 0; i < 2; ++i) {
                if (GATHER) { const int lt = (u.pm - tab[u.e]) * BM; int li = h * HALF + R[i]; li = li < u.nrows ? li : u.nrows - 1;
                    const int tok = rowtok[u.e * M + lt + li]; off[h][i] = (unsigned)((tok * K + C[i]) * 2); }
                else off[h][i] = (unsigned)(((u.pm * BM + h * HALF + R[i]) * K + C[i]) * 2);
            }
    }
    __device__ __forceinline__ const char* b_base(const Unit& u) const { return (const char*)W + (size_t)u.e * wbytes + (size_t)u.pn * BM * K * 2; }
};
struct EpiMoe1 {
    static constexpr bool PERM = true;
    bf16* act; const float* b_gu;
    __device__ __forceinline__ void operator()(const f32x4 (&acc)[2][2][4][2], const Unit& u, int wr, int wc, int fr, int fq) const {
        const int row0 = u.pm * BM + wr * 64 + fr, cc = u.pn * HALF + wc * 32 + 8 * fq;
        const float* bias = b_gu + (size_t)u.e * 4096 + cc;
        const f32x4 bg0 = *(const f32x4*)(bias), bg1 = *(const f32x4*)(bias + 4), bl0 = *(const f32x4*)(bias + 2048), bl1 = *(const f32x4*)(bias + 2048 + 4);
#pragma unroll
        for (int ai = 0; ai < 2; ++ai)
#pragma unroll
            for (int m = 0; m < 4; ++m) {
                f32x4 o[2];
#pragma unroll
                for (int n = 0; n < 2; ++n) { const f32x4 gv = acc[ai][0][m][n] + (n ? bg1 : bg0), lv = acc[ai][1][m][n] + (n ? bl1 : bl0);
#pragma unroll
                    for (int j = 0; j < 4; ++j) { const float g = fminf(gv[j], 7.0f), l = fminf(fmaxf(lv[j], -7.0f), 7.0f);
                        o[n][j] = (l + 1.0f) * g * __builtin_amdgcn_rcpf(1.0f + __builtin_amdgcn_exp2f(-1.702f * 1.4426950408889634f * g)); } }
                u32x4 w; w.x = cvt_pk_bf16(o[0][0], o[0][1]); w.y = cvt_pk_bf16(o[0][2], o[0][3]); w.z = cvt_pk_bf16(o[1][0], o[1][1]); w.w = cvt_pk_bf16(o[1][2], o[1][3]);
                *(u32x4*)(act + (size_t)(row0 + ai * HALF + m * 16) * DFF + cc) = w;
            }
    }
};
struct EpiMoe2 {
    static constexpr bool PERM = true;
    bf16* y; const float* b_d;
    __device__ __forceinline__ void operator()(const f32x4 (&acc)[2][2][4][2], const Unit& u, int wr, int wc, int fr, int fq) const {
        const int row0 = u.pm * BM + wr * 64 + fr, col0 = u.pn * BM + wc * 32 + 8 * fq;
        const float* bias = b_d + (size_t)u.e * D + col0;
        f32x4 bv[2][2];
#pragma unroll
        for (int bj = 0; bj < 2; ++bj)
#pragma unroll
            for (int n = 0; n < 2; ++n) bv[bj][n] = *(const f32x4*)(bias + bj * HALF + 4 * n);
#pragma unroll
        for (int ai = 0; ai < 2; ++ai)
#pragma unroll
            for (int m = 0; m < 4; ++m) { bf16* rowp = y + (size_t)(row0 + ai * HALF + m * 16) * D + col0;
#pragma unroll
                for (int bj = 0; bj < 2; ++bj) { const f32x4 v0 = acc[ai][bj][m][0] + bv[bj][0], v1 = acc[ai][bj][m][1] + bv[bj][1];
                    u32x4 w; w.x = cvt_pk_bf16(v0[0], v0[1]); w.y = cvt_pk_bf16(v0[2], v0[3]); w.z = cvt_pk_bf16(v1[0], v1[1]); w.w = cvt_pk_bf16(v1[2], v1[3]);
                    *(u32x4*)(rowp + bj * HALF) = w; } }
    }
};
}

namespace att {
typedef float f32x16 __attribute__((ext_vector_type(16)));
constexpr int KPITCH = 400, VPITCH = 144;
constexpr int KBYTES = 64 * KPITCH, VBYTES = 128 * VPITCH, STAGE = KBYTES + VBYTES;
constexpr int WSF_OFF = 2 * STAGE;
static_assert(WSF_OFF + 8 * 256 <= RING_BYTES, "attention LDS");
constexpr float SC = 0.07216878364870322f * 1.4426950408889634f;

__device__ __forceinline__ int crow(int r, int hi) { return (r & 3) + 8 * (r >> 2) + 4 * hi; }

__device__ __forceinline__ void attn_unit(LAS unsigned char* lds, int b, int h, int qb, const bf16* __restrict__ Q, const bf16* __restrict__ Kn, const bf16* __restrict__ Kpe,
                                          const bf16* __restrict__ Vt, const float* __restrict__ g_attn, bf16* __restrict__ mixed) {
    const int tid = threadIdx.x, lane = tid & 63, r32 = lane & 31, hi = lane >> 5, wid = __builtin_amdgcn_readfirstlane(tid >> 6);
    const int t0 = qb * 256 + wid * 32;
    const int m0 = b * S + t0;
    const int wave_max_pos = t0 + 31 + NMETA, wave_min_pos = t0 + NMETA;
    const int NT = (qb * 256 + 255 + NMETA) / 64 + 1;
    LAS float* wsf = (LAS float*)(lds + WSF_OFF) + wid * 64;
    const bf16* ksrc[3]; unsigned kdst[3];
#pragma unroll
    for (int i = 0; i < 3; ++i) { const int id = tid + 512 * i, key = id / 24, c = id % 24;
        ksrc[i] = c < 16 ? Kn + ((size_t)(b * LP + key) * NH + h) * 128 + c * 8 : Kpe + (size_t)(b * LP + key) * ROPE + (c - 16) * 8;
        const int row = (key & ~12) | ((key & 4) << 1) | ((key & 8) >> 1);
        kdst[i] = (unsigned)(row * KPITCH + c * 16); }
    unsigned kstr[3];
#pragma unroll
    for (int i = 0; i < 3; ++i) kstr[i] = ((tid + 512 * i) % 24) < 16 ? 64u * NH * 128 : 64u * ROPE;
    const bf16* vsrc[2]; unsigned vdst[2];
#pragma unroll
    for (int i = 0; i < 2; ++i) { const int id = tid + 512 * i, d = id >> 3, kc = id & 7;
        vsrc[i] = Vt + ((size_t)(b * NH + h) * 128 + d) * LP + kc * 8; vdst[i] = (unsigned)(KBYTES + d * VPITCH + kc * 16); }
    bf16x8 qf[12];
    { const bf16* qp = Q + ((size_t)(m0 + r32) * NH + h) * DQK + 8 * hi;
#pragma unroll
      for (int ks = 0; ks < 12; ++ks) qf[ks] = *(const bf16x8*)(qp + ks * 16); }
    f32x16 o[4];
#pragma unroll
    for (int d = 0; d < 4; ++d)
#pragma unroll
        for (int r = 0; r < 16; ++r) o[d][r] = 0.f;
    float mrow = -INFINITY, lsum = 0.f;
    u32x4 kreg[3], vreg[2];
#pragma unroll
    for (int i = 0; i < 3; ++i) kreg[i] = *(const u32x4*)(ksrc[i]);
#pragma unroll
    for (int i = 0; i < 2; ++i) vreg[i] = *(const u32x4*)(vsrc[i]);
#pragma unroll
    for (int i = 0; i < 3; ++i) *(LAS u32x4*)(lds + kdst[i]) = kreg[i];
#pragma unroll
    for (int i = 0; i < 2; ++i) *(LAS u32x4*)(lds + vdst[i]) = vreg[i];
    __syncthreads();
    for (int t = 0; t < NT; ++t) {
        const bool more = t + 1 < NT;
        if (more) {
#pragma unroll
            for (int i = 0; i < 3; ++i) kreg[i] = *(const u32x4*)(ksrc[i] + (size_t)(t + 1) * kstr[i]);
#pragma unroll
            for (int i = 0; i < 2; ++i) vreg[i] = *(const u32x4*)(vsrc[i] + (size_t)(t + 1) * 64);
        }
        const int kb = t * 64;
        if (kb <= wave_max_pos) {
            const LAS unsigned char* Kb = lds + (t & 1) * STAGE; const LAS unsigned char* Vb = Kb + KBYTES;
            f32x16 p0, p1;
#pragma unroll
            for (int r = 0; r < 16; ++r) { p0[r] = 0.f; p1[r] = 0.f; }
            const LAS unsigned char* kp = Kb + r32 * KPITCH + hi * 16;
#pragma unroll
            for (int ks = 0; ks < 12; ++ks) {
                const bf16x8 k0 = *(const LAS bf16x8*)(kp + ks * 32), k1 = *(const LAS bf16x8*)(kp + 32 * KPITCH + ks * 32);
                p0 = __builtin_amdgcn_mfma_f32_32x32x16_bf16(k0, qf[ks], p0, 0, 0, 0);
                p1 = __builtin_amdgcn_mfma_f32_32x32x16_bf16(k1, qf[ks], p1, 0, 0, 0);
            }
            if (kb + 63 > wave_min_pos) {
                const int qpos = t0 + r32 + NMETA, kbase = kb + 8 * hi;
#pragma unroll
                for (int r = 0; r < 16; ++r) { const int key = kbase + 16 * (r >> 3) + (r & 7); if (key > qpos) p0[r] = -INFINITY; if (key + 32 > qpos) p1[r] = -INFINITY; }
            }
            float mx = fmaxf(p0[0], p1[0]);
#pragma unroll
            for (int r = 1; r < 16; ++r) mx = fmaxf(mx, fmaxf(p0[r], p1[r]));
            mx = fmaxf(mx, __shfl_xor(mx, 32));
            const float mnew = fmaxf(mrow, mx);
            const bool grew = __any(mnew > mrow);
            if (grew) {
                const float corr = __builtin_amdgcn_exp2f((mrow - mnew) * SC);
                lsum *= corr; mrow = mnew;
                if (hi == 0) wsf[r32] = corr;
                asm volatile("s_waitcnt lgkmcnt(0)" ::: "memory");
#pragma unroll
                for (int g = 0; g < 4; ++g) { const f32x4 f = *(const LAS f32x4*)(wsf + 8 * g + 4 * hi);
#pragma unroll
                    for (int d = 0; d < 4; ++d) { o[d][4 * g + 0] *= f.x; o[d][4 * g + 1] *= f.y; o[d][4 * g + 2] *= f.z; o[d][4 * g + 3] *= f.w; } }
            }
            const float nm = -mrow * SC;
            float ps = 0.f;
#pragma unroll
            for (int r = 0; r < 16; ++r) { p0[r] = __builtin_amdgcn_exp2f(__builtin_fmaf(p0[r], SC, nm)); p1[r] = __builtin_amdgcn_exp2f(__builtin_fmaf(p1[r], SC, nm)); ps += p0[r] + p1[r]; }
            lsum += ps;
            u32x4 pa[4];
            pa[0] = (u32x4){pg8::cvt_pk_bf16(p0[0], p0[1]), pg8::cvt_pk_bf16(p0[2], p0[3]), pg8::cvt_pk_bf16(p0[4], p0[5]), pg8::cvt_pk_bf16(p0[6], p0[7])};
            pa[1] = (u32x4){pg8::cvt_pk_bf16(p0[8], p0[9]), pg8::cvt_pk_bf16(p0[10], p0[11]), pg8::cvt_pk_bf16(p0[12], p0[13]), pg8::cvt_pk_bf16(p0[14], p0[15])};
            pa[2] = (u32x4){pg8::cvt_pk_bf16(p1[0], p1[1]), pg8::cvt_pk_bf16(p1[2], p1[3]), pg8::cvt_pk_bf16(p1[4], p1[5]), pg8::cvt_pk_bf16(p1[6], p1[7])};
            pa[3] = (u32x4){pg8::cvt_pk_bf16(p1[8], p1[9]), pg8::cvt_pk_bf16(p1[10], p1[11]), pg8::cvt_pk_bf16(p1[12], p1[13]), pg8::cvt_pk_bf16(p1[14], p1[15])};
            const LAS unsigned char* vp = Vb + r32 * VPITCH + hi * 16;
#pragma unroll
            for (int d = 0; d < 4; ++d)
#pragma unroll
                for (int s = 0; s < 4; ++s) { const bf16x8 vf = *(const LAS bf16x8*)(vp + d * 32 * VPITCH + s * 32);
                    o[d] = __builtin_amdgcn_mfma_f32_32x32x16_bf16(__builtin_bit_cast(bf16x8, pa[s]), vf, o[d], 0, 0, 0); }
        }
        if (more) {
            LAS unsigned char* nb = lds + ((t + 1) & 1) * STAGE;
#pragma unroll
            for (int i = 0; i < 3; ++i) *(LAS u32x4*)(nb + kdst[i]) = kreg[i];
#pragma unroll
            for (int i = 0; i < 2; ++i) *(LAS u32x4*)(nb + vdst[i]) = vreg[i];
        }
        __syncthreads();
    }
    lsum += __shfl_xor(lsum, 32);
    if (hi == 0) wsf[r32] = 1.0f / lsum;
    asm volatile("s_waitcnt lgkmcnt(0)" ::: "memory");
    float ss[16];
#pragma unroll
    for (int g = 0; g < 4; ++g) { const f32x4 f = *(const LAS f32x4*)(wsf + 8 * g + 4 * hi);
#pragma unroll
        for (int j = 0; j < 4; ++j) { const float il = j == 0 ? f.x : j == 1 ? f.y : j == 2 ? f.z : f.w; float a = 0.f;
#pragma unroll
            for (int d = 0; d < 4; ++d) { o[d][4 * g + j] *= il; a += o[d][4 * g + j] * o[d][4 * g + j]; }
            ss[4 * g + j] = a; } }
#pragma unroll
    for (int r = 0; r < 16; ++r) {
#pragma unroll
        for (int of = 1; of < 32; of <<= 1) ss[r] += __shfl_xor(ss[r], of);
        ss[r] = rsqrtf(ss[r] * (1.f / 128.f) + EPS);
    }
    float gv[4];
#pragma unroll
    for (int d = 0; d < 4; ++d) gv[d] = g_attn[h * DV + d * 32 + r32];
#pragma unroll
    for (int r = 0; r < 16; ++r) { bf16* dst = mixed + (size_t)(m0 + crow(r, hi)) * D + DCONV + h * DV + r32;
#pragma unroll
        for (int d = 0; d < 4; ++d) dst[d * 32] = f2bf(o[d][r] * ss[r] * gv[d]); }
    __syncthreads();
}
}

struct Ctx { int lane, wave, tid, gw, NGW, wg, G; LAS unsigned char* lds; };

template <int MODE>
__device__ __forceinline__ void transpose_item(const float* W, int K, int N, bf16* WT, LAS float* scr, int item, int lane) {
    const int nblk = N / 32, kb = item / nblk, nb = item % nblk, k0 = 64 * kb, n0 = 32 * nb;
    int dr0 = n0;
    if (MODE == 1) { const int bj = n0 / 2048, c = n0 % 2048; dr0 = 256 * (c / 128) + 128 * bj + (c % 128); }
#pragma unroll 8
    for (int i = 0; i < 32; ++i) { const int kk = 2 * i + (lane >> 5); scr[kk * 33 + (lane & 31)] = W[(size_t)(k0 + kk) * N + n0 + (lane & 31)]; }
    LDS_WAIT(); asm volatile("" ::: "memory");
    const int c = lane & 7;
#pragma unroll
    for (int j = 0; j < 4; ++j) { const int n = (lane >> 3) + 8 * j; const LAS float* s = scr + (8 * c) * 33 + n;
        u32x4 o; o.x = pk2(s[0 * 33], s[1 * 33]); o.y = pk2(s[2 * 33], s[3 * 33]); o.z = pk2(s[4 * 33], s[5 * 33]); o.w = pk2(s[6 * 33], s[7 * 33]);
        *(u32x4*)(WT + (size_t)(dr0 + n) * K + k0 + 8 * c) = o; }
    LDS_WAIT(); asm volatile("" ::: "memory");
}
template <int MODE>
__device__ __forceinline__ void transpose_all(const Ctx& c, const float* W, int K, int N, int NOUT, int NEXP, bf16* WT) {
    LAS float* scr = (LAS float*)(c.lds + c.wave * 16384);
    const int per = (K / 64) * (N / 32), total = per * NEXP;
    for (int it = c.gw; it < total; it += c.NGW) { const int e = it / per, r = it % per;
        transpose_item<MODE>(W + (size_t)e * K * N, K, N, WT + (size_t)e * NOUT * K, scr, r, c.lane); }
}

__device__ __forceinline__ void norm1_row(int R, int lane, const float* x, const float* meta, const float* g, bf16* hn) {
    const float* src = R < M ? x + (size_t)R * D : meta + (size_t)(R - M) * D;
    f32x4 v[8]; float ss = 0.f;
#pragma unroll
    for (int j = 0; j < 8; ++j) { v[j] = *(const f32x4*)(src + j * 256 + lane * 4); ss += v[j].x * v[j].x + v[j].y * v[j].y + v[j].z * v[j].z + v[j].w * v[j].w; }
    const float rstd = rsqrtf(wave_sum(ss) * (1.f / D) + EPS);
#pragma unroll
    for (int j = 0; j < 8; ++j) {
        const f32x4 gg = *(const f32x4*)(g + j * 256 + lane * 4);
        u32x2 o; o.x = pk2(v[j].x * rstd * gg.x, v[j].y * rstd * gg.y); o.y = pk2(v[j].z * rstd * gg.z, v[j].w * rstd * gg.w);
        *(u32x2*)(hn + (size_t)R * D + j * 256 + lane * 4) = o;
    }
}

struct EpiProj { bf16* proj; int roff; __device__ void operator()(int m, int n, float v) const { proj[(size_t)(m + roff) * DINP + n] = f2bf(v); } };
struct EpiQraw { float* q; __device__ void operator()(int m, int n, float v) const { if (m < M) q[(size_t)m * 1536 + n] = v; } };
struct EpiKV {
    bf16* kn; bf16* vv;
    __device__ void operator()(int R, int n, float v) const {
        if (R >= MR) return;
        const int h = n >> 8, part = (n >> 7) & 1, d = n & 127; const bf16 o = f2bf(v);
        const int b0 = R < M ? R / S : 0, b1 = R < M ? b0 : 1, pos = R < M ? (R % S) + NMETA : R - M;
        for (int b = b0; b <= b1; ++b) {
            if (part) vv[((size_t)(b * NH + h) * 128 + d) * LP + pos] = o;
            else kn[((size_t)(b * LP + pos) * NH + h) * 128 + d] = o;
        }
    }
};
struct EpiWout { const float* x; float* h1; __device__ void operator()(int m, int n, float v) const { h1[(size_t)m * D + n] = x[(size_t)m * D + n] + v; } };

template <class Epi>
__device__ __forceinline__ void gemm_simple(const Ctx& c, const bf16* __restrict__ A, int lda, const bf16* __restrict__ Bt, int ldb, int K, int nMt, int nNt, const Epi& epi) {
    const int r = c.lane & 15, q = c.lane >> 4;
    for (int wt = c.gw; wt < nMt * nNt; wt += c.NGW) {
        const int m0 = (wt / nNt) * 32, n0 = (wt % nNt) * 32;
        f32x4 acc[2][2];
#pragma unroll
        for (int i = 0; i < 2; ++i)
#pragma unroll
            for (int j = 0; j < 2; ++j) acc[i][j] = (f32x4){0.f, 0.f, 0.f, 0.f};
        const bf16* a0 = A + (size_t)(m0 + r) * lda + 8 * q; const bf16* b0 = Bt + (size_t)(n0 + r) * ldb + 8 * q;
#pragma unroll 2
        for (int k0 = 0; k0 < K; k0 += 32) {
            bf16x8 a[2], b[2];
#pragma unroll
            for (int i = 0; i < 2; ++i) { a[i] = *(const bf16x8*)(a0 + (size_t)i * 16 * lda + k0); b[i] = *(const bf16x8*)(b0 + (size_t)i * 16 * ldb + k0); }
#pragma unroll
            for (int i = 0; i < 2; ++i)
#pragma unroll
                for (int j = 0; j < 2; ++j) acc[i][j] = __builtin_amdgcn_mfma_f32_16x16x32_bf16(a[i], b[j], acc[i][j], 0, 0, 0);
        }
#pragma unroll
        for (int i = 0; i < 2; ++i)
#pragma unroll
            for (int j = 0; j < 2; ++j)
#pragma unroll
                for (int t = 0; t < 4; ++t) epi(m0 + i * 16 + q * 4 + t, n0 + j * 16 + r, acc[i][j][t]);
    }
}

__device__ __forceinline__ float inv_freq(int i) { return powf(10000.0f, -(float)i / 32.0f); }

__device__ __forceinline__ void postproj_row(int R, int lane, const bf16* __restrict__ proj, const float* __restrict__ conv_w, const float* __restrict__ g_conv,
                                             const float* __restrict__ g_q, const float* __restrict__ g_kv,
                                             bf16* __restrict__ mixed, bf16* __restrict__ qn, bf16* __restrict__ kvn, bf16* __restrict__ kpe) {
    const bf16* pr = proj + (size_t)R * DINP;
    const bool meta = R >= M; const int b = meta ? 0 : R / S, t = meta ? 0 : R % S, pos = meta ? R - M : t + NMETA;
    {
        const u32x2 w = *(const u32x2*)(pr + O_KV + lane * 4);
        float f[4] = {__uint_as_float(w.x << 16), __uint_as_float(w.x & 0xffff0000u), __uint_as_float(w.y << 16), __uint_as_float(w.y & 0xffff0000u)};
        const float ss = wave_sum(f[0] * f[0] + f[1] * f[1] + f[2] * f[2] + f[3] * f[3]);
        const float rstd = rsqrtf(ss * (1.f / KVL) + EPS);
        const f32x4 g = *(const f32x4*)(g_kv + lane * 4);
        u32x2 o; o.x = pk2(f[0] * rstd * g.x, f[1] * rstd * g.y); o.y = pk2(f[2] * rstd * g.z, f[3] * rstd * g.w);
        *(u32x2*)(kvn + (size_t)R * KVL + lane * 4) = o;
    }
    if (lane < 32) {
        const float x1 = bf2f(pr[O_R + lane]), x2 = bf2f(pr[O_R + 32 + lane]);
        const float ang = (float)pos * inv_freq(lane); const float cs = cosf(ang), sn = sinf(ang);
        const bf16 o1 = f2bf(x1 * cs - x2 * sn), o2 = f2bf(x1 * sn + x2 * cs);
        if (!meta) { bf16* d = kpe + (size_t)(b * LP + pos) * ROPE; d[lane] = o1; d[32 + lane] = o2; }
        else { bf16* d0 = kpe + (size_t)(0 * LP + pos) * ROPE; bf16* d1 = kpe + (size_t)(1 * LP + pos) * ROPE; d0[lane] = o1; d0[32 + lane] = o2; d1[lane] = o1; d1[32 + lane] = o2; }
    }
    if (meta) return;
    {
        float f[8]; unpack8(*(const u32x4*)(pr + O_Q + lane * 8), f);
        float ss = 0.f;
#pragma unroll
        for (int i = 0; i < 8; ++i) ss += f[i] * f[i];
        const float rstd = rsqrtf(wave_sum(ss) * (1.f / QL) + EPS);
        const f32x4 g0 = *(const f32x4*)(g_q + lane * 8), g1 = *(const f32x4*)(g_q + lane * 8 + 4);
        u32x4 o; o.x = pk2(f[0] * rstd * g0.x, f[1] * rstd * g0.y); o.y = pk2(f[2] * rstd * g0.z, f[3] * rstd * g0.w);
        o.z = pk2(f[4] * rstd * g1.x, f[5] * rstd * g1.y); o.w = pk2(f[6] * rstd * g1.z, f[7] * rstd * g1.w);
        *(u32x4*)(qn + (size_t)R * QL + lane * 8) = o;
    }
    {
        const int r1 = (t >= 1) ? R - 1 : M + 15, r2 = (t >= 2) ? R - 2 : (t == 1 ? M + 15 : M + 14);
        const bf16* p1 = proj + (size_t)r1 * DINP; const bf16* p2 = proj + (size_t)r2 * DINP;
        const int c0 = lane * 16;
        float v[16]; float ss = 0.f;
#pragma unroll
        for (int hh = 0; hh < 2; ++hh) {
            const int c = c0 + hh * 8;
            float bg[8], cg0[8], ui0[8], cg1[8], ui1[8], cg2[8], ui2[8];
            unpack8(*(const u32x4*)(pr + c), bg); unpack8(*(const u32x4*)(pr + O_C + c), cg0); unpack8(*(const u32x4*)(pr + O_U + c), ui0);
            unpack8(*(const u32x4*)(p1 + O_C + c), cg1); unpack8(*(const u32x4*)(p1 + O_U + c), ui1);
            unpack8(*(const u32x4*)(p2 + O_C + c), cg2); unpack8(*(const u32x4*)(p2 + O_U + c), ui2);
#pragma unroll
            for (int i = 0; i < 8; ++i) {
                const float y = conv_w[2 * DCONV + c + i] * (cg0[i] * ui0[i]) + conv_w[1 * DCONV + c + i] * (cg1[i] * ui1[i]) + conv_w[0 * DCONV + c + i] * (cg2[i] * ui2[i]);
                const float o = bg[i] * y; v[hh * 8 + i] = o; ss += o * o;
            }
        }
        ss += __shfl_xor(ss, 1); ss += __shfl_xor(ss, 2);
        const float rstd = rsqrtf(ss * (1.f / 64.f) + EPS);
#pragma unroll
        for (int hh = 0; hh < 2; ++hh) {
            const int c = c0 + hh * 8;
            const f32x4 g0 = *(const f32x4*)(g_conv + c), g1 = *(const f32x4*)(g_conv + c + 4);
            u32x4 o; o.x = pk2(v[hh * 8 + 0] * rstd * g0.x, v[hh * 8 + 1] * rstd * g0.y); o.y = pk2(v[hh * 8 + 2] * rstd * g0.z, v[hh * 8 + 3] * rstd * g0.w);
            o.z = pk2(v[hh * 8 + 4] * rstd * g1.x, v[hh * 8 + 5] * rstd * g1.y); o.w = pk2(v[hh * 8 + 6] * rstd * g1.z, v[hh * 8 + 7] * rstd * g1.w);
            *(u32x4*)(mixed + (size_t)R * D + c) = o;
        }
    }
}

__device__ __forceinline__ void rope_q_row(int m, int lane, const float* __restrict__ qraw, bf16* __restrict__ Q) {
    const int pos = (m % S) + NMETA;
    float cs = 0.f, sn = 0.f;
    if (lane < 32) { const float ang = (float)pos * inv_freq(lane); cs = cosf(ang); sn = sinf(ang); }
    for (int h = 0; h < NH; ++h) {
        const float* src = qraw + (size_t)m * 1536 + h * DQK; bf16* dst = Q + ((size_t)m * NH + h) * DQK;
        dst[lane] = f2bf(src[lane]); dst[64 + lane] = f2bf(src[64 + lane]);
        if (lane < 32) { const float x1 = src[128 + lane], x2 = src[160 + lane]; dst[128 + lane] = f2bf(x1 * cs - x2 * sn); dst[160 + lane] = f2bf(x1 * sn + x2 * cs); }
    }
}

__device__ __forceinline__ void attn_simple_row(int wid, int lane, const bf16* __restrict__ Q, const bf16* __restrict__ Kn, const bf16* __restrict__ Kpe, const bf16* __restrict__ V,
                                                const float* __restrict__ g_attn, bf16* __restrict__ mixed) {
    const int m = wid / NH, h = wid % NH, b = m / S, pos = (m % S) + NMETA;
    const bf16* q = Q + ((size_t)m * NH + h) * DQK;
    const float scale = 0.07216878364870322f;
    const float q0 = bf2f(q[lane]) * scale, q1 = bf2f(q[64 + lane]) * scale, q2 = bf2f(q[128 + lane]) * scale;
    const bf16* kn = Kn + ((size_t)b * LP * NH + h) * 128; const bf16* vv = V + ((size_t)b * LP * NH + h) * 128; const bf16* kp = Kpe + (size_t)b * LP * ROPE;
    float mx = -INFINITY, sum = 0.f, o0 = 0.f, o1 = 0.f;
    for (int j = 0; j <= pos; j += 4) {
        float s[4], v0[4], v1[4];
#pragma unroll
        for (int u = 0; u < 4; ++u) {
            const size_t ro = (size_t)(j + u) * NH * 128;
            s[u] = q0 * bf2f(kn[ro + lane]) + q1 * bf2f(kn[ro + 64 + lane]) + q2 * bf2f(kp[(size_t)(j + u) * ROPE + lane]);
            v0[u] = bf2f(vv[ro + lane]); v1[u] = bf2f(vv[ro + 64 + lane]);
        }
#pragma unroll
        for (int o = 1; o < 64; o <<= 1) {
#pragma unroll
            for (int u = 0; u < 4; ++u) s[u] += __shfl_xor(s[u], o);
        }
#pragma unroll
        for (int u = 0; u < 4; ++u) if (j + u > pos) s[u] = -INFINITY;
        const float mn = fmaxf(fmaxf(mx, fmaxf(s[0], s[1])), fmaxf(s[2], s[3]));
        const float corr = __expf(mx - mn);
        sum *= corr; o0 *= corr; o1 *= corr;
#pragma unroll
        for (int u = 0; u < 4; ++u) { const float p = __expf(s[u] - mn); sum += p; o0 += p * v0[u]; o1 += p * v1[u]; }
        mx = mn;
    }
    const float inv = 1.f / sum; o0 *= inv; o1 *= inv;
    const float ss = wave_sum(o0 * o0 + o1 * o1);
    const float rstd = rsqrtf(ss * (1.f / 128.f) + EPS);
    bf16* dst = mixed + (size_t)m * D + DCONV + h * DV;
    dst[lane] = f2bf(o0 * rstd * g_attn[h * DV + lane]); dst[64 + lane] = f2bf(o1 * rstd * g_attn[h * DV + 64 + lane]);
}

__device__ __forceinline__ void router_row(int m, int lane, const float* __restrict__ h1, const float* __restrict__ g_ffn, const float* __restrict__ w_r, const float* __restrict__ b_r,
                                           bf16* __restrict__ xn, unsigned* __restrict__ cnt, int* __restrict__ rowtok, int* __restrict__ tok_e, int* __restrict__ tok_p, float* __restrict__ gate) {
    const float* src = h1 + (size_t)m * D;
    float ss = 0.f;
#pragma unroll
    for (int j = 0; j < 8; ++j) { const f32x4 t = *(const f32x4*)(src + j * 256 + lane * 4); ss += t.x * t.x + t.y * t.y + t.z * t.z + t.w * t.w; }
    const float rstd = rsqrtf(wave_sum(ss) * (1.f / D) + EPS);
    float acc[32];
#pragma unroll
    for (int e = 0; e < 32; ++e) acc[e] = 0.f;
#pragma unroll 1
    for (int j = 0; j < 8; ++j) {
        const f32x4 vv = *(const f32x4*)(src + j * 256 + lane * 4);
        const f32x4 gg = *(const f32x4*)(g_ffn + j * 256 + lane * 4);
        const float xv[4] = {vv.x * rstd * gg.x, vv.y * rstd * gg.y, vv.z * rstd * gg.z, vv.w * rstd * gg.w};
        u32x2 o; o.x = pk2(xv[0], xv[1]); o.y = pk2(xv[2], xv[3]);
        *(u32x2*)(xn + (size_t)m * D + j * 256 + lane * 4) = o;
#pragma unroll
        for (int i = 0; i < 4; ++i) {
            const float* wr = w_r + (size_t)(j * 256 + lane * 4 + i) * NE;
#pragma unroll
            for (int e4 = 0; e4 < 8; ++e4) { const f32x4 w = *(const f32x4*)(wr + e4 * 4);
                acc[e4 * 4 + 0] += xv[i] * w.x; acc[e4 * 4 + 1] += xv[i] * w.y; acc[e4 * 4 + 2] += xv[i] * w.z; acc[e4 * 4 + 3] += xv[i] * w.w; }
        }
    }
    float logit = -INFINITY;
#pragma unroll
    for (int e = 0; e < 32; ++e) { const float tot = wave_sum(acc[e]) + b_r[e]; if (lane == e) logit = tot; }
    float tv[4]; int ti[4];
#pragma unroll
    for (int k = 0; k < 4; ++k) {
        const float mxv = wave_max(logit);
        const unsigned long long mask = __ballot(logit == mxv);
        const int idx = __ffsll((long long)mask) - 1;
        tv[k] = mxv; ti[k] = idx;
        if (lane == idx) logit = -INFINITY;
    }
    float ex[4]; float es = 0.f;
#pragma unroll
    for (int k = 0; k < 4; ++k) { ex[k] = expf(tv[k] - tv[0]); es += ex[k]; }
    if (lane == 0) {
#pragma unroll
        for (int k = 0; k < 4; ++k) {
            const unsigned p = atomicAdd(&cnt[ti[k]], 1u);
            rowtok[ti[k] * M + p] = m; tok_e[m * 4 + k] = ti[k]; tok_p[m * 4 + k] = (int)p; gate[m * 4 + k] = ex[k] / es;
        }
    }
}

__device__ __forceinline__ bool expert_of_row(const unsigned* cnt, int row0, int& e_out, int& local0, int& n_out, int& off_out) {
    int off = 0;
    for (int e = 0; e < NE; ++e) { const int n = (int)cnt[e], p = (n + 255) / 256 * 256; if (row0 < off + p) { e_out = e; local0 = row0 - off; n_out = n; off_out = off; return true; } off += p; }
    return false;
}
__device__ __forceinline__ void moe1_simple(const Ctx& cx, const bf16* __restrict__ xn, const bf16* __restrict__ Wgu, const float* __restrict__ b_gu, const unsigned* __restrict__ cnt,
                                            const int* __restrict__ rowtok, bf16* __restrict__ act) {
    const int r = cx.lane & 15, q = cx.lane >> 4;
    constexpr int nNt = DFF / 32;
    for (int wt = cx.gw; wt < (RP / 32) * nNt; wt += cx.NGW) {
        int e, lm0, n, off;
        if (!expert_of_row(cnt, (wt / nNt) * 32, e, lm0, n, off)) break;
        if (lm0 >= n) continue;
        const int c0 = (wt % nNt) * 32;
        const bf16* Wt = Wgu + (size_t)e * 4096 * D;
        const bf16* ap[2]; const bf16* bg[2];
#pragma unroll
        for (int i = 0; i < 2; ++i) { const int li = lm0 + i * 16 + r; const int tok = li < n ? rowtok[e * M + li] : rowtok[e * M]; ap[i] = xn + (size_t)tok * D + 8 * q; }
#pragma unroll
        for (int j = 0; j < 2; ++j) { const int c = c0 + j * 16 + r; const int ng = 256 * (c >> 7) + (c & 127); bg[j] = Wt + (size_t)ng * D + 8 * q; }
        f32x4 ag[2][2], al[2][2];
#pragma unroll
        for (int i = 0; i < 2; ++i)
#pragma unroll
            for (int j = 0; j < 2; ++j) { ag[i][j] = (f32x4){0.f, 0.f, 0.f, 0.f}; al[i][j] = (f32x4){0.f, 0.f, 0.f, 0.f}; }
#pragma unroll 2
        for (int k0 = 0; k0 < D; k0 += 32) {
            bf16x8 a[2], wg[2], wl[2];
#pragma unroll
            for (int i = 0; i < 2; ++i) { a[i] = *(const bf16x8*)(ap[i] + k0); wg[i] = *(const bf16x8*)(bg[i] + k0); wl[i] = *(const bf16x8*)(bg[i] + (size_t)128 * D + k0); }
#pragma unroll
            for (int i = 0; i < 2; ++i)
#pragma unroll
                for (int j = 0; j < 2; ++j) { ag[i][j] = __builtin_amdgcn_mfma_f32_16x16x32_bf16(a[i], wg[j], ag[i][j], 0, 0, 0); al[i][j] = __builtin_amdgcn_mfma_f32_16x16x32_bf16(a[i], wl[j], al[i][j], 0, 0, 0); }
        }
        const float* bias = b_gu + (size_t)e * 4096;
#pragma unroll
        for (int i = 0; i < 2; ++i)
#pragma unroll
            for (int j = 0; j < 2; ++j)
#pragma unroll
                for (int t = 0; t < 4; ++t) {
                    const int li = lm0 + i * 16 + q * 4 + t, c = c0 + j * 16 + r;
                    if (li < n) {
                        const float g = fminf(ag[i][j][t] + bias[c], 7.0f);
                        const float l = fminf(fmaxf(al[i][j][t] + bias[2048 + c], -7.0f), 7.0f);
                        const float a = (l + 1.0f) * (g / (1.0f + expf(-1.702f * g)));
                        act[(size_t)(off + li) * DFF + c] = f2bf(a);
                    }
                }
    }
}
__device__ __forceinline__ void moe2_simple(const Ctx& cx, const bf16* __restrict__ act, const bf16* __restrict__ Wd, const float* __restrict__ b_d, const unsigned* __restrict__ cnt, bf16* __restrict__ y) {
    const int r = cx.lane & 15, q = cx.lane >> 4;
    constexpr int nNt = D / 32;
    for (int wt = cx.gw; wt < (RP / 32) * nNt; wt += cx.NGW) {
        int e, lm0, n, off;
        if (!expert_of_row(cnt, (wt / nNt) * 32, e, lm0, n, off)) break;
        if (lm0 >= n) continue;
        const int n0 = (wt % nNt) * 32;
        const bf16* Wt = Wd + (size_t)e * D * DFF;
        const bf16* a0 = act + (size_t)(off + lm0 + r) * DFF + 8 * q; const bf16* b0 = Wt + (size_t)(n0 + r) * DFF + 8 * q;
        f32x4 acc[2][2];
#pragma unroll
        for (int i = 0; i < 2; ++i)
#pragma unroll
            for (int j = 0; j < 2; ++j) acc[i][j] = (f32x4){0.f, 0.f, 0.f, 0.f};
#pragma unroll 2
        for (int k0 = 0; k0 < DFF; k0 += 32) {
            bf16x8 a[2], b[2];
#pragma unroll
            for (int i = 0; i < 2; ++i) { a[i] = *(const bf16x8*)(a0 + (size_t)i * 16 * DFF + k0); b[i] = *(const bf16x8*)(b0 + (size_t)i * 16 * DFF + k0); }
#pragma unroll
            for (int i = 0; i < 2; ++i)
#pragma unroll
                for (int j = 0; j < 2; ++j) acc[i][j] = __builtin_amdgcn_mfma_f32_16x16x32_bf16(a[i], b[j], acc[i][j], 0, 0, 0);
        }
        const float* bias = b_d + (size_t)e * D;
#pragma unroll
        for (int i = 0; i < 2; ++i)
#pragma unroll
            for (int j = 0; j < 2; ++j)
#pragma unroll
                for (int t = 0; t < 4; ++t) { const int li = lm0 + i * 16 + q * 4 + t, c = n0 + j * 16 + r; if (li < n) y[(size_t)(off + li) * D + c] = f2bf(acc[i][j][t] + bias[c]); }
    }
}

__device__ __forceinline__ void combine_row(int m, int lane, const float* __restrict__ h1, const bf16* __restrict__ y, const unsigned* __restrict__ cnt, const int* __restrict__ tok_e, const int* __restrict__ tok_p,
                                            const float* __restrict__ gate, const float* __restrict__ g_final, float* __restrict__ out) {
    size_t yrow[4]; float gk[4];
#pragma unroll
    for (int k = 0; k < 4; ++k) {
        const int e = tok_e[m * 4 + k]; int off = 0;
        for (int e2 = 0; e2 < e; ++e2) off += ((int)cnt[e2] + 255) / 256 * 256;
        yrow[k] = (size_t)(off + tok_p[m * 4 + k]) * D; gk[k] = gate[m * 4 + k];
    }
    f32x4 v[8]; float ss = 0.f;
#pragma unroll
    for (int j = 0; j < 8; ++j) {
        const int idx = j * 256 + lane * 4;
        f32x4 a = *(const f32x4*)(h1 + (size_t)m * D + idx);
#pragma unroll
        for (int k = 0; k < 4; ++k) { const u32x2 w = *(const u32x2*)(y + yrow[k] + idx);
            a.x += gk[k] * __uint_as_float(w.x << 16); a.y += gk[k] * __uint_as_float(w.x & 0xffff0000u); a.z += gk[k] * __uint_as_float(w.y << 16); a.w += gk[k] * __uint_as_float(w.y & 0xffff0000u); }
        v[j] = a; ss += a.x * a.x + a.y * a.y + a.z * a.z + a.w * a.w;
    }
    const float rstd = rsqrtf(wave_sum(ss) * (1.f / D) + EPS);
#pragma unroll
    for (int j = 0; j < 8; ++j) { const int idx = j * 256 + lane * 4; const f32x4 gg = *(const f32x4*)(g_final + idx);
        *(f32x4*)(out + (size_t)m * D + idx) = (f32x4){v[j].x * rstd * gg.x, v[j].y * rstd * gg.y, v[j].z * rstd * gg.z, v[j].w * rstd * gg.w}; }
}


constexpr int TAB_OFF = MISC_OFF + 128;
__device__ __forceinline__ const LAS int* build_expert_table(const Ctx& c, const unsigned* cnt) {
    LAS int* tab = (LAS int*)(c.lds + TAB_OFF);
    if (c.tid < 64) {
        const int n = c.lane < NE ? (int)cnt[c.lane] : 0; int t = (n + 255) / 256, incl = t;
#pragma unroll
        for (int o = 1; o < 32; o <<= 1) { const int v = __shfl_up(incl, o); if (c.lane >= o) incl += v; }
        if (c.lane < NE) tab[c.lane + 1] = incl;
        if (c.lane == 0) tab[0] = 0;
    }
    __syncthreads();
    return tab;
}
constexpr int NPHASE = 10;
struct Args { const float* in[20]; float* out; unsigned char* ws; int ph_lo, ph_hi; };
__global__ void __launch_bounds__(NWAVES * 64, 2) mk_fwd(Args a) {
    extern __shared__ __attribute__((aligned(16))) unsigned char lds_raw[];
    Ctx c;
    c.lds = (LAS unsigned char*)lds_raw;
    c.tid = threadIdx.x; c.lane = c.tid & 63; c.wave = __builtin_amdgcn_readfirstlane(c.tid >> 6);
    c.G = gridDim.x; c.wg = blockIdx.x; c.gw = c.wg * NWAVES + c.wave; c.NGW = c.G * NWAVES;
    volatile LAS unsigned* MISC = (volatile LAS unsigned*)(c.lds + MISC_OFF);
    if (c.tid < 32) MISC[c.tid] = 0u;
    __syncthreads();
    unsigned char* ws = a.ws;
    unsigned* ctl = (unsigned*)(ws + WS_CTL);
    XcdBarrier bar = xcd_barrier_post(ctl + CW_BAR, MISC + 8);
    const float* x = a.in[0]; const float* meta = a.in[1]; const float* g_mix = a.in[2]; const float* w_in = a.in[3];
    const float* conv_w = a.in[4]; const float* g_q = a.in[5]; const float* w_q_up = a.in[6]; const float* g_kv = a.in[7];
    const float* w_kv_up = a.in[8]; const float* g_conv = a.in[9]; const float* g_attn = a.in[10]; const float* w_out = a.in[11];
    const float* g_ffn = a.in[12]; const float* w_router = a.in[13]; const float* b_router = a.in[14]; const float* w_gu = a.in[15];
    const float* b_gu = a.in[16]; const float* w_d = a.in[17]; const float* b_d = a.in[18]; const float* g_final = a.in[19];
    bf16* Win = (bf16*)(ws + WS_WIN); bf16* Wq = (bf16*)(ws + WS_WQ); bf16* Wkv = (bf16*)(ws + WS_WKV); bf16* Wout = (bf16*)(ws + WS_WOUT); bf16* Wgu = (bf16*)(ws + WS_WGU); bf16* Wd = (bf16*)(ws + WS_WD);
    bf16* hn = (bf16*)(ws + WS_HN); bf16* proj = (bf16*)(ws + WS_PROJ); bf16* mixed = (bf16*)(ws + WS_MIXED); bf16* qn = (bf16*)(ws + WS_QN); bf16* kvn = (bf16*)(ws + WS_KVN);
    float* qraw = (float*)(ws + WS_QRAW); bf16* Q = (bf16*)(ws + WS_Q); bf16* Kn = (bf16*)(ws + WS_KN); bf16* V = (bf16*)(ws + WS_V); bf16* Kpe = (bf16*)(ws + WS_KPE);
    float* h1 = (float*)(ws + WS_H1); bf16* xn = (bf16*)(ws + WS_XN); int* tok_e = (int*)(ws + WS_TOKE); int* tok_p = (int*)(ws + WS_TOKP); float* gate = (float*)(ws + WS_GATE);
    int* rowtok = (int*)(ws + WS_ROWTOK); bf16* act = (bf16*)(ws + WS_ACT); bf16* y = (bf16*)(ws + WS_Y);
    unsigned* cnt = ctl + CW_CNT;

    const int lo = a.ph_lo, hi = a.ph_hi;
#define IN(k) (lo <= (k) && (k) < hi)
#define SEAM(k) do { if (IN(k) && IN((k) + 1)) xcd_barrier(bar); } while (0)

    if (IN(0)) {
        transpose_all<0>(c, w_in, D, DIN, DINP, 1, Win);
        for (int i = c.gw * 64 + c.lane; i < (DINP - DIN) * D / 8; i += c.NGW * 64) ((u32x4*)(Win + (size_t)DIN * D))[i] = (u32x4){0u, 0u, 0u, 0u};
        transpose_all<0>(c, w_q_up, QL, 1536, 1536, 1, Wq);
        transpose_all<0>(c, w_kv_up, KVL, 2048, 2048, 1, Wkv);
        transpose_all<0>(c, w_out, D, D, D, 1, Wout);
        transpose_all<1>(c, w_gu, D, 4096, 4096, NE, Wgu);
        transpose_all<0>(c, w_d, DFF, D, D, NE, Wd);
        for (int R = c.gw; R < MR; R += c.NGW) norm1_row(R, c.lane, x, meta, g_mix, hn);
    }
    SEAM(0);
    if (IN(1)) {
        pg8::Gemm g{hn, D}; pg8::PlainSched Sc; Sc.init(Win, M, DINP, D, c.G, c.wg);
        pg8::gemm_phase<pg8::EpiStoreBf16, pg8::PlainSched, true>(c.lds, g, Sc, pg8::EpiStoreBf16{proj, DINP});
        gemm_simple(c, hn + (size_t)M * D, D, Win, D, D, 1, DINP / 32, EpiProj{proj, M});
    }
    SEAM(1);
    if (IN(2)) { for (int R = c.gw; R < MR; R += c.NGW) postproj_row(R, c.lane, proj, conv_w, g_conv, g_q, g_kv, mixed, qn, kvn, Kpe); }
    SEAM(2);
    if (IN(3)) { gemm_simple(c, qn, QL, Wq, QL, QL, M / 32, 1536 / 32, EpiQraw{qraw}); gemm_simple(c, kvn, KVL, Wkv, KVL, KVL, MRP / 32, 2048 / 32, EpiKV{Kn, V}); }
    SEAM(3);
    if (IN(4)) { for (int m = c.gw; m < M; m += c.NGW) rope_q_row(m, c.lane, qraw, Q); }
    SEAM(4);
    if (IN(5)) {
        for (int u = c.wg; u < NB * NH * 16; u += c.G) { const int bh = (u & 7) * 2 + ((u >> 3) >> 4), qb = (u >> 3) & 15;
            att::attn_unit(c.lds, bh >> 3, bh & 7, qb, Q, Kn, Kpe, V, g_attn, mixed); }
    }
    SEAM(5);
    if (IN(6)) {
        pg8::Gemm g{mixed, D}; pg8::PlainSched Sc; Sc.init(Wout, M, D, D, c.G, c.wg);
        pg8::gemm_phase<pg8::EpiResF32, pg8::PlainSched, true>(c.lds, g, Sc, pg8::EpiResF32{x, h1, D});
    }
    SEAM(6);
    if (IN(7)) { for (int m = c.gw; m < M; m += c.NGW) router_row(m, c.lane, h1, g_ffn, w_router, b_router, xn, cnt, rowtok, tok_e, tok_p, gate); }
    SEAM(7);
    if (IN(8)) {
        const LAS int* tab = build_expert_table(c, cnt);
        pg8::Gemm g{xn, D}; pg8::MoeSched<true> Sc{Wgu, (size_t)4096 * D * 2, cnt, rowtok, tab, D, 16, c.G, c.wg};
        pg8::gemm_phase<pg8::EpiMoe1, pg8::MoeSched<true>, true>(c.lds, g, Sc, pg8::EpiMoe1{act, b_gu});
    }
    SEAM(8);
    if (IN(9)) {
        const LAS int* tab = build_expert_table(c, cnt);
        pg8::Gemm g{act, DFF}; pg8::MoeSched<false> Sc{Wd, (size_t)D * DFF * 2, cnt, rowtok, tab, DFF, 8, c.G, c.wg};
        pg8::gemm_phase<pg8::EpiMoe2, pg8::MoeSched<false>, true>(c.lds, g, Sc, pg8::EpiMoe2{y, b_d});
    }
    SEAM(9);
    if (IN(10)) { for (int m = c.gw; m < M; m += c.NGW) combine_row(m, c.lane, h1, y, cnt, tok_e, tok_p, gate, g_final, a.out); }
#undef IN
#undef SEAM
}

extern "C" void kernel_launch(void* const* d_in, const int* in_sizes, int n_in, void* d_out, int out_size, void* d_ws, size_t ws_size, hipStream_t stream) {
    static int grid = 0;
    if (grid == 0) {
        if (n_in != 20 || ws_size < WS_END) { fprintf(stderr, "kernel_launch: unexpected n_in %d / ws %zu (need %zu)\n", n_in, ws_size, (size_t)WS_END); grid = -1; return; }
        int dev = 0, cus = 0, per_cu = 0;
        if (hipGetDevice(&dev) != hipSuccess || hipDeviceGetAttribute(&cus, hipDeviceAttributeMultiprocessorCount, dev) != hipSuccess) { grid = -1; return; }
        if (hipFuncSetAttribute((const void*)mk_fwd, hipFuncAttributeMaxDynamicSharedMemorySize, LDS_BYTES) != hipSuccess) { fprintf(stderr, "kernel_launch: hipFuncSetAttribute failed\n"); grid = -1; return; }
        if (hipOccupancyMaxActiveBlocksPerMultiprocessor(&per_cu, (const void*)mk_fwd, NWAVES * 64, LDS_BYTES) != hipSuccess || per_cu < 1) { fprintf(stderr, "kernel_launch: occupancy query says %d\n", per_cu); (void)hipGetLastError(); grid = -1; return; }
        grid = cus;
    }
    if (grid < 0) return;
    if (hipMemsetAsync((char*)d_ws + WS_CTL, 0, CTL_BYTES, stream) != hipSuccess) return;
    Args a{};
    for (int i = 0; i < 20; ++i) a.in[i] = (const float*)d_in[i];
    a.out = (float*)d_out; a.ws = (unsigned char*)d_ws; a.ph_lo = 0; a.ph_hi = NPHASE + 1;
    hipLaunchKernelGGL(mk_fwd, dim3(grid), dim3(NWAVES * 64), LDS_BYTES, stream, a);
}
```

```cpp
#include <hip/hip_runtime.h>
#include <cstdint>
#include <cstdio>

typedef unsigned short bf16;
typedef short bf16x8 __attribute__((ext_vector_type(8)));
typedef float f32x4 __attribute__((ext_vector_type(4)));
typedef unsigned u32x4 __attribute__((ext_vector_type(4)));
typedef unsigned u32x2 __attribute__((ext_vector_type(2)));

constexpr int D = 2048, NB = 2, S = 4096, NMETA = 16, M = NB * S;
constexpr int MR = M + NMETA;
constexpr int MRP = 8256;
constexpr int DCONV = 1024, QL = 512, KVL = 256, ROPE = 64, NH = 8, DN = 128, DV = 128, DQK = 192;
constexpr int DIN = 3904, DINP = 4096;
constexpr int O_C = 1024, O_U = 2048, O_Q = 3072, O_KV = 3584, O_R = 3840;
constexpr int NE = 32, TOPK = 4, DFF = 2048;
constexpr int LP = 4224;
constexpr int RP = 41216;
constexpr float EPS = 1e-6f;

constexpr size_t MiB = 1u << 20;
constexpr size_t WS_CTL = 0, CTL_BYTES = 1 * MiB;
constexpr size_t WS_WIN = 2 * MiB;
constexpr size_t WS_WQ = WS_WIN + 16 * MiB;
constexpr size_t WS_WKV = WS_WQ + 2 * MiB;
constexpr size_t WS_WOUT = WS_WKV + 2 * MiB;
constexpr size_t WS_WGU = WS_WOUT + 8 * MiB;
constexpr size_t WS_WD = WS_WGU + 512 * MiB;
constexpr size_t WS_HN = WS_WD + 256 * MiB;
constexpr size_t WS_PROJ = WS_HN + 34 * MiB;
constexpr size_t WS_MIXED = WS_PROJ + 66 * MiB;
constexpr size_t WS_QN = WS_MIXED + 32 * MiB;
constexpr size_t WS_KVN = WS_QN + 8 * MiB;
constexpr size_t WS_QRAW = WS_KVN + 6 * MiB;
constexpr size_t WS_WKVK = WS_QRAW;
constexpr size_t WS_WKVV = WS_QRAW + 1 * MiB;
constexpr size_t WS_COS = WS_QRAW + 2 * MiB;
constexpr size_t WS_SIN = WS_QRAW + 3 * MiB;
constexpr size_t WS_WRT = WS_QRAW + 4 * MiB;
constexpr size_t WS_Q = WS_QRAW + 48 * MiB;
constexpr size_t WS_KN = WS_Q + 24 * MiB;
constexpr size_t WS_V = WS_KN + 18 * MiB;
constexpr size_t WS_KPE = WS_V + 18 * MiB;
constexpr size_t WS_H1 = WS_KPE + 2 * MiB;
constexpr size_t WS_XN = WS_H1 + 64 * MiB;
constexpr size_t WS_TOKE = WS_XN + 32 * MiB;
constexpr size_t WS_TOKP = WS_TOKE + 1 * MiB;
constexpr size_t WS_GATE = WS_TOKP + 1 * MiB;
constexpr size_t WS_ROWTOK = WS_GATE + 1 * MiB;
constexpr size_t WS_ACT = WS_ROWTOK + 1 * MiB;
constexpr size_t WS_Y = WS_ACT + 162 * MiB;
constexpr size_t WS_END = WS_Y + 162 * MiB;
constexpr int CW_CNT = 64;
constexpr int CW_BAR = 4096;

__device__ __forceinline__ float bf2f(bf16 v) { return __uint_as_float((unsigned)v << 16); }
__device__ __forceinline__ bf16 f2bf(float f) { unsigned u = __float_as_uint(f); return (bf16)((u + 0x7fffu + ((u >> 16) & 1u)) >> 16); }
__device__ __forceinline__ float wave_sum(float v) {
#pragma unroll
    for (int o = 1; o < 64; o <<= 1) v += __shfl_xor(v, o);
    return v;
}
__device__ __forceinline__ float wave_max(float v) {
#pragma unroll
    for (int o = 1; o < 64; o <<= 1) v = fmaxf(v, __shfl_xor(v, o));
    return v;
}
__device__ __forceinline__ void unpack8(const u32x4 w, float (&f)[8]) {
    f[0] = __uint_as_float(w.x << 16); f[1] = __uint_as_float(w.x & 0xffff0000u);
    f[2] = __uint_as_float(w.y << 16); f[3] = __uint_as_float(w.y & 0xffff0000u);
    f[4] = __uint_as_float(w.z << 16); f[5] = __uint_as_float(w.z & 0xffff0000u);
    f[6] = __uint_as_float(w.w << 16); f[7] = __uint_as_float(w.w & 0xffff0000u);
}
__device__ __forceinline__ unsigned pk2(float lo, float hi) { return (unsigned)f2bf(lo) | ((unsigned)f2bf(hi) << 16); }


#define GAS __attribute__((address_space(1)))
#define LAS __attribute__((address_space(3)))
#define LDS_WAIT() asm volatile("s_waitcnt lgkmcnt(0)" ::: "memory")
#define VM_WAIT() asm volatile("s_waitcnt vmcnt(0)" ::: "memory")
constexpr int NWAVES = 8;
constexpr int LDS_BYTES = 147456;
constexpr int RING_BYTES = 131072, MISC_OFF = RING_BYTES + 320;

#define XB_TMO      128
#define XB_XCNT(j)  (256  + 64 * (j))
#define XB_XSUB(j)  (1280 + 64 * (j))
#define XB_XGEN(j)  (2304 + 64 * (j))
#define XB_TOP      3328
#define XB_TOPGEN   3392
#define XCD_BAR_WORDS 3456
#define XB_SPIN_CAP (1u << 18)

__device__ __forceinline__ unsigned xb_ld(unsigned* p)              { return __hip_atomic_load(p, __ATOMIC_RELAXED, __HIP_MEMORY_SCOPE_AGENT); }
__device__ __forceinline__ unsigned xb_add(unsigned* p, unsigned v) { return __hip_atomic_fetch_add(p, v, __ATOMIC_RELAXED, __HIP_MEMORY_SCOPE_AGENT); }
__device__ __forceinline__ unsigned xb_xcc_id() { return (unsigned)__builtin_amdgcn_s_getreg((3 << 11) | 20) & 0xFu; }
#define XB_SPIN(cond, bar) do { unsigned _sp = 0; while (cond) { __builtin_amdgcn_s_sleep(1); \
    if ((++_sp & 255u) == 0u) { if (xb_ld(&(bar)[XB_TMO])) break; if (_sp > XB_SPIN_CAP) { atomicAdd(&(bar)[XB_TMO], 1u); break; } } } } while (0)

struct XcdBarrier {
    unsigned* bar; unsigned x;
    volatile LAS unsigned* st;
};
__device__ __forceinline__ XcdBarrier xcd_barrier_post(unsigned* bar, volatile LAS unsigned* st) {
    XcdBarrier b; b.bar = bar; b.x = xb_xcc_id(); b.st = st;
    if (threadIdx.x == 0) (void)xb_add(&bar[XB_XCNT(b.x)], 1u);
    return b;
}
__device__ __forceinline__ void xcd_barrier_complete(unsigned* bar, unsigned x, unsigned& nloc, unsigned& nx) {
    const unsigned G = gridDim.x * gridDim.y * gridDim.z;
    unsigned sum, cnt, mine, sp = 0u;
    for (;;) {
        sum = 0u; cnt = 0u; mine = 0u;
#pragma unroll
        for (unsigned j = 0; j < 16; ++j) { const unsigned c = xb_ld(&bar[XB_XCNT(j)]); sum += c; cnt += (c > 0u) ? 1u : 0u; mine = (j == x) ? c : mine; }
        if (sum == G) break;
        __builtin_amdgcn_s_sleep(1);
        if ((++sp & 255u) == 0u) { if (xb_ld(&bar[XB_TMO])) break; if (sp > XB_SPIN_CAP) { atomicAdd(&bar[XB_TMO], 1u); break; } }
    }
    nloc = mine > 0u ? mine : 1u; nx = cnt > 0u ? cnt : 1u;
}
__device__ __forceinline__ void xcd_barrier(const XcdBarrier& b) {
    asm volatile("s_waitcnt vmcnt(0)" ::: "memory");
    __syncthreads();
    if (threadIdx.x == 0) {
        unsigned* bar = b.bar;
        __builtin_amdgcn_s_waitcnt(0);
        unsigned nloc = b.st[0], nx = b.st[1];
        if (nloc == 0u) { xcd_barrier_complete(bar, b.x, nloc, nx); b.st[0] = nloc; b.st[1] = nx; }
        const unsigned old = xb_add(&bar[XB_XSUB(b.x)], 1u);
        const unsigned gen = old / nloc;
        if (old + 1u == (gen + 1u) * nloc) {
            __builtin_amdgcn_fence(__ATOMIC_RELEASE, "agent");
            asm volatile("s_waitcnt vmcnt(0)" ::: "memory");
            const unsigned og = xb_add(&bar[XB_TOP], 1u);
            const unsigned tg = og / nx;
            if (og + 1u == (tg + 1u) * nx) xb_add(&bar[XB_TOPGEN], 1u);
            else XB_SPIN(xb_ld(&bar[XB_TOPGEN]) == tg, bar);
            __builtin_amdgcn_fence(__ATOMIC_ACQUIRE, "agent");
            xb_add(&bar[XB_XGEN(b.x)], 1u);
            asm volatile("s_waitcnt vmcnt(0)" ::: "memory");
        } else {
            XB_SPIN(xb_ld(&bar[XB_XGEN(b.x)]) == gen, bar);
            __builtin_amdgcn_fence(__ATOMIC_ACQUIRE, "agent");
            asm volatile("s_waitcnt vmcnt(0)" ::: "memory");
        }
    }
    __syncthreads();
}

namespace pg8 {
constexpr int BM = 256, BK = 64, HALF = 128, HTB = HALF * BK * 2  , STAGE_BYTES = 8 * HTB, NXCD = 8, WGM = 8;
__host__ __device__ __forceinline__ int lds_byte(int r, int c) { const int st = (r >> 4) * 2 + (c >> 5), rr = r & 15, cc = c & 31, ob = rr * 64 + cc * 2; return st * 1024 + (ob ^ (((ob >> 9) & 1) << 5)); }
__host__ __device__ __forceinline__ void stage_rc(int b, int& R, int& C) { const int st = b / 1024, sb = b % 1024, swz = sb ^ (((sb >> 9) & 1) << 5); R = (st >> 1) * 16 + swz / 64; C = (st & 1) * 32 + (swz % 64) / 2; }
__host__ __device__ __forceinline__ int perm32(int rho) { const int n = rho >> 4, i = rho & 15; return 8 * (i >> 2) + 4 * n + (i & 3); }

struct Unit { int pm, pn, e, nrows; };
struct Gemm { const bf16* A; int K; };

__device__ __forceinline__ unsigned cvt_pk_bf16(float lo, float hi) { unsigned r; asm volatile("v_cvt_pk_bf16_f32 %0, %1, %2" : "=v"(r) : "v"(lo), "v"(hi)); return r; }

template <class Epi, class Sched, bool ALIGN_EPI>
__device__ __forceinline__ void gemm_phase(LAS unsigned char* lds, const Gemm g, const Sched& S, const Epi& E) {
    int tid_ = threadIdx.x; asm volatile("" : "+v"(tid_));
    const int tid = tid_, wid = __builtin_amdgcn_readfirstlane(tid >> 6), lane = tid & 63, wr = wid >> 2, wc = wid & 3, fr = lane & 15, fq = lane >> 4;
    const int K = g.K, nt = K / BK;
    int sR[2], sC[2]; unsigned voffB[2];
#pragma unroll
    for (int i = 0; i < 2; ++i) { stage_rc(tid * 16 + i * 8192, sR[i], sC[i]); const int Rb = Epi::PERM ? ((sR[i] & ~31) + perm32(sR[i] & 31)) : sR[i]; voffB[i] = (unsigned)(Rb * K + sC[i]) * 2u; }
    const size_t kstep = (size_t)(BK * 2);
    const size_t hstep = (size_t)HALF * K * 2;
    const unsigned ldsw = (unsigned)wid * 1024u;
    const int aoff = lds_byte(wr * 64 + fr, fq * 8), boff = lds_byte(wc * 32 + fr, fq * 8);
    const char* Ab = (const char*)g.A;
#define PG8_SA(b, h) (((b) * 2 + (h)) * HTB)
#define PG8_SB(b, h) ((4 + (b) * 2 + (h)) * HTB)
#define PG8_STAGE(bufoff, gbase, voff) do { _Pragma("unroll") for (int _i = 0; _i < 2; ++_i) \
        __builtin_amdgcn_global_load_lds((const unsigned*)((const char*)(gbase) + (voff)[_i]), (LAS unsigned*)(lds + (bufoff) + ldsw + _i * 8192), 16, 0, 0); } while (0)
#define PG8_LDA(dst, b, h) do { _Pragma("unroll") for (int m = 0; m < 4; ++m) _Pragma("unroll") for (int k = 0; k < 2; ++k) dst[m][k] = *(const LAS bf16x8*)(lds + PG8_SA(b, h) + aoff + m * 2048 + k * 1024); } while (0)
#define PG8_LDB(dst, b, h) do { _Pragma("unroll") for (int n = 0; n < 2; ++n) _Pragma("unroll") for (int k = 0; k < 2; ++k) dst[n][k] = *(const LAS bf16x8*)(lds + PG8_SB(b, h) + boff + n * 2048 + k * 1024); } while (0)
#define PG8_MMA(ai, bj, At, Bt) do { __builtin_amdgcn_s_setprio(1); _Pragma("unroll") for (int m = 0; m < 4; ++m) _Pragma("unroll") for (int n = 0; n < 2; ++n) _Pragma("unroll") for (int k = 0; k < 2; ++k) \
        acc[ai][bj][m][n] = __builtin_amdgcn_mfma_f32_16x16x32_bf16(Bt[n][k], At[m][k], acc[ai][bj][m][n], 0, 0, 0); __builtin_amdgcn_s_setprio(0); } while (0)
#define PG8_WAIT_V(n) asm volatile("s_waitcnt vmcnt(" #n ")" ::: "memory")
#define PG8_WAIT_L(n) asm volatile("s_waitcnt lgkmcnt(" #n ")" ::: "memory")
#define PG8_BAR __builtin_amdgcn_s_barrier()
#define PG8_SCHED __builtin_amdgcn_sched_barrier(0)
    Unit cur, nxt; int ui = 0;
    if (!S.next(0, cur)) return;
    f32x4 acc[2][2][4][2];
#pragma unroll
    for (int a = 0; a < 2; ++a)
#pragma unroll
        for (int b = 0; b < 2; ++b)
#pragma unroll
            for (int m = 0; m < 4; ++m)
#pragma unroll
                for (int n = 0; n < 2; ++n) acc[a][b][m][n] = (f32x4){0.f, 0.f, 0.f, 0.f};
    bf16x8 At[4][2], B0[2][2], B1[2][2];
    unsigned ao[2][2], an[2][2];
    S.a_off(cur, sR, sC, ao);
    const char* cB = S.b_base(cur);
    PG8_STAGE(PG8_SB(0, 0), cB, voffB); PG8_STAGE(PG8_SB(0, 1), cB + hstep, voffB); PG8_STAGE(PG8_SA(0, 0), Ab, ao[0]); PG8_STAGE(PG8_SA(0, 1), Ab, ao[1]);
    if (wr == 1) PG8_BAR;
    PG8_WAIT_V(2); PG8_BAR;
    PG8_STAGE(PG8_SB(1, 0), cB + kstep, voffB); PG8_STAGE(PG8_SA(1, 0), Ab + kstep, ao[0]); PG8_STAGE(PG8_SB(1, 1), cB + hstep + kstep, voffB);
    PG8_WAIT_V(6); PG8_BAR;
    for (;;) {
        const bool has_next = S.next(ui + 1, nxt);
        const char* nB = cB;
        if (has_next) { S.a_off(nxt, sR, sC, an); nB = S.b_base(nxt); }
        else { an[0][0] = ao[0][0]; an[0][1] = ao[0][1]; an[1][0] = ao[1][0]; an[1][1] = ao[1][1]; }
#pragma unroll 1
        for (int t = 0; t < nt; t += 2) {
            const bool last = (t == nt - 2);
            const char* a1 = Ab + (size_t)(t + 1) * kstep;
            PG8_LDB(B0, 0, 0); PG8_LDB(B1, 0, 1); PG8_SCHED; PG8_LDA(At, 0, 0); PG8_STAGE(PG8_SA(1, 1), a1, ao[1]);
            PG8_WAIT_V(8); PG8_WAIT_L(0); PG8_BAR; PG8_MMA(0, 0, At, B0); PG8_MMA(0, 1, At, B1); PG8_BAR; PG8_SCHED;
            const char* a2 = last ? Ab : Ab + (size_t)(t + 2) * kstep; const char* b2 = last ? nB : cB + (size_t)(t + 2) * kstep;
            if (last) { ao[0][0] = an[0][0]; ao[0][1] = an[0][1]; ao[1][0] = an[1][0]; ao[1][1] = an[1][1]; }
            const char* a3 = a2 + kstep; const char* b3 = b2 + kstep;
            PG8_LDA(At, 0, 1); PG8_STAGE(PG8_SB(0, 0), b2, voffB); PG8_STAGE(PG8_SB(0, 1), b2 + hstep, voffB); PG8_STAGE(PG8_SA(0, 0), a2, ao[0]);
            PG8_WAIT_V(8); PG8_WAIT_L(0); PG8_BAR; PG8_MMA(1, 0, At, B0); PG8_MMA(1, 1, At, B1); PG8_BAR; PG8_SCHED;
            PG8_LDB(B0, 1, 0); PG8_LDB(B1, 1, 1); PG8_SCHED; PG8_LDA(At, 1, 0); PG8_STAGE(PG8_SA(0, 1), a2, ao[1]);
            PG8_WAIT_V(8); PG8_WAIT_L(0); PG8_BAR; PG8_MMA(0, 0, At, B0); PG8_MMA(0, 1, At, B1); PG8_BAR; PG8_SCHED;
            PG8_LDA(At, 1, 1); PG8_STAGE(PG8_SB(1, 0), b3, voffB); PG8_STAGE(PG8_SB(1, 1), b3 + hstep, voffB); PG8_STAGE(PG8_SA(1, 0), a3, ao[0]);
            PG8_WAIT_V(8); PG8_WAIT_L(0); PG8_BAR; PG8_MMA(1, 0, At, B0); PG8_MMA(1, 1, At, B1); PG8_BAR; PG8_SCHED;
        }
        if constexpr (ALIGN_EPI) { if (wr == 0) PG8_BAR; }
        E(acc, cur, wr, wc, fr, fq);
        if (!has_next) break;
#pragma unroll
        for (int a = 0; a < 2; ++a)
#pragma unroll
            for (int b = 0; b < 2; ++b)
#pragma unroll
                for (int m = 0; m < 4; ++m)
#pragma unroll
                    for (int n = 0; n < 2; ++n) acc[a][b][m][n] = (f32x4){0.f, 0.f, 0.f, 0.f};
        cur = nxt; cB = nB; ++ui;
        if constexpr (ALIGN_EPI) { if (wr == 1) PG8_BAR; }
    }
    PG8_WAIT_V(0);
    if constexpr (!ALIGN_EPI) { if (wr == 0) PG8_BAR; }
    PG8_BAR;
#undef PG8_SA
#undef PG8_SB
#undef PG8_STAGE
#undef PG8_LDA
#undef PG8_LDB
#undef PG8_MMA
#undef PG8_WAIT_V
#undef PG8_WAIT_L
#undef PG8_BAR
#undef PG8_SCHED
}

struct PlainSched {
    const bf16* Bt; int K, nM, nN, nwg, G, c;
    __device__ void init(const bf16* Bt_, int M_, int N_, int K_, int G_, int c_) { Bt = Bt_; K = K_; nM = M_ / BM; nN = N_ / BM; nwg = nM * nN; G = G_; c = c_; }
    __device__ __forceinline__ bool next(int i, Unit& u) const {
        const long L = (long)i * G + c; if (L >= nwg) return false;
        int wgid = (int)L; { const int q = nwg / NXCD, r = nwg % NXCD, xcd = wgid % NXCD, off = wgid / NXCD; wgid = (xcd < r ? xcd * (q + 1) : r * (q + 1) + (xcd - r) * q) + off; }
        const int nig = WGM * nN, gid = wgid / nig, fm = gid * WGM, gsz = (nM - fm) < WGM ? (nM - fm) : WGM;
        u.pm = fm + ((wgid % nig) % gsz); u.pn = (wgid % nig) / gsz; u.e = 0; u.nrows = BM; return true;
    }
    __device__ __forceinline__ void a_off(const Unit& u, const int (&R)[2], const int (&C)[2], unsigned (&off)[2][2]) const {
#pragma unroll
        for (int h = 0; h < 2; ++h)
#pragma unroll
            for (int i = 0; i < 2; ++i) off[h][i] = (unsigned)(((u.pm * BM + h * HALF + R[i]) * K + C[i]) * 2);
    }
    __device__ __forceinline__ const char* b_base(const Unit& u) const { return (const char*)Bt + (size_t)u.pn * BM * K * 2; }
};

struct EpiStoreBf16 {
    static constexpr bool PERM = true;
    bf16* O; int ldc;
    __device__ __forceinline__ void operator()(const f32x4 (&acc)[2][2][4][2], const Unit& u, int wr, int wc, int fr, int fq) const {
        const int row0 = u.pm * BM + wr * 64 + fr, col0 = u.pn * BM + wc * 32 + 8 * fq;
#pragma unroll
        for (int ai = 0; ai < 2; ++ai)
#pragma unroll
            for (int m = 0; m < 4; ++m) { bf16* rowp = O + (size_t)(row0 + ai * HALF + m * 16) * ldc + col0;
#pragma unroll
                for (int bj = 0; bj < 2; ++bj) { const f32x4 v0 = acc[ai][bj][m][0], v1 = acc[ai][bj][m][1];
                    u32x4 w; w.x = cvt_pk_bf16(v0[0], v0[1]); w.y = cvt_pk_bf16(v0[2], v0[3]); w.z = cvt_pk_bf16(v1[0], v1[1]); w.w = cvt_pk_bf16(v1[2], v1[3]);
                    *(u32x4*)(rowp + bj * HALF) = w; } }
    }
};
struct EpiResF32 {
    static constexpr bool PERM = false;
    const float* base; float* out; int ldc;
    __device__ __forceinline__ void operator()(const f32x4 (&acc)[2][2][4][2], const Unit& u, int wr, int wc, int fr, int fq) const {
        const int row0 = u.pm * BM + wr * 64 + fr, col0 = u.pn * BM + wc * 32 + 4 * fq;
#pragma unroll
        for (int ai = 0; ai < 2; ++ai)
#pragma unroll
            for (int m = 0; m < 4; ++m) { const size_t off = (size_t)(row0 + ai * HALF + m * 16) * ldc + col0;
#pragma unroll
                for (int bj = 0; bj < 2; ++bj)
#pragma unroll
                    for (int n = 0; n < 2; ++n) { const f32x4 b = *(const f32x4*)(base + off + bj * HALF + n * 16); *(f32x4*)(out + off + bj * HALF + n * 16) = b + acc[ai][bj][m][n]; } }
    }
};
struct EpiQ {
    static constexpr bool PERM = true;
    bf16* Q; const float* cosT; const float* sinT;
    __device__ __forceinline__ void operator()(const f32x4 (&acc)[2][2][4][2], const Unit& u, int wr, int wc, int fr, int fq) const {
        const int row0 = u.pm * BM + wr * 64 + fr;
#pragma unroll
        for (int bj = 0; bj < 2; ++bj) {
            const int k64 = 4 * u.pn + 2 * bj + (wc >> 1), head = k64 / 3, type = k64 % 3, blk = wc & 1;
            if (type < 2) {
                const int dim = 64 * type + 32 * blk + 8 * fq;
#pragma unroll
                for (int ai = 0; ai < 2; ++ai)
#pragma unroll
                    for (int m = 0; m < 4; ++m) { const int r = row0 + ai * HALF + m * 16; const f32x4 v0 = acc[ai][bj][m][0], v1 = acc[ai][bj][m][1];
                        u32x4 w; w.x = cvt_pk_bf16(v0[0], v0[1]); w.y = cvt_pk_bf16(v0[2], v0[3]); w.z = cvt_pk_bf16(v1[0], v1[1]); w.w = cvt_pk_bf16(v1[2], v1[3]);
                        *(u32x4*)(Q + ((size_t)r * NH + head) * DQK + dim) = w; }
            } else {
                const int i0 = 16 * blk + 4 * fq;
#pragma unroll
                for (int ai = 0; ai < 2; ++ai)
#pragma unroll
                    for (int m = 0; m < 4; ++m) { const int r = row0 + ai * HALF + m * 16, pos = (r % S) + NMETA;
                        const f32x4 cs = *(const f32x4*)(cosT + pos * 32 + i0), sn = *(const f32x4*)(sinT + pos * 32 + i0);
                        const f32x4 x1 = acc[ai][bj][m][0], x2 = acc[ai][bj][m][1];
                        const f32x4 o1 = x1 * cs - x2 * sn, o2 = x1 * sn + x2 * cs;
                        bf16* dst = Q + ((size_t)r * NH + head) * DQK + 128 + i0;
                        u32x2 w1; w1.x = cvt_pk_bf16(o1[0], o1[1]); w1.y = cvt_pk_bf16(o1[2], o1[3]); *(u32x2*)(dst) = w1;
                        u32x2 w2; w2.x = cvt_pk_bf16(o2[0], o2[1]); w2.y = cvt_pk_bf16(o2[2], o2[3]); *(u32x2*)(dst + 32) = w2; }
            }
        }
    }
};
struct EpiKn {
    static constexpr bool PERM = true;
    bf16* kn;
    __device__ __forceinline__ void operator()(const f32x4 (&acc)[2][2][4][2], const Unit& u, int wr, int wc, int fr, int fq) const {
        const int row0 = u.pm * BM + wr * 64 + fr, col0 = u.pn * BM + wc * 32 + 8 * fq;
#pragma unroll
        for (int ai = 0; ai < 2; ++ai)
#pragma unroll
            for (int m = 0; m < 4; ++m) { const int r = row0 + ai * HALF + m * 16, b = r / S, pos = (r % S) + NMETA; bf16* rowp = kn + (size_t)(b * LP + pos) * (NH * 128) + col0;
#pragma unroll
                for (int bj = 0; bj < 2; ++bj) { const f32x4 v0 = acc[ai][bj][m][0], v1 = acc[ai][bj][m][1];
                    u32x4 w; w.x = cvt_pk_bf16(v0[0], v0[1]); w.y = cvt_pk_bf16(v0[2], v0[3]); w.z = cvt_pk_bf16(v1[0], v1[1]); w.w = cvt_pk_bf16(v1[2], v1[3]);
                    *(u32x4*)(rowp + bj * HALF) = w; } }
    }
};
struct EpiVt {
    static constexpr bool PERM = true;
    bf16* vt;
    __device__ __forceinline__ void operator()(const f32x4 (&acc)[2][2][4][2], const Unit& u, int wr, int wc, int fr, int fq) const {
        const int f0 = u.pm * BM + wr * 64 + fr, tk0 = u.pn * BM + wc * 32 + 8 * fq;
#pragma unroll
        for (int ai = 0; ai < 2; ++ai)
#pragma unroll
            for (int m = 0; m < 4; ++m) { const int f = f0 + ai * HALF + m * 16;
#pragma unroll
                for (int bj = 0; bj < 2; ++bj) { const int tk = tk0 + bj * HALF, b = tk / S, t = tk % S; const f32x4 v0 = acc[ai][bj][m][0], v1 = acc[ai][bj][m][1];
                    u32x4 w; w.x = cvt_pk_bf16(v0[0], v0[1]); w.y = cvt_pk_bf16(v0[2], v0[3]); w.z = cvt_pk_bf16(v1[0], v1[1]); w.w = cvt_pk_bf16(v1[2], v1[3]);
                    *(u32x4*)(vt + ((size_t)b * (NH * 128) + f) * LP + NMETA + t) = w; } }
    }
};
template <bool GATHER>
struct MoeSched {
    const bf16* W; size_t wbytes;
    const unsigned* cnt; const int* rowtok; const LAS int* tab;
    int K, nN, G, c;
    __device__ __forceinline__ bool next(int i, Unit& u) const {
        const int total = tab[32] * nN; const int L = i * G + c; if (L >= total) return false;
        const int gt = L / nN; int e = 0;
#pragma unroll
        for (int j = 1; j < 32; ++j) e += (gt >= tab[j]) ? 1 : 0;
        e = __builtin_amdgcn_readfirstlane(e);
        u.pm = __builtin_amdgcn_readfirstlane(gt); u.pn = __builtin_amdgcn_readfirstlane(L % nN); u.e = e;
        u.nrows = __builtin_amdgcn_readfirstlane((int)cnt[e] - (gt - tab[e]) * BM);
        return true;
    }
    __device__ __forceinline__ void a_off(const Unit& u, const int (&R)[2], const int (&C)[2], unsigned (&off)[2][2]) const {
#pragma unroll
        for (int h = 0; h < 2; ++h)
#pragma unroll
            for (int i = 0; i < 2; ++i) {
                if (GATHER) { const int lt = (u.pm - tab[u.e]) * BM; int li = h * HALF + R[i]; li = li < u.nrows ? li : u.nrows - 1;
                    const int tok = rowtok[u.e * M + lt + li]; off[h][i] = (unsigned)((tok * K + C[i]) * 2); }
                else off[h][i] = (unsigned)(((u.pm * BM + h * HALF + R[i]) * K + C[i]) * 2);
            }
    }
    __device__ __forceinline__ const char* b_base(const Unit& u) const { return (const char*)W + (size_t)u.e * wbytes + (size_t)u.pn * BM * K * 2; }
};
struct EpiMoe1 {
    static constexpr bool PERM = true;
    bf16* act; const float* b_gu;
    __device__ __forceinline__ void operator()(const f32x4 (&acc)[2][2][4][2], const Unit& u, int wr, int wc, int fr, int fq) const {
        const int row0 = u.pm * BM + wr * 64 + fr, cc = u.pn * HALF + wc * 32 + 8 * fq;
        const float* bias = b_gu + (size_t)u.e * 4096 + cc;
        const f32x4 bg0 = *(const f32x4*)(bias), bg1 = *(const f32x4*)(bias + 4), bl0 = *(const f32x4*)(bias + 2048), bl1 = *(const f32x4*)(bias + 2048 + 4);
#pragma unroll
        for (int ai = 0; ai < 2; ++ai)
#pragma unroll
            for (int m = 0; m < 4; ++m) {
                f32x4 o[2];
#pragma unroll
                for (int n = 0; n < 2; ++n) { const f32x4 gv = acc[ai][0][m][n] + (n ? bg1 : bg0), lv = acc[ai][1][m][n] + (n ? bl1 : bl0);
#pragma unroll
                    for (int j = 0; j < 4; ++j) { const float g = fminf(gv[j], 7.0f), l = fminf(fmaxf(lv[j], -7.0f), 7.0f);
                        o[n][j] = (l + 1.0f) * g * __builtin_amdgcn_rcpf(1.0f + __builtin_amdgcn_exp2f(-1.702f * 1.4426950408889634f * g)); } }
                u32x4 w; w.x = cvt_pk_bf16(o[0][0], o[0][1]); w.y = cvt_pk_bf16(o[0][2], o[0][3]); w.z = cvt_pk_bf16(o[1][0], o[1][1]); w.w = cvt_pk_bf16(o[1][2], o[1][3]);
                *(u32x4*)(act + (size_t)(row0 + ai * HALF + m * 16) * DFF + cc) = w;
            }
    }
};
struct EpiMoe2 {
    static constexpr bool PERM = true;
    bf16* y; const float* b_d;
    __device__ __forceinline__ void operator()(const f32x4 (&acc)[2][2][4][2], const Unit& u, int wr, int wc, int fr, int fq) const {
        const int row0 = u.pm * BM + wr * 64 + fr, col0 = u.pn * BM + wc * 32 + 8 * fq;
        const float* bias = b_d + (size_t)u.e * D + col0;
        f32x4 bv[2][2];
#pragma unroll
        for (int bj = 0; bj < 2; ++bj)
#pragma unroll
            for (int n = 0; n < 2; ++n) bv[bj][n] = *(const f32x4*)(bias + bj * HALF + 4 * n);
#pragma unroll
        for (int ai = 0; ai < 2; ++ai)
#pragma unroll
            for (int m = 0; m < 4; ++m) { bf16* rowp = y + (size_t)(row0 + ai * HALF + m * 16) * D + col0;
#pragma unroll
                for (int bj = 0; bj < 2; ++bj) { const f32x4 v0 = acc[ai][bj][m][0] + bv[bj][0], v1 = acc[ai][bj][m][1] + bv[bj][1];
                    u32x4 w; w.x = cvt_pk_bf16(v0[0], v0[1]); w.y = cvt_pk_bf16(v0[2], v0[3]); w.z = cvt_pk_bf16(v1[0], v1[1]); w.w = cvt_pk_bf16(v1[2], v1[3]);
                    *(u32x4*)(rowp + bj * HALF) = w; } }
    }
};
}

namespace att {
typedef float f32x16 __attribute__((ext_vector_type(16)));
constexpr int KPITCH = 400, VPITCH = 144;
constexpr int KBYTES = 64 * KPITCH, VBYTES = 128 * VPITCH, STAGE = KBYTES + VBYTES;
constexpr int WSF_OFF = 2 * STAGE;
static_assert(WSF_OFF + 8 * 256 <= RING_BYTES, "attention LDS");
constexpr float SC = 0.07216878364870322f * 1.4426950408889634f;

__device__ __forceinline__ int crow(int r, int hi) { return (r & 3) + 8 * (r >> 2) + 4 * hi; }

__device__ __forceinline__ void attn_unit(LAS unsigned char* lds, int b, int h, int qb, const bf16* __restrict__ Q, const bf16* __restrict__ Kn, const bf16* __restrict__ Kpe,
                                          const bf16* __restrict__ Vt, const float* __restrict__ g_attn, bf16* __restrict__ mixed) {
    const int tid = threadIdx.x, lane = tid & 63, r32 = lane & 31, hi = lane >> 5, wid = __builtin_amdgcn_readfirstlane(tid >> 6);
    const int t0 = qb * 256 + wid * 32;
    const int m0 = b * S + t0;
    const int wave_max_pos = t0 + 31 + NMETA, wave_min_pos = t0 + NMETA;
    const int NT = (qb * 256 + 255 + NMETA) / 64 + 1;
    LAS float* wsf = (LAS float*)(lds + WSF_OFF) + wid * 64;
    const bf16* ksrc[3]; unsigned kdst[3];
#pragma unroll
    for (int i = 0; i < 3; ++i) { const int id = tid + 512 * i, key = id / 24, c = id % 24;
        ksrc[i] = c < 16 ? Kn + ((size_t)(b * LP + key) * NH + h) * 128 + c * 8 : Kpe + (size_t)(b * LP + key) * ROPE + (c - 16) * 8;
        const int row = (key & ~12) | ((key & 4) << 1) | ((key & 8) >> 1);
        kdst[i] = (unsigned)(row * KPITCH + c * 16); }
    unsigned kstr[3];
#pragma unroll
    for (int i = 0; i < 3; ++i) kstr[i] = ((tid + 512 * i) % 24) < 16 ? 64u * NH * 128 : 64u * ROPE;
    const bf16* vsrc[2]; unsigned vdst[2];
#pragma unroll
    for (int i = 0; i < 2; ++i) { const int id = tid + 512 * i, d = id >> 3, kc = id & 7;
        vsrc[i] = Vt + ((size_t)(b * NH + h) * 128 + d) * LP + kc * 8; vdst[i] = (unsigned)(KBYTES + d * VPITCH + kc * 16); }
    bf16x8 qf[12];
    { const bf16* qp = Q + ((size_t)(m0 + r32) * NH + h) * DQK + 8 * hi;
#pragma unroll
      for (int ks = 0; ks < 12; ++ks) qf[ks] = *(const bf16x8*)(qp + ks * 16); }
    f32x16 o[4];
#pragma unroll
    for (int d = 0; d < 4; ++d)
#pragma unroll
        for (int r = 0; r < 16; ++r) o[d][r] = 0.f;
    float mrow = -INFINITY, lsum = 0.f;
    u32x4 kreg[3], vreg[2];
#pragma unroll
    for (int i = 0; i < 3; ++i) kreg[i] = *(const u32x4*)(ksrc[i]);
#pragma unroll
    for (int i = 0; i < 2; ++i) vreg[i] = *(const u32x4*)(vsrc[i]);
#pragma unroll
    for (int i = 0; i < 3; ++i) *(LAS u32x4*)(lds + kdst[i]) = kreg[i];
#pragma unroll
    for (int i = 0; i < 2; ++i) *(LAS u32x4*)(lds + vdst[i]) = vreg[i];
    __syncthreads();
    for (int t = 0; t < NT; ++t) {
        const bool more = t + 1 < NT;
        if (more) {
#pragma unroll
            for (int i = 0; i < 3; ++i) kreg[i] = *(const u32x4*)(ksrc[i] + (size_t)(t + 1) * kstr[i]);
#pragma unroll
            for (int i = 0; i < 2; ++i) vreg[i] = *(const u32x4*)(vsrc[i] + (size_t)(t + 1) * 64);
        }
        const int kb = t * 64;
        if (kb <= wave_max_pos) {
            const LAS unsigned char* Kb = lds + (t & 1) * STAGE; const LAS unsigned char* Vb = Kb + KBYTES;
            f32x16 p0, p1;
#pragma unroll
            for (int r = 0; r < 16; ++r) { p0[r] = 0.f; p1[r] = 0.f; }
            const LAS unsigned char* kp = Kb + r32 * KPITCH + hi * 16;
#pragma unroll
            for (int ks = 0; ks < 12; ++ks) {
                const bf16x8 k0 = *(const LAS bf16x8*)(kp + ks * 32), k1 = *(const LAS bf16x8*)(kp + 32 * KPITCH + ks * 32);
                p0 = __builtin_amdgcn_mfma_f32_32x32x16_bf16(k0, qf[ks], p0, 0, 0, 0);
                p1 = __builtin_amdgcn_mfma_f32_32x32x16_bf16(k1, qf[ks], p1, 0, 0, 0);
            }
            if (kb + 63 > wave_min_pos) {
                const int qpos = t0 + r32 + NMETA, kbase = kb + 8 * hi;
#pragma unroll
                for (int r = 0; r < 16; ++r) { const int key = kbase + 16 * (r >> 3) + (r & 7); if (key > qpos) p0[r] = -INFINITY; if (key + 32 > qpos) p1[r] = -INFINITY; }
            }
            float mx = fmaxf(p0[0], p1[0]);
#pragma unroll
            for (int r = 1; r < 16; ++r) mx = fmaxf(mx, fmaxf(p0[r], p1[r]));
            mx = fmaxf(mx, __shfl_xor(mx, 32));
            const float mnew = fmaxf(mrow, mx);
            const bool grew = __any(mnew > mrow);
            if (grew) {
                const float corr = __builtin_amdgcn_exp2f((mrow - mnew) * SC);
                lsum *= corr; mrow = mnew;
                if (hi == 0) wsf[r32] = corr;
                asm volatile("s_waitcnt lgkmcnt(0)" ::: "memory");
#pragma unroll
                for (int g = 0; g < 4; ++g) { const f32x4 f = *(const LAS f32x4*)(wsf + 8 * g + 4 * hi);
#pragma unroll
                    for (int d = 0; d < 4; ++d) { o[d][4 * g + 0] *= f.x; o[d][4 * g + 1] *= f.y; o[d][4 * g + 2] *= f.z; o[d][4 * g + 3] *= f.w; } }
            }
            const float nm = -mrow * SC;
            float ps = 0.f;
#pragma unroll
            for (int r = 0; r < 16; ++r) { p0[r] = __builtin_amdgcn_exp2f(__builtin_fmaf(p0[r], SC, nm)); p1[r] = __builtin_amdgcn_exp2f(__builtin_fmaf(p1[r], SC, nm)); ps += p0[r] + p1[r]; }
            lsum += ps;
            u32x4 pa[4];
            pa[0] = (u32x4){pg8::cvt_pk_bf16(p0[0], p0[1]), pg8::cvt_pk_bf16(p0[2], p0[3]), pg8::cvt_pk_bf16(p0[4], p0[5]), pg8::cvt_pk_bf16(p0[6], p0[7])};
            pa[1] = (u32x4){pg8::cvt_pk_bf16(p0[8], p0[9]), pg8::cvt_pk_bf16(p0[10], p0[11]), pg8::cvt_pk_bf16(p0[12], p0[13]), pg8::cvt_pk_bf16(p0[14], p0[15])};
            pa[2] = (u32x4){pg8::cvt_pk_bf16(p1[0], p1[1]), pg8::cvt_pk_bf16(p1[2], p1[3]), pg8::cvt_pk_bf16(p1[4], p1[5]), pg8::cvt_pk_bf16(p1[6], p1[7])};
            pa[3] = (u32x4){pg8::cvt_pk_bf16(p1[8], p1[9]), pg8::cvt_pk_bf16(p1[10], p1[11]), pg8::cvt_pk_bf16(p1[12], p1[13]), pg8::cvt_pk_bf16(p1[14], p1[15])};
            const LAS unsigned char* vp = Vb + r32 * VPITCH + hi * 16;
#pragma unroll
            for (int d = 0; d < 4; ++d)
#pragma unroll
                for (int s = 0; s < 4; ++s) { const bf16x8 vf = *(const LAS bf16x8*)(vp + d * 32 * VPITCH + s * 32);
                    o[d] = __builtin_amdgcn_mfma_f32_32x32x16_bf16(__builtin_bit_cast(bf16x8, pa[s]), vf, o[d], 0, 0, 0); }
        }
        if (more) {
            LAS unsigned char* nb = lds + ((t + 1) & 1) * STAGE;
#pragma unroll
            for (int i = 0; i < 3; ++i) *(LAS u32x4*)(nb + kdst[i]) = kreg[i];
#pragma unroll
            for (int i = 0; i < 2; ++i) *(LAS u32x4*)(nb + vdst[i]) = vreg[i];
        }
        __syncthreads();
    }
    lsum += __shfl_xor(lsum, 32);
    if (hi == 0) wsf[r32] = 1.0f / lsum;
    asm volatile("s_waitcnt lgkmcnt(0)" ::: "memory");
    float ss[16];
#pragma unroll
    for (int g = 0; g < 4; ++g) { const f32x4 f = *(const LAS f32x4*)(wsf + 8 * g + 4 * hi);
#pragma unroll
        for (int j = 0; j < 4; ++j) { const float il = j == 0 ? f.x : j == 1 ? f.y : j == 2 ? f.z : f.w; float a = 0.f;
#pragma unroll
            for (int d = 0; d < 4; ++d) { o[d][4 * g + j] *= il; a += o[d][4 * g + j] * o[d][4 * g + j]; }
            ss[4 * g + j] = a; } }
#pragma unroll
    for (int r = 0; r < 16; ++r) {
#pragma unroll
        for (int of = 1; of < 32; of <<= 1) ss[r] += __shfl_xor(ss[r], of);
        ss[r] = rsqrtf(ss[r] * (1.f / 128.f) + EPS);
    }
    float gv[4];
#pragma unroll
    for (int d = 0; d < 4; ++d) gv[d] = g_attn[h * DV + d * 32 + r32];
#pragma unroll
    for (int r = 0; r < 16; ++r) { bf16* dst = mixed + (size_t)(m0 + crow(r, hi)) * D + DCONV + h * DV + r32;
#pragma unroll
        for (int d = 0; d < 4; ++d) dst[d * 32] = f2bf(o[d][r] * ss[r] * gv[d]); }
    __syncthreads();
}
}

struct Ctx { int lane, wave, tid, gw, NGW, wg, G; LAS unsigned char* lds; };

template <int MODE> __device__ __forceinline__ int drow_of(int n) {
    if (MODE == 1) { const int bj = n / 2048, c = n % 2048; return 256 * (c / 128) + 128 * bj + (c % 128); }
    if (MODE == 2) { const int k64 = n >> 6, w = n & 63; if (k64 % 3 != 2) return n; const int part = w >> 5, i = w & 31; return (k64 << 6) + 32 * (i >> 4) + 8 * ((i & 15) >> 2) + 4 * part + (i & 3); }
    if (MODE == 3) { return (n & 128) ? -1 : (n >> 8) * 128 + (n & 127); }
    if (MODE == 4) { return (n & 128) ? (n >> 8) * 128 + (n & 127) : -1; }
    return n;
}
template <int MODE>
__device__ __forceinline__ void transpose_item(const float* W, int K, int N, bf16* WT, LAS float* scr, int item, int lane) {
    const int nblk = N / 32, kb = item / nblk, nb = item % nblk, k0 = 64 * kb, n0 = 32 * nb;
#pragma unroll 8
    for (int i = 0; i < 32; ++i) { const int kk = 2 * i + (lane >> 5); scr[kk * 33 + (lane & 31)] = W[(size_t)(k0 + kk) * N + n0 + (lane & 31)]; }
    LDS_WAIT(); asm volatile("" ::: "memory");
    const int c = lane & 7;
#pragma unroll
    for (int j = 0; j < 4; ++j) { const int n = (lane >> 3) + 8 * j; const LAS float* s = scr + (8 * c) * 33 + n;
        u32x4 o; o.x = pk2(s[0 * 33], s[1 * 33]); o.y = pk2(s[2 * 33], s[3 * 33]); o.z = pk2(s[4 * 33], s[5 * 33]); o.w = pk2(s[6 * 33], s[7 * 33]);
        const int dr = drow_of<MODE>(n0 + n);
        if (dr >= 0) *(u32x4*)(WT + (size_t)dr * K + k0 + 8 * c) = o; }
    LDS_WAIT(); asm volatile("" ::: "memory");
}
template <int MODE>
__device__ __forceinline__ void transpose_all(const Ctx& c, const float* W, int K, int N, int NOUT, int NEXP, bf16* WT) {
    LAS float* scr = (LAS float*)(c.lds + c.wave * 16384);
    const int per = (K / 64) * (N / 32), total = per * NEXP;
    for (int it = c.gw; it < total; it += c.NGW) { const int e = it / per, r = it % per;
        transpose_item<MODE>(W + (size_t)e * K * N, K, N, WT + (size_t)e * NOUT * K, scr, r, c.lane); }
}

__device__ __forceinline__ void norm1_row(int R, int lane, const float* x, const float* meta, const float* g, bf16* hn) {
    const float* src = R < M ? x + (size_t)R * D : meta + (size_t)(R - M) * D;
    f32x4 v[8]; float ss = 0.f;
#pragma unroll
    for (int j = 0; j < 8; ++j) { v[j] = *(const f32x4*)(src + j * 256 + lane * 4); ss += v[j].x * v[j].x + v[j].y * v[j].y + v[j].z * v[j].z + v[j].w * v[j].w; }
    const float rstd = rsqrtf(wave_sum(ss) * (1.f / D) + EPS);
#pragma unroll
    for (int j = 0; j < 8; ++j) {
        const f32x4 gg = *(const f32x4*)(g + j * 256 + lane * 4);
        u32x2 o; o.x = pk2(v[j].x * rstd * gg.x, v[j].y * rstd * gg.y); o.y = pk2(v[j].z * rstd * gg.z, v[j].w * rstd * gg.w);
        *(u32x2*)(hn + (size_t)R * D + j * 256 + lane * 4) = o;
    }
}

struct EpiProj { bf16* proj; int roff; __device__ void operator()(int m, int n, float v) const { proj[(size_t)(m + roff) * DINP + n] = f2bf(v); } };
struct EpiQraw { float* q; __device__ void operator()(int m, int n, float v) const { if (m < M) q[(size_t)m * 1536 + n] = v; } };
struct EpiKV {
    bf16* kn; bf16* vv; int roff;
    __device__ void operator()(int r, int n, float v) const {
        const int R = r + roff; if (R < M || R >= MR) return;
        const int h = n >> 8, part = (n >> 7) & 1, d = n & 127, pos = R - M; const bf16 o = f2bf(v);
        for (int b = 0; b < NB; ++b) {
            if (part) vv[((size_t)(b * NH + h) * 128 + d) * LP + pos] = o;
            else kn[((size_t)(b * LP + pos) * NH + h) * 128 + d] = o;
        }
    }
};
struct EpiWout { const float* x; float* h1; __device__ void operator()(int m, int n, float v) const { h1[(size_t)m * D + n] = x[(size_t)m * D + n] + v; } };

template <class Epi>
__device__ __forceinline__ void gemm_simple(const Ctx& c, const bf16* __restrict__ A, int lda, const bf16* __restrict__ Bt, int ldb, int K, int nMt, int nNt, const Epi& epi) {
    const int r = c.lane & 15, q = c.lane >> 4;
    for (int wt = c.gw; wt < nMt * nNt; wt += c.NGW) {
        const int m0 = (wt / nNt) * 32, n0 = (wt % nNt) * 32;
        f32x4 acc[2][2];
#pragma unroll
        for (int i = 0; i < 2; ++i)
#pragma unroll
            for (int j = 0; j < 2; ++j) acc[i][j] = (f32x4){0.f, 0.f, 0.f, 0.f};
        const bf16* a0 = A + (size_t)(m0 + r) * lda + 8 * q; const bf16* b0 = Bt + (size_t)(n0 + r) * ldb + 8 * q;
#pragma unroll 2
        for (int k0 = 0; k0 < K; k0 += 32) {
            bf16x8 a[2], b[2];
#pragma unroll
            for (int i = 0; i < 2; ++i) { a[i] = *(const bf16x8*)(a0 + (size_t)i * 16 * lda + k0); b[i] = *(const bf16x8*)(b0 + (size_t)i * 16 * ldb + k0); }
#pragma unroll
            for (int i = 0; i < 2; ++i)
#pragma unroll
                for (int j = 0; j < 2; ++j) acc[i][j] = __builtin_amdgcn_mfma_f32_16x16x32_bf16(a[i], b[j], acc[i][j], 0, 0, 0);
        }
#pragma unroll
        for (int i = 0; i < 2; ++i)
#pragma unroll
            for (int j = 0; j < 2; ++j)
#pragma unroll
                for (int t = 0; t < 4; ++t) epi(m0 + i * 16 + q * 4 + t, n0 + j * 16 + r, acc[i][j][t]);
    }
}

__device__ __forceinline__ float inv_freq(int i) { return powf(10000.0f, -(float)i / 32.0f); }

__device__ __forceinline__ void postproj_row(int R, int lane, const bf16* __restrict__ proj, const float* __restrict__ conv_w, const float* __restrict__ g_conv,
                                             const float* __restrict__ g_q, const float* __restrict__ g_kv,
                                             bf16* __restrict__ mixed, bf16* __restrict__ qn, bf16* __restrict__ kvn, bf16* __restrict__ kpe) {
    const bf16* pr = proj + (size_t)R * DINP;
    const bool meta = R >= M; const int b = meta ? 0 : R / S, t = meta ? 0 : R % S, pos = meta ? R - M : t + NMETA;
    {
        const u32x2 w = *(const u32x2*)(pr + O_KV + lane * 4);
        float f[4] = {__uint_as_float(w.x << 16), __uint_as_float(w.x & 0xffff0000u), __uint_as_float(w.y << 16), __uint_as_float(w.y & 0xffff0000u)};
        const float ss = wave_sum(f[0] * f[0] + f[1] * f[1] + f[2] * f[2] + f[3] * f[3]);
        const float rstd = rsqrtf(ss * (1.f / KVL) + EPS);
        const f32x4 g = *(const f32x4*)(g_kv + lane * 4);
        u32x2 o; o.x = pk2(f[0] * rstd * g.x, f[1] * rstd * g.y); o.y = pk2(f[2] * rstd * g.z, f[3] * rstd * g.w);
        *(u32x2*)(kvn + (size_t)R * KVL + lane * 4) = o;
    }
    if (lane < 32) {
        const float x1 = bf2f(pr[O_R + lane]), x2 = bf2f(pr[O_R + 32 + lane]);
        const float ang = (float)pos * inv_freq(lane); const float cs = cosf(ang), sn = sinf(ang);
        const bf16 o1 = f2bf(x1 * cs - x2 * sn), o2 = f2bf(x1 * sn + x2 * cs);
        if (!meta) { bf16* d = kpe + (size_t)(b * LP + pos) * ROPE; d[lane] = o1; d[32 + lane] = o2; }
        else { bf16* d0 = kpe + (size_t)(0 * LP + pos) * ROPE; bf16* d1 = kpe + (size_t)(1 * LP + pos) * ROPE; d0[lane] = o1; d0[32 + lane] = o2; d1[lane] = o1; d1[32 + lane] = o2; }
    }
    if (meta) return;
    {
        float f[8]; unpack8(*(const u32x4*)(pr + O_Q + lane * 8), f);
        float ss = 0.f;
#pragma unroll
        for (int i = 0; i < 8; ++i) ss += f[i] * f[i];
        const float rstd = rsqrtf(wave_sum(ss) * (1.f / QL) + EPS);
        const f32x4 g0 = *(const f32x4*)(g_q + lane * 8), g1 = *(const f32x4*)(g_q + lane * 8 + 4);
        u32x4 o; o.x = pk2(f[0] * rstd * g0.x, f[1] * rstd * g0.y); o.y = pk2(f[2] * rstd * g0.z, f[3] * rstd * g0.w);
        o.z = pk2(f[4] * rstd * g1.x, f[5] * rstd * g1.y); o.w = pk2(f[6] * rstd * g1.z, f[7] * rstd * g1.w);
        *(u32x4*)(qn + (size_t)R * QL + lane * 8) = o;
    }
    {
        const int r1 = (t >= 1) ? R - 1 : M + 15, r2 = (t >= 2) ? R - 2 : (t == 1 ? M + 15 : M + 14);
        const bf16* p1 = proj + (size_t)r1 * DINP; const bf16* p2 = proj + (size_t)r2 * DINP;
        const int c0 = lane * 16;
        float v[16]; float ss = 0.f;
#pragma unroll
        for (int hh = 0; hh < 2; ++hh) {
            const int c = c0 + hh * 8;
            float bg[8], cg0[8], ui0[8], cg1[8], ui1[8], cg2[8], ui2[8];
            unpack8(*(const u32x4*)(pr + c), bg); unpack8(*(const u32x4*)(pr + O_C + c), cg0); unpack8(*(const u32x4*)(pr + O_U + c), ui0);
            unpack8(*(const u32x4*)(p1 + O_C + c), cg1); unpack8(*(const u32x4*)(p1 + O_U + c), ui1);
            unpack8(*(const u32x4*)(p2 + O_C + c), cg2); unpack8(*(const u32x4*)(p2 + O_U + c), ui2);
#pragma unroll
            for (int i = 0; i < 8; ++i) {
                const float y = conv_w[2 * DCONV + c + i] * (cg0[i] * ui0[i]) + conv_w[1 * DCONV + c + i] * (cg1[i] * ui1[i]) + conv_w[0 * DCONV + c + i] * (cg2[i] * ui2[i]);
                const float o = bg[i] * y; v[hh * 8 + i] = o; ss += o * o;
            }
        }
        ss += __shfl_xor(ss, 1); ss += __shfl_xor(ss, 2);
        const float rstd = rsqrtf(ss * (1.f / 64.f) + EPS);
#pragma unroll
        for (int hh = 0; hh < 2; ++hh) {
            const int c = c0 + hh * 8;
            const f32x4 g0 = *(const f32x4*)(g_conv + c), g1 = *(const f32x4*)(g_conv + c + 4);
            u32x4 o; o.x = pk2(v[hh * 8 + 0] * rstd * g0.x, v[hh * 8 + 1] * rstd * g0.y); o.y = pk2(v[hh * 8 + 2] * rstd * g0.z, v[hh * 8 + 3] * rstd * g0.w);
            o.z = pk2(v[hh * 8 + 4] * rstd * g1.x, v[hh * 8 + 5] * rstd * g1.y); o.w = pk2(v[hh * 8 + 6] * rstd * g1.z, v[hh * 8 + 7] * rstd * g1.w);
            *(u32x4*)(mixed + (size_t)R * D + c) = o;
        }
    }
}

__device__ __forceinline__ void rope_q_row(int m, int lane, const float* __restrict__ qraw, bf16* __restrict__ Q) {
    const int pos = (m % S) + NMETA;
    float cs = 0.f, sn = 0.f;
    if (lane < 32) { const float ang = (float)pos * inv_freq(lane); cs = cosf(ang); sn = sinf(ang); }
    for (int h = 0; h < NH; ++h) {
        const float* src = qraw + (size_t)m * 1536 + h * DQK; bf16* dst = Q + ((size_t)m * NH + h) * DQK;
        dst[lane] = f2bf(src[lane]); dst[64 + lane] = f2bf(src[64 + lane]);
        if (lane < 32) { const float x1 = src[128 + lane], x2 = src[160 + lane]; dst[128 + lane] = f2bf(x1 * cs - x2 * sn); dst[160 + lane] = f2bf(x1 * sn + x2 * cs); }
    }
}

__device__ __forceinline__ void attn_simple_row(int wid, int lane, const bf16* __restrict__ Q, const bf16* __restrict__ Kn, const bf16* __restrict__ Kpe, const bf16* __restrict__ V,
                                                const float* __restrict__ g_attn, bf16* __restrict__ mixed) {
    const int m = wid / NH, h = wid % NH, b = m / S, pos = (m % S) + NMETA;
    const bf16* q = Q + ((size_t)m * NH + h) * DQK;
    const float scale = 0.07216878364870322f;
    const float q0 = bf2f(q[lane]) * scale, q1 = bf2f(q[64 + lane]) * scale, q2 = bf2f(q[128 + lane]) * scale;
    const bf16* kn = Kn + ((size_t)b * LP * NH + h) * 128; const bf16* vv = V + ((size_t)b * LP * NH + h) * 128; const bf16* kp = Kpe + (size_t)b * LP * ROPE;
    float mx = -INFINITY, sum = 0.f, o0 = 0.f, o1 = 0.f;
    for (int j = 0; j <= pos; j += 4) {
        float s[4], v0[4], v1[4];
#pragma unroll
        for (int u = 0; u < 4; ++u) {
            const size_t ro = (size_t)(j + u) * NH * 128;
            s[u] = q0 * bf2f(kn[ro + lane]) + q1 * bf2f(kn[ro + 64 + lane]) + q2 * bf2f(kp[(size_t)(j + u) * ROPE + lane]);
            v0[u] = bf2f(vv[ro + lane]); v1[u] = bf2f(vv[ro + 64 + lane]);
        }
#pragma unroll
        for (int o = 1; o < 64; o <<= 1) {
#pragma unroll
            for (int u = 0; u < 4; ++u) s[u] += __shfl_xor(s[u], o);
        }
#pragma unroll
        for (int u = 0; u < 4; ++u) if (j + u > pos) s[u] = -INFINITY;
        const float mn = fmaxf(fmaxf(mx, fmaxf(s[0], s[1])), fmaxf(s[2], s[3]));
        const float corr = __expf(mx - mn);
        sum *= corr; o0 *= corr; o1 *= corr;
#pragma unroll
        for (int u = 0; u < 4; ++u) { const float p = __expf(s[u] - mn); sum += p; o0 += p * v0[u]; o1 += p * v1[u]; }
        mx = mn;
    }
    const float inv = 1.f / sum; o0 *= inv; o1 *= inv;
    const float ss = wave_sum(o0 * o0 + o1 * o1);
    const float rstd = rsqrtf(ss * (1.f / 128.f) + EPS);
    bf16* dst = mixed + (size_t)m * D + DCONV + h * DV;
    dst[lane] = f2bf(o0 * rstd * g_attn[h * DV + lane]); dst[64 + lane] = f2bf(o1 * rstd * g_attn[h * DV + 64 + lane]);
}

__device__ __forceinline__ void router_row(int m, int lane, const float* __restrict__ h1, const float* __restrict__ g_ffn, const float* __restrict__ w_r, const float* __restrict__ b_r,
                                           bf16* __restrict__ xn, unsigned* __restrict__ cnt, int* __restrict__ rowtok, int* __restrict__ tok_e, int* __restrict__ tok_p, float* __restrict__ gate) {
    const float* src = h1 + (size_t)m * D;
    float ss = 0.f;
#pragma unroll
    for (int j = 0; j < 8; ++j) { const f32x4 t = *(const f32x4*)(src + j * 256 + lane * 4); ss += t.x * t.x + t.y * t.y + t.z * t.z + t.w * t.w; }
    const float rstd = rsqrtf(wave_sum(ss) * (1.f / D) + EPS);
    float acc[32];
#pragma unroll
    for (int e = 0; e < 32; ++e) acc[e] = 0.f;
#pragma unroll 1
    for (int j = 0; j < 8; ++j) {
        const f32x4 vv = *(const f32x4*)(src + j * 256 + lane * 4);
        const f32x4 gg = *(const f32x4*)(g_ffn + j * 256 + lane * 4);
        const float xv[4] = {vv.x * rstd * gg.x, vv.y * rstd * gg.y, vv.z * rstd * gg.z, vv.w * rstd * gg.w};
        u32x2 o; o.x = pk2(xv[0], xv[1]); o.y = pk2(xv[2], xv[3]);
        *(u32x2*)(xn + (size_t)m * D + j * 256 + lane * 4) = o;
#pragma unroll
        for (int i = 0; i < 4; ++i) {
            const float* wr = w_r + (size_t)(j * 256 + lane * 4 + i) * NE;
#pragma unroll
            for (int e4 = 0; e4 < 8; ++e4) { const f32x4 w = *(const f32x4*)(wr + e4 * 4);
                acc[e4 * 4 + 0] += xv[i] * w.x; acc[e4 * 4 + 1] += xv[i] * w.y; acc[e4 * 4 + 2] += xv[i] * w.z; acc[e4 * 4 + 3] += xv[i] * w.w; }
        }
    }
    float logit = -INFINITY;
#pragma unroll
    for (int e = 0; e < 32; ++e) { const float tot = wave_sum(acc[e]) + b_r[e]; if (lane == e) logit = tot; }
    float tv[4]; int ti[4];
#pragma unroll
    for (int k = 0; k < 4; ++k) {
        const float mxv = wave_max(logit);
        const unsigned long long mask = __ballot(logit == mxv);
        const int idx = __ffsll((long long)mask) - 1;
        tv[k] = mxv; ti[k] = idx;
        if (lane == idx) logit = -INFINITY;
    }
    float ex[4]; float es = 0.f;
#pragma unroll
    for (int k = 0; k < 4; ++k) { ex[k] = expf(tv[k] - tv[0]); es += ex[k]; }
    if (lane == 0) {
#pragma unroll
        for (int k = 0; k < 4; ++k) {
            const unsigned p = atomicAdd(&cnt[ti[k]], 1u);
            rowtok[ti[k] * M + p] = m; tok_e[m * 4 + k] = ti[k]; tok_p[m * 4 + k] = (int)p; gate[m * 4 + k] = ex[k] / es;
        }
    }
}

constexpr int RT_OFF = 0;
__device__ __forceinline__ void router_block(const Ctx& c, int blk, const float* __restrict__ h1, const float* __restrict__ g_ffn, const float* __restrict__ Wrt, const float* __restrict__ b_r,
                                             bf16* __restrict__ xn, unsigned* __restrict__ cnt, int* __restrict__ rowtok, int* __restrict__ tok_e, int* __restrict__ tok_p, float* __restrict__ gate) {
    LAS float* part = (LAS float*)(c.lds + RT_OFF); LAS float* srstd = part + 2 * 32 * 32;
    const int lane = c.lane, m0 = blk * 32;
#pragma unroll 1
    for (int r = 0; r < 4; ++r) {
        const int m = m0 + c.wave * 4 + r; const float* src = h1 + (size_t)m * D;
        f32x4 v[8]; float ss = 0.f;
#pragma unroll
        for (int j = 0; j < 8; ++j) { v[j] = *(const f32x4*)(src + j * 256 + lane * 4); ss += v[j].x * v[j].x + v[j].y * v[j].y + v[j].z * v[j].z + v[j].w * v[j].w; }
        const float rstd = rsqrtf(wave_sum(ss) * (1.f / D) + EPS);
#pragma unroll
        for (int j = 0; j < 8; ++j) { const f32x4 gg = *(const f32x4*)(g_ffn + j * 256 + lane * 4);
            u32x2 o; o.x = pk2(v[j].x * rstd * gg.x, v[j].y * rstd * gg.y); o.y = pk2(v[j].z * rstd * gg.z, v[j].w * rstd * gg.w);
            *(u32x2*)(xn + (size_t)m * D + j * 256 + lane * 4) = o; }
        if (lane == 0) srstd[c.wave * 4 + r] = rstd;
    }
    {
        const int ti = c.wave & 3, rt = ti >> 1, et = ti & 1, kh = c.wave >> 2, row = lane & 15, kq = lane >> 4;
        const float* ap = h1 + (size_t)(m0 + rt * 16 + row) * D + kh * 1024 + 4 * kq;
        const float* bp = Wrt + (size_t)(et * 16 + row) * D + kh * 1024 + 4 * kq;
        f32x4 acc = (f32x4){0.f, 0.f, 0.f, 0.f};
#pragma unroll 4
        for (int j = 0; j < 64; ++j) {
            const f32x4 a4 = *(const f32x4*)(ap + 16 * j), b4 = *(const f32x4*)(bp + 16 * j);
            acc = __builtin_amdgcn_mfma_f32_16x16x4f32(a4.x, b4.x, acc, 0, 0, 0);
            acc = __builtin_amdgcn_mfma_f32_16x16x4f32(a4.y, b4.y, acc, 0, 0, 0);
            acc = __builtin_amdgcn_mfma_f32_16x16x4f32(a4.z, b4.z, acc, 0, 0, 0);
            acc = __builtin_amdgcn_mfma_f32_16x16x4f32(a4.w, b4.w, acc, 0, 0, 0);
        }
#pragma unroll
        for (int t = 0; t < 4; ++t) part[(kh * 32 + rt * 16 + kq * 4 + t) * 32 + et * 16 + row] = acc[t];
    }
    __syncthreads();
#pragma unroll 1
    for (int r = 0; r < 4; ++r) {
        const int lr = c.wave * 4 + r, m = m0 + lr;
        float logit = -INFINITY;
        if (lane < NE) logit = (part[lr * 32 + lane] + part[(32 + lr) * 32 + lane]) * srstd[lr] + b_r[lane];
        float tv[4]; int ti4[4];
#pragma unroll
        for (int k = 0; k < 4; ++k) {
            const float mxv = wave_max(logit);
            const unsigned long long mask = __ballot(logit == mxv);
            const int idx = __ffsll((long long)mask) - 1;
            tv[k] = mxv; ti4[k] = idx;
            if (lane == idx) logit = -INFINITY;
        }
        float ex[4]; float es = 0.f;
#pragma unroll
        for (int k = 0; k < 4; ++k) { ex[k] = expf(tv[k] - tv[0]); es += ex[k]; }
        if (lane == 0) {
#pragma unroll
            for (int k = 0; k < 4; ++k) {
                const unsigned p = atomicAdd(&cnt[ti4[k]], 1u);
                rowtok[ti4[k] * M + p] = m; tok_e[m * 4 + k] = ti4[k]; tok_p[m * 4 + k] = (int)p; gate[m * 4 + k] = ex[k] / es;
            }
        }
    }
    __syncthreads();
}

__device__ __forceinline__ bool expert_of_row(const unsigned* cnt, int row0, int& e_out, int& local0, int& n_out, int& off_out) {
    int off = 0;
    for (int e = 0; e < NE; ++e) { const int n = (int)cnt[e], p = (n + 255) / 256 * 256; if (row0 < off + p) { e_out = e; local0 = row0 - off; n_out = n; off_out = off; return true; } off += p; }
    return false;
}
__device__ __forceinline__ void moe1_simple(const Ctx& cx, const bf16* __restrict__ xn, const bf16* __restrict__ Wgu, const float* __restrict__ b_gu, const unsigned* __restrict__ cnt,
                                            const int* __restrict__ rowtok, bf16* __restrict__ act) {
    const int r = cx.lane & 15, q = cx.lane >> 4;
    constexpr int nNt = DFF / 32;
    for (int wt = cx.gw; wt < (RP / 32) * nNt; wt += cx.NGW) {
        int e, lm0, n, off;
        if (!expert_of_row(cnt, (wt / nNt) * 32, e, lm0, n, off)) break;
        if (lm0 >= n) continue;
        const int c0 = (wt % nNt) * 32;
        const bf16* Wt = Wgu + (size_t)e * 4096 * D;
        const bf16* ap[2]; const bf16* bg[2];
#pragma unroll
        for (int i = 0; i < 2; ++i) { const int li = lm0 + i * 16 + r; const int tok = li < n ? rowtok[e * M + li] : rowtok[e * M]; ap[i] = xn + (size_t)tok * D + 8 * q; }
#pragma unroll
        for (int j = 0; j < 2; ++j) { const int c = c0 + j * 16 + r; const int ng = 256 * (c >> 7) + (c & 127); bg[j] = Wt + (size_t)ng * D + 8 * q; }
        f32x4 ag[2][2], al[2][2];
#pragma unroll
        for (int i = 0; i < 2; ++i)
#pragma unroll
            for (int j = 0; j < 2; ++j) { ag[i][j] = (f32x4){0.f, 0.f, 0.f, 0.f}; al[i][j] = (f32x4){0.f, 0.f, 0.f, 0.f}; }
#pragma unroll 2
        for (int k0 = 0; k0 < D; k0 += 32) {
            bf16x8 a[2], wg[2], wl[2];
#pragma unroll
            for (int i = 0; i < 2; ++i) { a[i] = *(const bf16x8*)(ap[i] + k0); wg[i] = *(const bf16x8*)(bg[i] + k0); wl[i] = *(const bf16x8*)(bg[i] + (size_t)128 * D + k0); }
#pragma unroll
            for (int i = 0; i < 2; ++i)
#pragma unroll
                for (int j = 0; j < 2; ++j) { ag[i][j] = __builtin_amdgcn_mfma_f32_16x16x32_bf16(a[i], wg[j], ag[i][j], 0, 0, 0); al[i][j] = __builtin_amdgcn_mfma_f32_16x16x32_bf16(a[i], wl[j], al[i][j], 0, 0, 0); }
        }
        const float* bias = b_gu + (size_t)e * 4096;
#pragma unroll
        for (int i = 0; i < 2; ++i)
#pragma unroll
            for (int j = 0; j < 2; ++j)
#pragma unroll
                for (int t = 0; t < 4; ++t) {
                    const int li = lm0 + i * 16 + q * 4 + t, c = c0 + j * 16 + r;
                    if (li < n) {
                        const float g = fminf(ag[i][j][t] + bias[c], 7.0f);
                        const float l = fminf(fmaxf(al[i][j][t] + bias[2048 + c], -7.0f), 7.0f);
                        const float a = (l + 1.0f) * (g / (1.0f + expf(-1.702f * g)));
                        act[(size_t)(off + li) * DFF + c] = f2bf(a);
                    }
                }
    }
}
__device__ __forceinline__ void moe2_simple(const Ctx& cx, const bf16* __restrict__ act, const bf16* __restrict__ Wd, const float* __restrict__ b_d, const unsigned* __restrict__ cnt, bf16* __restrict__ y) {
    const int r = cx.lane & 15, q = cx.lane >> 4;
    constexpr int nNt = D / 32;
    for (int wt = cx.gw; wt < (RP / 32) * nNt; wt += cx.NGW) {
        int e, lm0, n, off;
        if (!expert_of_row(cnt, (wt / nNt) * 32, e, lm0, n, off)) break;
        if (lm0 >= n) continue;
        const int n0 = (wt % nNt) * 32;
        const bf16* Wt = Wd + (size_t)e * D * DFF;
        const bf16* a0 = act + (size_t)(off + lm0 + r) * DFF + 8 * q; const bf16* b0 = Wt + (size_t)(n0 + r) * DFF + 8 * q;
        f32x4 acc[2][2];
#pragma unroll
        for (int i = 0; i < 2; ++i)
#pragma unroll
            for (int j = 0; j < 2; ++j) acc[i][j] = (f32x4){0.f, 0.f, 0.f, 0.f};
#pragma unroll 2
        for (int k0 = 0; k0 < DFF; k0 += 32) {
            bf16x8 a[2], b[2];
#pragma unroll
            for (int i = 0; i < 2; ++i) { a[i] = *(const bf16x8*)(a0 + (size_t)i * 16 * DFF + k0); b[i] = *(const bf16x8*)(b0 + (size_t)i * 16 * DFF + k0); }
#pragma unroll
            for (int i = 0; i < 2; ++i)
#pragma unroll
                for (int j = 0; j < 2; ++j) acc[i][j] = __builtin_amdgcn_mfma_f32_16x16x32_bf16(a[i], b[j], acc[i][j], 0, 0, 0);
        }
        const float* bias = b_d + (size_t)e * D;
#pragma unroll
        for (int i = 0; i < 2; ++i)
#pragma unroll
            for (int j = 0; j < 2; ++j)
#pragma unroll
                for (int t = 0; t < 4; ++t) { const int li = lm0 + i * 16 + q * 4 + t, c = n0 + j * 16 + r; if (li < n) y[(size_t)(off + li) * D + c] = f2bf(acc[i][j][t] + bias[c]); }
    }
}

__device__ __forceinline__ void combine_row(int m, int lane, const float* __restrict__ h1, const bf16* __restrict__ y, const unsigned* __restrict__ cnt, const int* __restrict__ tok_e, const int* __restrict__ tok_p,
                                            const float* __restrict__ gate, const float* __restrict__ g_final, float* __restrict__ out) {
    size_t yrow[4]; float gk[4];
#pragma unroll
    for (int k = 0; k < 4; ++k) {
        const int e = tok_e[m * 4 + k]; int off = 0;
        for (int e2 = 0; e2 < e; ++e2) off += ((int)cnt[e2] + 255) / 256 * 256;
        yrow[k] = (size_t)(off + tok_p[m * 4 + k]) * D; gk[k] = gate[m * 4 + k];
    }
    f32x4 v[8]; float ss = 0.f;
#pragma unroll
    for (int j = 0; j < 8; ++j) {
        const int idx = j * 256 + lane * 4;
        f32x4 a = *(const f32x4*)(h1 + (size_t)m * D + idx);
#pragma unroll
        for (int k = 0; k < 4; ++k) { const u32x2 w = *(const u32x2*)(y + yrow[k] + idx);
            a.x += gk[k] * __uint_as_float(w.x << 16); a.y += gk[k] * __uint_as_float(w.x & 0xffff0000u); a.z += gk[k] * __uint_as_float(w.y << 16); a.w += gk[k] * __uint_as_float(w.y & 0xffff0000u); }
        v[j] = a; ss += a.x * a.x + a.y * a.y + a.z * a.z + a.w * a.w;
    }
    const float rstd = rsqrtf(wave_sum(ss) * (1.f / D) + EPS);
#pragma unroll
    for (int j = 0; j < 8; ++j) { const int idx = j * 256 + lane * 4; const f32x4 gg = *(const f32x4*)(g_final + idx);
        *(f32x4*)(out + (size_t)m * D + idx) = (f32x4){v[j].x * rstd * gg.x, v[j].y * rstd * gg.y, v[j].z * rstd * gg.z, v[j].w * rstd * gg.w}; }
}


constexpr int TAB_OFF = MISC_OFF + 128;
__device__ __forceinline__ const LAS int* build_expert_table(const Ctx& c, const unsigned* cnt) {
    LAS int* tab = (LAS int*)(c.lds + TAB_OFF);
    if (c.tid < 64) {
        const int n = c.lane < NE ? (int)cnt[c.lane] : 0; int t = (n + 255) / 256, incl = t;
#pragma unroll
        for (int o = 1; o < 32; o <<= 1) { const int v = __shfl_up(incl, o); if (c.lane >= o) incl += v; }
        if (c.lane < NE) tab[c.lane + 1] = incl;
        if (c.lane == 0) tab[0] = 0;
    }
    __syncthreads();
    return tab;
}

struct Args { const float* in[20]; float* out; unsigned char* ws; int ph_lo, ph_hi; };
#define KA() ({ const __attribute__((address_space(4))) Args* _p = (const __attribute__((address_space(4))) Args*)__builtin_amdgcn_kernarg_segment_ptr(); asm volatile("" : "+s"(_p)); _p; })
#define WSP(T, off) ((T*)(ws + (off)))
#define PHASE_PTRS \
    const auto ka = KA(); unsigned char* const ws = ka->ws; unsigned* const cnt = (unsigned*)(ws + WS_CTL) + CW_CNT; (void)cnt; \
    bf16* const Win = WSP(bf16, WS_WIN); bf16* const Wq = WSP(bf16, WS_WQ); bf16* const Wkv = WSP(bf16, WS_WKV); bf16* const Wout = WSP(bf16, WS_WOUT); bf16* const Wgu = WSP(bf16, WS_WGU); bf16* const Wd = WSP(bf16, WS_WD); \
    bf16* const hn = WSP(bf16, WS_HN); bf16* const proj = WSP(bf16, WS_PROJ); bf16* const mixed = WSP(bf16, WS_MIXED); bf16* const qn = WSP(bf16, WS_QN); bf16* const kvn = WSP(bf16, WS_KVN); \
    bf16* const WkvK = WSP(bf16, WS_WKVK); bf16* const WkvV = WSP(bf16, WS_WKVV); float* const cosT = WSP(float, WS_COS); float* const sinT = WSP(float, WS_SIN); float* const Wrt = WSP(float, WS_WRT); (void)Wrt; bf16* const Q = WSP(bf16, WS_Q); \
    bf16* const Kn = WSP(bf16, WS_KN); bf16* const V = WSP(bf16, WS_V); bf16* const Kpe = WSP(bf16, WS_KPE); float* const h1 = WSP(float, WS_H1); bf16* const xn = WSP(bf16, WS_XN); \
    int* const tok_e = WSP(int, WS_TOKE); int* const tok_p = WSP(int, WS_TOKP); float* const gate = WSP(float, WS_GATE); int* const rowtok = WSP(int, WS_ROWTOK); bf16* const act = WSP(bf16, WS_ACT); bf16* const y = WSP(bf16, WS_Y); \
    (void)Win; (void)Wq; (void)Wkv; (void)Wout; (void)Wgu; (void)Wd; (void)hn; (void)proj; (void)mixed; (void)qn; (void)kvn; (void)WkvK; (void)WkvV; (void)cosT; (void)sinT; (void)Q; (void)Kn; (void)V; (void)Kpe; \
    (void)h1; (void)xn; (void)tok_e; (void)tok_p; (void)gate; (void)rowtok; (void)act; (void)y
#define INP(k) (ka->in[k])
__device__ __forceinline__ void phase0(const Ctx& c) { PHASE_PTRS;
        transpose_all<0>(c, INP(3), D, DIN, DINP, 1, Win);
        for (int i = c.gw * 64 + c.lane; i < (DINP - DIN) * D / 8; i += c.NGW * 64) ((u32x4*)(Win + (size_t)DIN * D))[i] = (u32x4){0u, 0u, 0u, 0u};
        transpose_all<2>(c, INP(6), QL, 1536, 1536, 1, Wq);
        transpose_all<0>(c, INP(8), KVL, 2048, 2048, 1, Wkv);
        transpose_all<3>(c, INP(8), KVL, 2048, 1024, 1, WkvK);
        transpose_all<4>(c, INP(8), KVL, 2048, 1024, 1, WkvV);
        for (int i = c.gw * 64 + c.lane; i < (S + NMETA) * 32; i += c.NGW * 64) { const float ang = (float)(i >> 5) * inv_freq(i & 31); cosT[i] = cosf(ang); sinT[i] = sinf(ang); }
        for (int i = c.gw * 64 + c.lane; i < NE * D; i += c.NGW * 64) { const int e = i >> 11, k = i & (D - 1); Wrt[i] = INP(12)[k] * INP(13)[k * NE + e]; }
        transpose_all<0>(c, INP(11), D, D, D, 1, Wout);
        transpose_all<1>(c, INP(15), D, 4096, 4096, NE, Wgu);
        transpose_all<0>(c, INP(17), DFF, D, D, NE, Wd);
        for (int R = c.gw; R < MR; R += c.NGW) norm1_row(R, c.lane, INP(0), INP(1), INP(2), hn);
    }
__device__ __forceinline__ void phase1(const Ctx& c) { PHASE_PTRS;
        pg8::Gemm g{hn, D}; pg8::PlainSched Sc; Sc.init(Win, M, DINP, D, c.G, c.wg);
        pg8::gemm_phase<pg8::EpiStoreBf16, pg8::PlainSched, true>(c.lds, g, Sc, pg8::EpiStoreBf16{proj, DINP});
        gemm_simple(c, hn + (size_t)M * D, D, Win, D, D, 1, DINP / 32, EpiProj{proj, M});
    }
__device__ __forceinline__ void phase2(const Ctx& c) { PHASE_PTRS; for (int R = c.gw; R < MR; R += c.NGW) postproj_row(R, c.lane, proj, INP(4), INP(9), INP(5), INP(7), mixed, qn, kvn, Kpe); }
__device__ __forceinline__ void phase3(const Ctx& c) { PHASE_PTRS;
        { pg8::Gemm g{qn, QL}; pg8::PlainSched Sc; Sc.init(Wq, M, 1536, QL, c.G, c.wg);
          pg8::gemm_phase<pg8::EpiQ, pg8::PlainSched, true>(c.lds, g, Sc, pg8::EpiQ{Q, cosT, sinT}); }
        { pg8::Gemm g{kvn, KVL}; pg8::PlainSched Sc; Sc.init(WkvK, M, 1024, KVL, c.G, c.wg);
          pg8::gemm_phase<pg8::EpiKn, pg8::PlainSched, true>(c.lds, g, Sc, pg8::EpiKn{Kn}); }
        { pg8::Gemm g{WkvV, KVL}; pg8::PlainSched Sc; Sc.init(kvn, 1024, M, KVL, c.G, (c.wg + c.G / 2) % c.G);
          pg8::gemm_phase<pg8::EpiVt, pg8::PlainSched, true>(c.lds, g, Sc, pg8::EpiVt{V}); }
        gemm_simple(c, kvn + (size_t)M * KVL, KVL, Wkv, KVL, KVL, 1, 2048 / 32, EpiKV{Kn, V, M});
    }
__device__ __forceinline__ void phase5(const Ctx& c) { PHASE_PTRS;
        for (int u = c.wg; u < NB * NH * 16; u += c.G) { const int bh = (u & 7) * 2 + ((u >> 3) >> 4), qb = (u >> 3) & 15;
            att::attn_unit(c.lds, bh >> 3, bh & 7, qb, Q, Kn, Kpe, V, INP(10), mixed); }
    }
__device__ __forceinline__ void phase6(const Ctx& c) { PHASE_PTRS;
        pg8::Gemm g{mixed, D}; pg8::PlainSched Sc; Sc.init(Wout, M, D, D, c.G, c.wg);
        pg8::gemm_phase<pg8::EpiResF32, pg8::PlainSched, true>(c.lds, g, Sc, pg8::EpiResF32{INP(0), h1, D});
    }
__device__ __forceinline__ void phase7(const Ctx& c) { PHASE_PTRS;
    for (int blk = c.wg; blk < M / 32; blk += c.G) router_block(c, blk, h1, INP(12), Wrt, INP(14), xn, cnt, rowtok, tok_e, tok_p, gate);
}
__device__ __forceinline__ void phase8(const Ctx& c) { PHASE_PTRS;
        const LAS int* tab = build_expert_table(c, cnt);
        pg8::Gemm g{xn, D}; pg8::MoeSched<true> Sc{Wgu, (size_t)4096 * D * 2, cnt, rowtok, tab, D, 16, c.G, c.wg};
        pg8::gemm_phase<pg8::EpiMoe1, pg8::MoeSched<true>, true>(c.lds, g, Sc, pg8::EpiMoe1{act, INP(16)});
    }
__device__ __forceinline__ void phase9(const Ctx& c) { PHASE_PTRS;
        const LAS int* tab = build_expert_table(c, cnt);
        pg8::Gemm g{act, DFF}; pg8::MoeSched<false> Sc{Wd, (size_t)D * DFF * 2, cnt, rowtok, tab, DFF, 8, c.G, c.wg};
        pg8::gemm_phase<pg8::EpiMoe2, pg8::MoeSched<false>, true>(c.lds, g, Sc, pg8::EpiMoe2{y, INP(18)});
    }
__device__ __forceinline__ void phase10(const Ctx& c) { PHASE_PTRS; for (int m = c.gw; m < M; m += c.NGW) combine_row(m, c.lane, h1, y, cnt, tok_e, tok_p, gate, INP(19), ka->out); }
#undef KA
#undef WSP
#undef PHASE_PTRS
#undef INP

constexpr int NPHASE = 10;
constexpr int REP_PHASE = -1, REP_N = 1;
__global__ void __launch_bounds__(NWAVES * 64, 2) mk_fwd(Args a) {
    extern __shared__ __attribute__((aligned(16))) unsigned char lds_raw[];
    Ctx c;
    c.lds = (LAS unsigned char*)lds_raw;
    c.tid = threadIdx.x; c.lane = c.tid & 63; c.wave = __builtin_amdgcn_readfirstlane(c.tid >> 6);
    c.G = gridDim.x; c.wg = blockIdx.x; c.gw = c.wg * NWAVES + c.wave; c.NGW = c.G * NWAVES;
    volatile LAS unsigned* MISC = (volatile LAS unsigned*)(c.lds + MISC_OFF);
    if (c.tid < 32) MISC[c.tid] = 0u;
    __syncthreads();
    XcdBarrier bar = xcd_barrier_post((unsigned*)(a.ws + WS_CTL) + CW_BAR, MISC + 8);
    const int lo = a.ph_lo, hi = a.ph_hi;
#define IN(k) (lo <= (k) && (k) < hi)
#define SEAM(k) do { if (IN(k) && IN((k) + 1)) xcd_barrier(bar); } while (0)
#define RUN(k) do { if (IN(k)) { phase##k(c); if constexpr (REP_PHASE == k) { for (int r_ = 1; r_ < REP_N; ++r_) phase##k(c); } } } while (0)
    RUN(0);
    SEAM(0);
    RUN(1);
    SEAM(1);
    RUN(2);
    SEAM(2);
    RUN(3);
    SEAM(3);
    RUN(5);
    SEAM(5);
    RUN(6);
    SEAM(6);
    RUN(7);
    SEAM(7);
    RUN(8);
    SEAM(8);
    RUN(9);
    SEAM(9);
    RUN(10);
#undef IN
#undef SEAM
#undef RUN
}

extern "C" void kernel_launch(void* const* d_in, const int* in_sizes, int n_in, void* d_out, int out_size, void* d_ws, size_t ws_size, hipStream_t stream) {
    static int grid = 0;
    if (grid == 0) {
        if (n_in != 20 || ws_size < WS_END) { fprintf(stderr, "kernel_launch: unexpected n_in %d / ws %zu (need %zu)\n", n_in, ws_size, (size_t)WS_END); grid = -1; return; }
        int dev = 0, cus = 0, per_cu = 0;
        if (hipGetDevice(&dev) != hipSuccess || hipDeviceGetAttribute(&cus, hipDeviceAttributeMultiprocessorCount, dev) != hipSuccess) { grid = -1; return; }
        if (hipFuncSetAttribute((const void*)mk_fwd, hipFuncAttributeMaxDynamicSharedMemorySize, LDS_BYTES) != hipSuccess) { fprintf(stderr, "kernel_launch: hipFuncSetAttribute failed\n"); grid = -1; return; }
        if (hipOccupancyMaxActiveBlocksPerMultiprocessor(&per_cu, (const void*)mk_fwd, NWAVES * 64, LDS_BYTES) != hipSuccess || per_cu < 1) { fprintf(stderr, "kernel_launch: occupancy query says %d\n", per_cu); (void)hipGetLastError(); grid = -1; return; }
        grid = cus;
    }
    if (grid < 0) return;
    if (hipMemsetAsync((char*)d_ws + WS_CTL, 0, CTL_BYTES, stream) != hipSuccess) return;
    Args a{};
    for (int i = 0; i < 20; ++i) a.in[i] = (const float*)d_in[i];
    a.out = (float*)d_out; a.ws = (unsigned char*)d_ws; a.ph_lo = 0; a.ph_hi = NPHASE + 1;
    hipLaunchKernelGGL(mk_fwd, dim3(grid), dim3(NWAVES * 64), LDS_BYTES, stream, a);
}
```

```cpp
#include <hip/hip_runtime.h>
#include <cstdint>
#include <cstdio>

typedef unsigned short bf16;
typedef short bf16x8 __attribute__((ext_vector_type(8)));
typedef float f32x4 __attribute__((ext_vector_type(4)));
typedef unsigned u32x4 __attribute__((ext_vector_type(4)));
typedef unsigned u32x2 __attribute__((ext_vector_type(2)));

constexpr int D = 2048, NB = 2, S = 4096, NMETA = 16, M = NB * S;
constexpr int MR = M + NMETA;
constexpr int MRP = 8256;
constexpr int DCONV = 1024, QL = 512, KVL = 256, ROPE = 64, NH = 8, DN = 128, DV = 128, DQK = 192;
constexpr int DIN = 3904, DINP = 4096;
constexpr int O_C = 1024, O_U = 2048, O_Q = 3072, O_KV = 3584, O_R = 3840;
constexpr int NE = 32, TOPK = 4, DFF = 2048;
constexpr int LP = 4224;
constexpr int RP = 41216;
constexpr float EPS = 1e-6f;
constexpr float WSCALE = 64.0f, WINV = 1.0f / 64.0f;

constexpr size_t MiB = 1u << 20;
constexpr size_t WS_CTL = 0, CTL_BYTES = 1 * MiB;
constexpr size_t WS_WIN = 2 * MiB;
constexpr size_t WS_WQ = WS_WIN + 16 * MiB;
constexpr size_t WS_WKV = WS_WQ + 2 * MiB;
constexpr size_t WS_WOUT = WS_WKV + 2 * MiB;
constexpr size_t WS_WGU = WS_WOUT + 8 * MiB;
constexpr size_t WS_WD = WS_WGU + 512 * MiB;
constexpr size_t WS_HN = WS_WD + 256 * MiB;
constexpr size_t WS_PROJ = WS_HN + 34 * MiB;
constexpr size_t WS_MIXED = WS_PROJ + 66 * MiB;
constexpr size_t WS_QN = WS_MIXED + 32 * MiB;
constexpr size_t WS_KVN = WS_QN + 8 * MiB;
constexpr size_t WS_QRAW = WS_KVN + 6 * MiB;
constexpr size_t WS_WKVK = WS_QRAW;
constexpr size_t WS_WKVV = WS_QRAW + 1 * MiB;
constexpr size_t WS_COS = WS_QRAW + 2 * MiB;
constexpr size_t WS_SIN = WS_QRAW + 3 * MiB;
constexpr size_t WS_WRT = WS_QRAW + 4 * MiB;
constexpr size_t WS_Q = WS_QRAW + 48 * MiB;
constexpr size_t WS_KN = WS_Q + 24 * MiB;
constexpr size_t WS_V = WS_KN + 18 * MiB;
constexpr size_t WS_KPE = WS_V + 18 * MiB;
constexpr size_t WS_H1 = WS_KPE + 2 * MiB;
constexpr size_t WS_XN = WS_H1 + 64 * MiB;
constexpr size_t WS_TOKE = WS_XN + 32 * MiB;
constexpr size_t WS_TOKP = WS_TOKE + 1 * MiB;
constexpr size_t WS_GATE = WS_TOKP + 1 * MiB;
constexpr size_t WS_ROWTOK = WS_GATE + 1 * MiB;
constexpr size_t WS_ACT = WS_ROWTOK + 1 * MiB;
constexpr size_t WS_Y = WS_ACT + 162 * MiB;
constexpr size_t WS_END = WS_Y + 162 * MiB;
constexpr int CW_CNT = 64;
constexpr int CW_PROG = 2048;
constexpr int CW_QDONE = 1408;
constexpr int CW_PDONE = 1344;
constexpr int CW_ADONE = 1280;
constexpr int CW_BAR = 4096;

__device__ __forceinline__ float bf2f(bf16 v) { return __uint_as_float((unsigned)v << 16); }
__device__ __forceinline__ bf16 f2bf(float f) { unsigned u = __float_as_uint(f); return (bf16)((u + 0x7fffu + ((u >> 16) & 1u)) >> 16); }
__device__ __forceinline__ float wave_sum(float v) {
#pragma unroll
    for (int o = 1; o < 64; o <<= 1) v += __shfl_xor(v, o);
    return v;
}
__device__ __forceinline__ float wave_max(float v) {
#pragma unroll
    for (int o = 1; o < 64; o <<= 1) v = fmaxf(v, __shfl_xor(v, o));
    return v;
}
__device__ __forceinline__ void unpack8(const u32x4 w, float (&f)[8]) {
    f[0] = __uint_as_float(w.x << 16); f[1] = __uint_as_float(w.x & 0xffff0000u);
    f[2] = __uint_as_float(w.y << 16); f[3] = __uint_as_float(w.y & 0xffff0000u);
    f[4] = __uint_as_float(w.z << 16); f[5] = __uint_as_float(w.z & 0xffff0000u);
    f[6] = __uint_as_float(w.w << 16); f[7] = __uint_as_float(w.w & 0xffff0000u);
}
__device__ __forceinline__ unsigned pk2(float lo, float hi) { return (unsigned)f2bf(lo) | ((unsigned)f2bf(hi) << 16); }


#define GAS __attribute__((address_space(1)))
#define LAS __attribute__((address_space(3)))
#define LDS_WAIT() asm volatile("s_waitcnt lgkmcnt(0)" ::: "memory")
#define VM_WAIT() asm volatile("s_waitcnt vmcnt(0)" ::: "memory")
constexpr int NWAVES = 8;
constexpr int LDS_BYTES = 147456;
constexpr int RING_BYTES = 131072, MISC_OFF = LDS_BYTES - 2048;

#define XB_TMO      128
#define XB_XCNT(j)  (256  + 64 * (j))
#define XB_XSUB(j)  (1280 + 64 * (j))
#define XB_XGEN(j)  (2304 + 64 * (j))
#define XB_TOP      3328
#define XB_TOPGEN   3392
#define XCD_BAR_WORDS 3456
#define XB_SPIN_CAP (1u << 18)

__device__ __forceinline__ unsigned xb_ld(unsigned* p)              { return __hip_atomic_load(p, __ATOMIC_RELAXED, __HIP_MEMORY_SCOPE_AGENT); }
__device__ __forceinline__ unsigned xb_add(unsigned* p, unsigned v) { return __hip_atomic_fetch_add(p, v, __ATOMIC_RELAXED, __HIP_MEMORY_SCOPE_AGENT); }
__device__ __forceinline__ unsigned xb_xcc_id() { return (unsigned)__builtin_amdgcn_s_getreg((3 << 11) | 20) & 0xFu; }
#define XB_SPIN(cond, bar) do { unsigned _sp = 0; while (cond) { __builtin_amdgcn_s_sleep(1); \
    if ((++_sp & 255u) == 0u) { if (xb_ld(&(bar)[XB_TMO])) break; if (_sp > XB_SPIN_CAP) { atomicAdd(&(bar)[XB_TMO], 1u); break; } } } } while (0)

struct XcdBarrier {
    unsigned* bar; unsigned x;
    volatile LAS unsigned* st;
};
__device__ __forceinline__ XcdBarrier xcd_barrier_post(unsigned* bar, volatile LAS unsigned* st) {
    XcdBarrier b; b.bar = bar; b.x = xb_xcc_id(); b.st = st;
    if (threadIdx.x == 0) (void)xb_add(&bar[XB_XCNT(b.x)], 1u);
    return b;
}
__device__ __forceinline__ void xcd_barrier_complete(unsigned* bar, unsigned x, unsigned& nloc, unsigned& nx) {
    const unsigned G = gridDim.x * gridDim.y * gridDim.z;
    unsigned sum, cnt, mine, sp = 0u;
    for (;;) {
        sum = 0u; cnt = 0u; mine = 0u;
#pragma unroll
        for (unsigned j = 0; j < 16; ++j) { const unsigned c = xb_ld(&bar[XB_XCNT(j)]); sum += c; cnt += (c > 0u) ? 1u : 0u; mine = (j == x) ? c : mine; }
        if (sum == G) break;
        __builtin_amdgcn_s_sleep(1);
        if ((++sp & 255u) == 0u) { if (xb_ld(&bar[XB_TMO])) break; if (sp > XB_SPIN_CAP) { atomicAdd(&bar[XB_TMO], 1u); break; } }
    }
    nloc = mine > 0u ? mine : 1u; nx = cnt > 0u ? cnt : 1u;
}
__device__ __forceinline__ void xcd_barrier(const XcdBarrier& b) {
    asm volatile("s_waitcnt vmcnt(0)" ::: "memory");
    __syncthreads();
    if (threadIdx.x == 0) {
        unsigned* bar = b.bar;
        __builtin_amdgcn_s_waitcnt(0);
        unsigned nloc = b.st[0], nx = b.st[1];
        if (nloc == 0u) { xcd_barrier_complete(bar, b.x, nloc, nx); b.st[0] = nloc; b.st[1] = nx; }
        const unsigned old = xb_add(&bar[XB_XSUB(b.x)], 1u);
        const unsigned gen = old / nloc;
        if (old + 1u == (gen + 1u) * nloc) {
            __builtin_amdgcn_fence(__ATOMIC_RELEASE, "agent");
            asm volatile("s_waitcnt vmcnt(0)" ::: "memory");
            const unsigned og = xb_add(&bar[XB_TOP], 1u);
            const unsigned tg = og / nx;
            if (og + 1u == (tg + 1u) * nx) xb_add(&bar[XB_TOPGEN], 1u);
            else XB_SPIN(xb_ld(&bar[XB_TOPGEN]) == tg, bar);
            __builtin_amdgcn_fence(__ATOMIC_ACQUIRE, "agent");
            xb_add(&bar[XB_XGEN(b.x)], 1u);
            asm volatile("s_waitcnt vmcnt(0)" ::: "memory");
        } else {
            XB_SPIN(xb_ld(&bar[XB_XGEN(b.x)]) == gen, bar);
            __builtin_amdgcn_fence(__ATOMIC_ACQUIRE, "agent");
            asm volatile("s_waitcnt vmcnt(0)" ::: "memory");
        }
    }
    __syncthreads();
}

namespace pg8 {
constexpr bool NT_MOE_WEIGHTS = true;
constexpr int BM = 256, BK = 64, HALF = 128, HTB = HALF * BK * 2  , STAGE_BYTES = 8 * HTB, NXCD = 8, WGM = 8;
__host__ __device__ __forceinline__ int lds_byte(int r, int c) { const int st = (r >> 4) * 2 + (c >> 5), rr = r & 15, cc = c & 31, ob = rr * 64 + cc * 2; return st * 1024 + (ob ^ (((ob >> 9) & 1) << 5)); }
__host__ __device__ __forceinline__ void stage_rc(int b, int& R, int& C) { const int st = b / 1024, sb = b % 1024, swz = sb ^ (((sb >> 9) & 1) << 5); R = (st >> 1) * 16 + swz / 64; C = (st & 1) * 32 + (swz % 64) / 2; }
__host__ __device__ __forceinline__ int perm32(int rho) { const int n = rho >> 4, i = rho & 15; return 8 * (i >> 2) + 4 * n + (i & 3); }

struct Unit { int pm, pn, e, nrows; };
struct Gemm { const void* A; int RB; };
typedef int v8i __attribute__((ext_vector_type(8)));
typedef int v4i __attribute__((ext_vector_type(4)));

__device__ __forceinline__ unsigned cvt_pk_bf16(float lo, float hi) { unsigned r; asm volatile("v_cvt_pk_bf16_f32 %0, %1, %2" : "=v"(r) : "v"(lo), "v"(hi)); return r; }

struct Frag16 { bf16x8 h[2]; };
template <bool FP8> struct FragT { typedef Frag16 T; };
template <> struct FragT<true> { typedef v8i T; };
__device__ __forceinline__ void frag_set(Frag16& f, int k, const bf16x8 v) { f.h[k] = v; }
__device__ __forceinline__ void frag_set(v8i& f, int k, const bf16x8 v) { const v4i w = __builtin_bit_cast(v4i, v); if (k == 0) { f[0] = w[0]; f[1] = w[1]; f[2] = w[2]; f[3] = w[3]; } else { f[4] = w[0]; f[5] = w[1]; f[6] = w[2]; f[7] = w[3]; } }
__device__ __forceinline__ f32x4 mma_fp8(const v8i& b, const v8i& a, const f32x4 c) { return __builtin_amdgcn_mfma_scale_f32_16x16x128_f8f6f4(b, a, c, 0, 0, 0, 0, 0, 0); }
__device__ __forceinline__ f32x4 mma_fp8(const Frag16&, const Frag16&, const f32x4 c) { return c; }
__device__ __forceinline__ f32x4 mma_bf16(const Frag16& b, const Frag16& a, int k, const f32x4 c) { return __builtin_amdgcn_mfma_f32_16x16x32_bf16(b.h[k], a.h[k], c, 0, 0, 0); }
__device__ __forceinline__ f32x4 mma_bf16(const v8i&, const v8i&, int, const f32x4 c) { return c; }
template <class Epi, class Sched, bool ALIGN_EPI, bool FP8 = false>
__device__ __forceinline__ void gemm_phase(LAS unsigned char* lds, const Gemm g, const Sched& S, const Epi& E) {
    int tid_ = threadIdx.x; asm volatile("" : "+v"(tid_));
    const int tid = tid_, wid = __builtin_amdgcn_readfirstlane(tid >> 6), lane = tid & 63, wr = wid >> 2, wc = wid & 3, fr = lane & 15, fq = lane >> 4;
    const int RB = g.RB, nt = RB / (BK * 2);
    int sR[2], sC[2]; unsigned voffB[2];
#pragma unroll
    for (int i = 0; i < 2; ++i) { stage_rc(tid * 16 + i * 8192, sR[i], sC[i]); const int Rb = Epi::PERM ? ((sR[i] & ~31) + perm32(sR[i] & 31)) : sR[i]; voffB[i] = (unsigned)(Rb * RB + sC[i] * 2); }
    const size_t kstep = (size_t)(BK * 2);
    const size_t hstep = (size_t)HALF * RB;
    const unsigned ldsw = (unsigned)wid * 1024u;
    const int aoff = lds_byte(wr * 64 + fr, fq * 8), boff = lds_byte(wc * 32 + fr, fq * 8);
    const char* Ab = (const char*)g.A;
#define PG8_SA(b, h) (((b) * 2 + (h)) * HTB)
#define PG8_SB(b, h) ((4 + (b) * 2 + (h)) * HTB)
#define PG8_STAGE(bufoff, gbase, voff) do { _Pragma("unroll") for (int _i = 0; _i < 2; ++_i) \
        __builtin_amdgcn_global_load_lds((const unsigned*)((const char*)(gbase) + (voff)[_i]), (LAS unsigned*)(lds + (bufoff) + ldsw + _i * 8192), 16, 0, 0); } while (0)
#define PG8_STAGEB(bufoff, gbase, voff) do { _Pragma("unroll") for (int _i = 0; _i < 2; ++_i) { \
        if constexpr (FP8 && NT_MOE_WEIGHTS) __builtin_amdgcn_global_load_lds((const unsigned*)((const char*)(gbase) + (voff)[_i]), (LAS unsigned*)(lds + (bufoff) + ldsw + _i * 8192), 16, 0, 2); \
        else __builtin_amdgcn_global_load_lds((const unsigned*)((const char*)(gbase) + (voff)[_i]), (LAS unsigned*)(lds + (bufoff) + ldsw + _i * 8192), 16, 0, 0); } } while (0)
#define PG8_LDA(dst, b, h) do { _Pragma("unroll") for (int m = 0; m < 4; ++m) _Pragma("unroll") for (int k = 0; k < 2; ++k) frag_set(dst[m], k, *(const LAS bf16x8*)(lds + PG8_SA(b, h) + aoff + m * 2048 + k * 1024)); } while (0)
#define PG8_LDB(dst, b, h) do { _Pragma("unroll") for (int n = 0; n < 2; ++n) _Pragma("unroll") for (int k = 0; k < 2; ++k) frag_set(dst[n], k, *(const LAS bf16x8*)(lds + PG8_SB(b, h) + boff + n * 2048 + k * 1024)); } while (0)
#define PG8_MMA(ai, bj, At, Bt) do { __builtin_amdgcn_s_setprio(1); if constexpr (FP8) { _Pragma("unroll") for (int m = 0; m < 4; ++m) _Pragma("unroll") for (int n = 0; n < 2; ++n) \
        acc[ai][bj][m][n] = mma_fp8(Bt[n], At[m], acc[ai][bj][m][n]); } \
    else { _Pragma("unroll") for (int m = 0; m < 4; ++m) _Pragma("unroll") for (int n = 0; n < 2; ++n) _Pragma("unroll") for (int k = 0; k < 2; ++k) \
        acc[ai][bj][m][n] = mma_bf16(Bt[n], At[m], k, acc[ai][bj][m][n]); } __builtin_amdgcn_s_setprio(0); } while (0)
#define PG8_WAIT_V(n) asm volatile("s_waitcnt vmcnt(" #n ")" ::: "memory")
#define PG8_WAIT_L(n) asm volatile("s_waitcnt lgkmcnt(" #n ")" ::: "memory")
#define PG8_BAR __builtin_amdgcn_s_barrier()
#define PG8_SCHED __builtin_amdgcn_sched_barrier(0)
    Unit cur, nxt; int ui = 0;
    if (!S.next(0, cur)) return;
    f32x4 acc[2][2][4][2];
#pragma unroll
    for (int a = 0; a < 2; ++a)
#pragma unroll
        for (int b = 0; b < 2; ++b)
#pragma unroll
            for (int m = 0; m < 4; ++m)
#pragma unroll
                for (int n = 0; n < 2; ++n) acc[a][b][m][n] = (f32x4){0.f, 0.f, 0.f, 0.f};
    typename FragT<FP8>::T At[4], B0[2], B1[2];
    unsigned ao[2][2];
    S.a_off(cur, sR, sC, ao);
    const char* cB = S.b_base(cur);
    PG8_STAGEB(PG8_SB(0, 0), cB, voffB); PG8_STAGEB(PG8_SB(0, 1), cB + hstep, voffB); PG8_STAGE(PG8_SA(0, 0), Ab, ao[0]); PG8_STAGE(PG8_SA(0, 1), Ab, ao[1]);
    if (wr == 1) PG8_BAR;
    PG8_WAIT_V(2); PG8_BAR;
    PG8_STAGEB(PG8_SB(1, 0), cB + kstep, voffB); PG8_STAGE(PG8_SA(1, 0), Ab + kstep, ao[0]); PG8_STAGEB(PG8_SB(1, 1), cB + hstep + kstep, voffB);
    PG8_WAIT_V(6); PG8_BAR;
    for (;;) {
        const bool has_next = S.next(ui + 1, nxt);
        const char* nB = has_next ? S.b_base(nxt) : cB;
#pragma unroll 1
        for (int t = 0; t < nt; t += 2) {
            const bool last = (t == nt - 2);
            const char* a1 = Ab + (size_t)(t + 1) * kstep;
            PG8_LDB(B0, 0, 0); PG8_LDB(B1, 0, 1); PG8_SCHED; PG8_LDA(At, 0, 0); PG8_STAGE(PG8_SA(1, 1), a1, ao[1]);
            PG8_WAIT_V(8); PG8_WAIT_L(0); PG8_BAR; PG8_MMA(0, 0, At, B0); PG8_MMA(0, 1, At, B1); PG8_BAR; PG8_SCHED;
            const char* a2 = last ? Ab : Ab + (size_t)(t + 2) * kstep; const char* b2 = last ? nB : cB + (size_t)(t + 2) * kstep;
            if (last && has_next) { int t2 = tid; asm volatile("" : "+v"(t2)); int R2[2], C2[2];
#pragma unroll
                for (int i = 0; i < 2; ++i) stage_rc(t2 * 16 + i * 8192, R2[i], C2[i]);
                S.a_off(nxt, R2, C2, ao); }
            const char* a3 = a2 + kstep; const char* b3 = b2 + kstep;
            PG8_LDA(At, 0, 1); PG8_STAGEB(PG8_SB(0, 0), b2, voffB); PG8_STAGEB(PG8_SB(0, 1), b2 + hstep, voffB); PG8_STAGE(PG8_SA(0, 0), a2, ao[0]);
            PG8_WAIT_V(8); PG8_WAIT_L(0); PG8_BAR; PG8_MMA(1, 0, At, B0); PG8_MMA(1, 1, At, B1); PG8_BAR; PG8_SCHED;
            PG8_LDB(B0, 1, 0); PG8_LDB(B1, 1, 1); PG8_SCHED; PG8_LDA(At, 1, 0); PG8_STAGE(PG8_SA(0, 1), a2, ao[1]);
            PG8_WAIT_V(8); PG8_WAIT_L(0); PG8_BAR; PG8_MMA(0, 0, At, B0); PG8_MMA(0, 1, At, B1); PG8_BAR; PG8_SCHED;
            PG8_LDA(At, 1, 1); PG8_STAGEB(PG8_SB(1, 0), b3, voffB); PG8_STAGEB(PG8_SB(1, 1), b3 + hstep, voffB); PG8_STAGE(PG8_SA(1, 0), a3, ao[0]);
            PG8_WAIT_V(8); PG8_WAIT_L(0); PG8_BAR; PG8_MMA(1, 0, At, B0); PG8_MMA(1, 1, At, B1); PG8_BAR; PG8_SCHED;
        }
        if constexpr (ALIGN_EPI) { if (wr == 0) PG8_BAR; }
        E(acc, cur, wr, wc, fr, fq);
        if (!has_next) break;
#pragma unroll
        for (int a = 0; a < 2; ++a)
#pragma unroll
            for (int b = 0; b < 2; ++b)
#pragma unroll
                for (int m = 0; m < 4; ++m)
#pragma unroll
                    for (int n = 0; n < 2; ++n) acc[a][b][m][n] = (f32x4){0.f, 0.f, 0.f, 0.f};
        cur = nxt; cB = nB; ++ui;
        if constexpr (ALIGN_EPI) { if (wr == 1) PG8_BAR; }
    }
    PG8_WAIT_V(0);
    if constexpr (!ALIGN_EPI) { if (wr == 0) PG8_BAR; }
    PG8_BAR;
#undef PG8_SA
#undef PG8_SB
#undef PG8_STAGE
#undef PG8_STAGEB
#undef PG8_LDA
#undef PG8_LDB
#undef PG8_MMA
#undef PG8_WAIT_V
#undef PG8_WAIT_L
#undef PG8_BAR
#undef PG8_SCHED
}

struct PlainSched {
    const bf16* Bt; int RB, nM, nN, nwg, G, c;
    __device__ void init(const bf16* Bt_, int M_, int N_, int K_, int G_, int c_) { Bt = Bt_; RB = K_ * 2; nM = M_ / BM; nN = N_ / BM; nwg = nM * nN; G = G_; c = c_; }
    __device__ __forceinline__ bool next(int i, Unit& u) const {
        const long L = (long)i * G + c; if (L >= nwg) return false;
        int wgid = (int)L; { const int q = nwg / NXCD, r = nwg % NXCD, xcd = wgid % NXCD, off = wgid / NXCD; wgid = (xcd < r ? xcd * (q + 1) : r * (q + 1) + (xcd - r) * q) + off; }
        const int nig = WGM * nN, gid = wgid / nig, fm = gid * WGM, gsz = (nM - fm) < WGM ? (nM - fm) : WGM;
        u.pm = fm + ((wgid % nig) % gsz); u.pn = (wgid % nig) / gsz; u.e = 0; u.nrows = BM; return true;
    }
    __device__ __forceinline__ void a_off(const Unit& u, const int (&R)[2], const int (&C)[2], unsigned (&off)[2][2]) const {
#pragma unroll
        for (int h = 0; h < 2; ++h)
#pragma unroll
            for (int i = 0; i < 2; ++i) off[h][i] = (unsigned)((u.pm * BM + h * HALF + R[i]) * RB + C[i] * 2);
    }
    __device__ __forceinline__ const char* b_base(const Unit& u) const { return (const char*)Bt + (size_t)u.pn * BM * RB; }
};

struct EpiStoreBf16 {
    static constexpr bool PERM = true;
    bf16* O; int ldc;
    __device__ __forceinline__ void operator()(const f32x4 (&acc)[2][2][4][2], const Unit& u, int wr, int wc, int fr, int fq) const {
        const int row0 = u.pm * BM + wr * 64 + fr, col0 = u.pn * BM + wc * 32 + 8 * fq;
#pragma unroll
        for (int ai = 0; ai < 2; ++ai)
#pragma unroll
            for (int m = 0; m < 4; ++m) { bf16* rowp = O + (size_t)(row0 + ai * HALF + m * 16) * ldc + col0;
#pragma unroll
                for (int bj = 0; bj < 2; ++bj) { const f32x4 v0 = acc[ai][bj][m][0], v1 = acc[ai][bj][m][1];
                    u32x4 w; w.x = cvt_pk_bf16(v0[0], v0[1]); w.y = cvt_pk_bf16(v0[2], v0[3]); w.z = cvt_pk_bf16(v1[0], v1[1]); w.w = cvt_pk_bf16(v1[2], v1[3]);
                    *(u32x4*)(rowp + bj * HALF) = w; } }
    }
};
struct EpiResF32 {
    static constexpr bool PERM = false;
    const float* base; float* out; int ldc;
    __device__ __forceinline__ void operator()(const f32x4 (&acc)[2][2][4][2], const Unit& u, int wr, int wc, int fr, int fq) const {
        const int row0 = u.pm * BM + wr * 64 + fr, col0 = u.pn * BM + wc * 32 + 4 * fq;
#pragma unroll
        for (int ai = 0; ai < 2; ++ai)
#pragma unroll
            for (int m = 0; m < 4; ++m) { const size_t off = (size_t)(row0 + ai * HALF + m * 16) * ldc + col0;
#pragma unroll
                for (int bj = 0; bj < 2; ++bj)
#pragma unroll
                    for (int n = 0; n < 2; ++n) { const f32x4 b = *(const f32x4*)(base + off + bj * HALF + n * 16); *(f32x4*)(out + off + bj * HALF + n * 16) = b + acc[ai][bj][m][n]; } }
    }
};
struct EpiQ {
    static constexpr bool PERM = true;
    bf16* Q; const float* cosT; const float* sinT;
    __device__ __forceinline__ void operator()(const f32x4 (&acc)[2][2][4][2], const Unit& u, int wr, int wc, int fr, int fq) const {
        const int row0 = u.pm * BM + wr * 64 + fr;
#pragma unroll
        for (int bj = 0; bj < 2; ++bj) {
            const int k64 = 4 * u.pn + 2 * bj + (wc >> 1), head = k64 / 3, type = k64 % 3, blk = wc & 1;
            if (type < 2) {
                const int dim = 64 * type + 32 * blk + 8 * fq;
#pragma unroll
                for (int ai = 0; ai < 2; ++ai)
#pragma unroll
                    for (int m = 0; m < 4; ++m) { const int r = row0 + ai * HALF + m * 16; const f32x4 v0 = acc[ai][bj][m][0], v1 = acc[ai][bj][m][1];
                        u32x4 w; w.x = cvt_pk_bf16(v0[0], v0[1]); w.y = cvt_pk_bf16(v0[2], v0[3]); w.z = cvt_pk_bf16(v1[0], v1[1]); w.w = cvt_pk_bf16(v1[2], v1[3]);
                        *(u32x4*)(Q + ((size_t)r * NH + head) * DQK + dim) = w; }
            } else {
                const int i0 = 16 * blk + 4 * fq;
#pragma unroll
                for (int ai = 0; ai < 2; ++ai)
#pragma unroll
                    for (int m = 0; m < 4; ++m) { const int r = row0 + ai * HALF + m * 16, pos = (r % S) + NMETA;
                        const f32x4 cs = *(const f32x4*)(cosT + pos * 32 + i0), sn = *(const f32x4*)(sinT + pos * 32 + i0);
                        const f32x4 x1 = acc[ai][bj][m][0], x2 = acc[ai][bj][m][1];
                        const f32x4 o1 = x1 * cs - x2 * sn, o2 = x1 * sn + x2 * cs;
                        bf16* dst = Q + ((size_t)r * NH + head) * DQK + 128 + i0;
                        u32x2 w1; w1.x = cvt_pk_bf16(o1[0], o1[1]); w1.y = cvt_pk_bf16(o1[2], o1[3]); *(u32x2*)(dst) = w1;
                        u32x2 w2; w2.x = cvt_pk_bf16(o2[0], o2[1]); w2.y = cvt_pk_bf16(o2[2], o2[3]); *(u32x2*)(dst + 32) = w2; }
            }
        }
    }
};
struct EpiKn {
    static constexpr bool PERM = true;
    bf16* kn;
    __device__ __forceinline__ void operator()(const f32x4 (&acc)[2][2][4][2], const Unit& u, int wr, int wc, int fr, int fq) const {
        const int row0 = u.pm * BM + wr * 64 + fr, col0 = u.pn * BM + wc * 32 + 8 * fq;
#pragma unroll
        for (int ai = 0; ai < 2; ++ai)
#pragma unroll
            for (int m = 0; m < 4; ++m) { const int r = row0 + ai * HALF + m * 16, b = r / S, pos = (r % S) + NMETA; bf16* rowp = kn + (size_t)(b * LP + pos) * (NH * 128) + col0;
#pragma unroll
                for (int bj = 0; bj < 2; ++bj) { const f32x4 v0 = acc[ai][bj][m][0], v1 = acc[ai][bj][m][1];
                    u32x4 w; w.x = cvt_pk_bf16(v0[0], v0[1]); w.y = cvt_pk_bf16(v0[2], v0[3]); w.z = cvt_pk_bf16(v1[0], v1[1]); w.w = cvt_pk_bf16(v1[2], v1[3]);
                    *(u32x4*)(rowp + bj * HALF) = w; } }
    }
};
struct EpiVt {
    static constexpr bool PERM = true;
    bf16* vt;
    __device__ __forceinline__ void operator()(const f32x4 (&acc)[2][2][4][2], const Unit& u, int wr, int wc, int fr, int fq) const {
        const int f0 = u.pm * BM + wr * 64 + fr, tk0 = u.pn * BM + wc * 32 + 8 * fq;
#pragma unroll
        for (int ai = 0; ai < 2; ++ai)
#pragma unroll
            for (int m = 0; m < 4; ++m) { const int f = f0 + ai * HALF + m * 16;
#pragma unroll
                for (int bj = 0; bj < 2; ++bj) { const int tk = tk0 + bj * HALF, b = tk / S, t = tk % S; const f32x4 v0 = acc[ai][bj][m][0], v1 = acc[ai][bj][m][1];
                    u32x4 w; w.x = cvt_pk_bf16(v0[0], v0[1]); w.y = cvt_pk_bf16(v0[2], v0[3]); w.z = cvt_pk_bf16(v1[0], v1[1]); w.w = cvt_pk_bf16(v1[2], v1[3]);
                    *(u32x4*)(vt + ((size_t)b * (NH * 128) + f) * LP + NMETA + t) = w; } }
    }
};
template <bool GATHER>
struct MoeSched {
    const void* W; size_t wbytes;
    const unsigned* cnt; const int* rowtok; const LAS int* tab;
    int RB, nN, G, c;
    __device__ __forceinline__ bool next(int i, Unit& u) const {
        const int total = tab[32] * nN; const int L = i * G + c; if (L >= total) return false;
        const int gt = L / nN; int e = 0;
#pragma unroll
        for (int j = 1; j < 32; ++j) e += (gt >= tab[j]) ? 1 : 0;
        e = __builtin_amdgcn_readfirstlane(e);
        u.pm = __builtin_amdgcn_readfirstlane(gt); u.pn = __builtin_amdgcn_readfirstlane(L % nN); u.e = e;
        u.nrows = __builtin_amdgcn_readfirstlane((int)cnt[e] - (gt - tab[e]) * BM);
        return true;
    }
    __device__ __forceinline__ void a_off(const Unit& u, const int (&R)[2], const int (&C)[2], unsigned (&off)[2][2]) const {
#pragma unroll
        for (int h = 0; h < 2; ++h)
#pragma unroll
            for (int i = 0; i < 2; ++i) {
                if (GATHER) { const int lt = (u.pm - tab[u.e]) * BM; int li = h * HALF + R[i]; li = li < u.nrows ? li : u.nrows - 1;
                    const int tok = rowtok[u.e * M + lt + li]; off[h][i] = (unsigned)(tok * RB + C[i] * 2); }
                else off[h][i] = (unsigned)((u.pm * BM + h * HALF + R[i]) * RB + C[i] * 2);
            }
    }
    __device__ __forceinline__ const char* b_base(const Unit& u) const { return (const char*)W + (size_t)u.e * wbytes + (size_t)u.pn * BM * RB; }
};
struct EpiMoe1 {
    static constexpr bool PERM = true;
    unsigned char* act; const float* b_gu;
    __device__ __forceinline__ void operator()(const f32x4 (&acc)[2][2][4][2], const Unit& u, int wr, int wc, int fr, int fq) const {
        const int row0 = u.pm * BM + wr * 64 + fr, cc = u.pn * HALF + wc * 32 + 8 * fq;
        const float* bias = b_gu + (size_t)u.e * 4096 + cc;
        const f32x4 bg0 = *(const f32x4*)(bias), bg1 = *(const f32x4*)(bias + 4), bl0 = *(const f32x4*)(bias + 2048), bl1 = *(const f32x4*)(bias + 2048 + 4);
#pragma unroll
        for (int ai = 0; ai < 2; ++ai)
#pragma unroll
            for (int m = 0; m < 4; ++m) {
                f32x4 o[2];
#pragma unroll
                for (int n = 0; n < 2; ++n) { const f32x4 gv = acc[ai][0][m][n] * WINV + (n ? bg1 : bg0), lv = acc[ai][1][m][n] * WINV + (n ? bl1 : bl0);
#pragma unroll
                    for (int j = 0; j < 4; ++j) { const float g = fminf(gv[j], 7.0f), l = fminf(fmaxf(lv[j], -7.0f), 7.0f);
                        o[n][j] = (l + 1.0f) * g * __builtin_amdgcn_rcpf(1.0f + __builtin_amdgcn_exp2f(-1.702f * 1.4426950408889634f * g)); } }
                int w0 = 0, w1 = 0;
                w0 = __builtin_amdgcn_cvt_pk_fp8_f32(o[0][0], o[0][1], w0, false); w0 = __builtin_amdgcn_cvt_pk_fp8_f32(o[0][2], o[0][3], w0, true);
                w1 = __builtin_amdgcn_cvt_pk_fp8_f32(o[1][0], o[1][1], w1, false); w1 = __builtin_amdgcn_cvt_pk_fp8_f32(o[1][2], o[1][3], w1, true);
                *(u32x2*)(act + (size_t)(row0 + ai * HALF + m * 16) * DFF + cc) = (u32x2){(unsigned)w0, (unsigned)w1};
            }
    }
};
struct EpiMoe2 {
    static constexpr bool PERM = true;
    bf16* y; const float* b_d;
    __device__ __forceinline__ void operator()(const f32x4 (&acc)[2][2][4][2], const Unit& u, int wr, int wc, int fr, int fq) const {
        const int row0 = u.pm * BM + wr * 64 + fr, col0 = u.pn * BM + wc * 32 + 8 * fq;
        const float* bias = b_d + (size_t)u.e * D + col0;
        f32x4 bv[2][2];
#pragma unroll
        for (int bj = 0; bj < 2; ++bj)
#pragma unroll
            for (int n = 0; n < 2; ++n) bv[bj][n] = *(const f32x4*)(bias + bj * HALF + 4 * n);
#pragma unroll
        for (int ai = 0; ai < 2; ++ai)
#pragma unroll
            for (int m = 0; m < 4; ++m) { bf16* rowp = y + (size_t)(row0 + ai * HALF + m * 16) * D + col0;
#pragma unroll
                for (int bj = 0; bj < 2; ++bj) { const f32x4 v0 = acc[ai][bj][m][0] * WINV + bv[bj][0], v1 = acc[ai][bj][m][1] * WINV + bv[bj][1];
                    u32x4 w; w.x = cvt_pk_bf16(v0[0], v0[1]); w.y = cvt_pk_bf16(v0[2], v0[3]); w.z = cvt_pk_bf16(v1[0], v1[1]); w.w = cvt_pk_bf16(v1[2], v1[3]);
                    *(u32x4*)(rowp + bj * HALF) = w; } }
    }
};
}

namespace att {
typedef float f32x16 __attribute__((ext_vector_type(16)));
typedef float f32x2 __attribute__((ext_vector_type(2)));
constexpr int KPITCH = 400, VPITCH = 144;
constexpr int KBYTES = 64 * KPITCH, VBYTES = 128 * VPITCH, STAGE = KBYTES + VBYTES;
constexpr int WSF_OFF = 2 * STAGE;
static_assert(WSF_OFF + 8 * 256 <= RING_BYTES, "attention LDS");
constexpr float SC = 0.07216878364870322f * 1.4426950408889634f;

__device__ __forceinline__ int crow(int r, int hi) { return (r & 3) + 8 * (r >> 2) + 4 * hi; }

__device__ __forceinline__ void attn_unit(LAS unsigned char* lds, int b, int h, int qb, int ta, int tb, const bf16* __restrict__ Q, const bf16* __restrict__ Kn, const bf16* __restrict__ Kpe,
                                          const bf16* __restrict__ Vt, const float* __restrict__ g_attn, bf16* __restrict__ mixed) {
    const int tid = threadIdx.x, lane = tid & 63, r32 = lane & 31, hi = lane >> 5, wid = __builtin_amdgcn_readfirstlane(tid >> 6);
    const int t0 = qb * 256 + wid * 32;
    const int m0 = b * S + t0;
    const int wave_max_pos = t0 + 31 + NMETA, wave_min_pos = t0 + NMETA;
    LAS float* wsf = (LAS float*)(lds + WSF_OFF) + wid * 64;
    unsigned koff[3], kdst[3], kstr[3];
#pragma unroll
    for (int i = 0; i < 3; ++i) { const int id = tid + 512 * i, key = id / 24, c = id % 24;
        koff[i] = c < 16 ? (unsigned)((((b * LP + key) * NH + h) * 128 + c * 8) * 2) : (unsigned)(WS_KPE - WS_KN) + (unsigned)(((b * LP + key) * ROPE + (c - 16) * 8) * 2);
        kstr[i] = c < 16 ? 64u * NH * 128 * 2 : 64u * ROPE * 2;
        const int row = (key & ~12) | ((key & 4) << 1) | ((key & 8) >> 1);
        kdst[i] = (unsigned)(row * KPITCH + c * 16); }
    unsigned voff[2], vdst[2];
#pragma unroll
    for (int i = 0; i < 2; ++i) { const int id = tid + 512 * i, d = id >> 3, kc = id & 7;
        voff[i] = (unsigned)((((b * NH + h) * 128 + d) * LP + kc * 8) * 2); vdst[i] = (unsigned)(KBYTES + d * VPITCH + kc * 16); }
    const char* const Knb = (const char*)Kn; const char* const Vtb = (const char*)Vt;
    bf16x8 qf[12];
    { const bf16* qp = Q + ((size_t)(m0 + r32) * NH + h) * DQK + 8 * hi;
#pragma unroll
      for (int ks = 0; ks < 12; ++ks) qf[ks] = *(const bf16x8*)(qp + ks * 16); }
    f32x16 o[4];
#pragma unroll
    for (int d = 0; d < 4; ++d)
#pragma unroll
        for (int r = 0; r < 16; ++r) o[d][r] = 0.f;
    float mrow = -1.0e30f, lsum = 0.f;
    u32x4 kreg[3], vreg[2];
#pragma unroll
    for (int i = 0; i < 3; ++i) kreg[i] = *(const u32x4*)(Knb + (koff[i] + (unsigned)ta * kstr[i]));
#pragma unroll
    for (int i = 0; i < 2; ++i) vreg[i] = *(const u32x4*)(Vtb + (voff[i] + (unsigned)ta * 128u));
#pragma unroll
    for (int i = 0; i < 3; ++i) *(LAS u32x4*)(lds + kdst[i]) = kreg[i];
#pragma unroll
    for (int i = 0; i < 2; ++i) *(LAS u32x4*)(lds + vdst[i]) = vreg[i];
    __syncthreads();
    for (int t = ta; t < tb; ++t) {
        const bool more = t + 1 < tb; const int st = (t - ta) & 1;
        if (more) {
#pragma unroll
            for (int i = 0; i < 3; ++i) kreg[i] = *(const u32x4*)(Knb + (koff[i] + (unsigned)(t + 1) * kstr[i]));
#pragma unroll
            for (int i = 0; i < 2; ++i) vreg[i] = *(const u32x4*)(Vtb + (voff[i] + (unsigned)(t + 1) * 128u));
        }
        const int kb = t * 64;
        if (kb <= wave_max_pos) {
            const LAS unsigned char* Kb = lds + st * STAGE; const LAS unsigned char* Vb = Kb + KBYTES;
            f32x16 p0, p1;
#pragma unroll
            for (int r = 0; r < 16; ++r) { p0[r] = 0.f; p1[r] = 0.f; }
            const LAS unsigned char* kp = Kb + r32 * KPITCH + hi * 16;
#pragma unroll
            for (int ks = 0; ks < 12; ++ks) {
                const bf16x8 k0 = *(const LAS bf16x8*)(kp + ks * 32), k1 = *(const LAS bf16x8*)(kp + 32 * KPITCH + ks * 32);
                p0 = __builtin_amdgcn_mfma_f32_32x32x16_bf16(k0, qf[ks], p0, 0, 0, 0);
                p1 = __builtin_amdgcn_mfma_f32_32x32x16_bf16(k1, qf[ks], p1, 0, 0, 0);
            }
            if (kb + 63 > wave_min_pos) {
                const int qpos = t0 + r32 + NMETA, kbase = kb + 8 * hi;
#pragma unroll
                for (int r = 0; r < 16; ++r) { const int key = kbase + 16 * (r >> 3) + (r & 7); if (key > qpos) p0[r] = -INFINITY; if (key + 32 > qpos) p1[r] = -INFINITY; }
            }
            float mx = fmaxf(p0[0], p1[0]);
#pragma unroll
            for (int r = 1; r < 16; ++r) mx = fmaxf(mx, fmaxf(p0[r], p1[r]));
            mx = fmaxf(mx, __shfl_xor(mx, 32));
            const float mnew = fmaxf(mrow, mx);
            const bool grew = __any(mnew > mrow);
            if (grew) {
                const float corr = __builtin_amdgcn_exp2f((mrow - mnew) * SC);
                lsum *= corr; mrow = mnew;
                if (hi == 0) wsf[r32] = corr;
                asm volatile("s_waitcnt lgkmcnt(0)" ::: "memory");
#pragma unroll
                for (int g = 0; g < 4; ++g) { const f32x4 f = *(const LAS f32x4*)(wsf + 8 * g + 4 * hi);
#pragma unroll
                    for (int d = 0; d < 4; ++d) { o[d][4 * g + 0] *= f.x; o[d][4 * g + 1] *= f.y; o[d][4 * g + 2] *= f.z; o[d][4 * g + 3] *= f.w; } }
            }
            const float nm = -mrow * SC;
            float ps = 0.f;
#pragma unroll
            for (int r = 0; r < 16; ++r) { p0[r] = __builtin_amdgcn_exp2f(__builtin_fmaf(p0[r], SC, nm)); p1[r] = __builtin_amdgcn_exp2f(__builtin_fmaf(p1[r], SC, nm)); ps += p0[r] + p1[r]; }
            lsum += ps;
            u32x4 pa[4];
            pa[0] = (u32x4){pg8::cvt_pk_bf16(p0[0], p0[1]), pg8::cvt_pk_bf16(p0[2], p0[3]), pg8::cvt_pk_bf16(p0[4], p0[5]), pg8::cvt_pk_bf16(p0[6], p0[7])};
            pa[1] = (u32x4){pg8::cvt_pk_bf16(p0[8], p0[9]), pg8::cvt_pk_bf16(p0[10], p0[11]), pg8::cvt_pk_bf16(p0[12], p0[13]), pg8::cvt_pk_bf16(p0[14], p0[15])};
            pa[2] = (u32x4){pg8::cvt_pk_bf16(p1[0], p1[1]), pg8::cvt_pk_bf16(p1[2], p1[3]), pg8::cvt_pk_bf16(p1[4], p1[5]), pg8::cvt_pk_bf16(p1[6], p1[7])};
            pa[3] = (u32x4){pg8::cvt_pk_bf16(p1[8], p1[9]), pg8::cvt_pk_bf16(p1[10], p1[11]), pg8::cvt_pk_bf16(p1[12], p1[13]), pg8::cvt_pk_bf16(p1[14], p1[15])};
            const LAS unsigned char* vp = Vb + r32 * VPITCH + hi * 16;
#pragma unroll
            for (int d = 0; d < 4; ++d)
#pragma unroll
                for (int s = 0; s < 4; ++s) { const bf16x8 vf = *(const LAS bf16x8*)(vp + d * 32 * VPITCH + s * 32);
                    o[d] = __builtin_amdgcn_mfma_f32_32x32x16_bf16(__builtin_bit_cast(bf16x8, pa[s]), vf, o[d], 0, 0, 0); }
        }
        if (more) {
            LAS unsigned char* nb = lds + (st ^ 1) * STAGE;
#pragma unroll
            for (int i = 0; i < 3; ++i) *(LAS u32x4*)(nb + kdst[i]) = kreg[i];
#pragma unroll
            for (int i = 0; i < 2; ++i) *(LAS u32x4*)(nb + vdst[i]) = vreg[i];
        }
        __syncthreads();
    }
    lsum += __shfl_xor(lsum, 32);
    {
        if (hi == 0) wsf[r32] = 1.0f / lsum;
        asm volatile("s_waitcnt lgkmcnt(0)" ::: "memory");
        float ss[16];
#pragma unroll
        for (int g = 0; g < 4; ++g) { const f32x4 f = *(const LAS f32x4*)(wsf + 8 * g + 4 * hi);
#pragma unroll
            for (int j = 0; j < 4; ++j) { const float il = j == 0 ? f.x : j == 1 ? f.y : j == 2 ? f.z : f.w; float a = 0.f;
#pragma unroll
                for (int d = 0; d < 4; ++d) { o[d][4 * g + j] *= il; a += o[d][4 * g + j] * o[d][4 * g + j]; }
                ss[4 * g + j] = a; } }
#pragma unroll
        for (int r = 0; r < 16; ++r) {
#pragma unroll
            for (int of = 1; of < 32; of <<= 1) ss[r] += __shfl_xor(ss[r], of);
            ss[r] = rsqrtf(ss[r] * (1.f / 128.f) + EPS);
        }
        float gv[4];
#pragma unroll
        for (int d = 0; d < 4; ++d) gv[d] = g_attn[h * DV + d * 32 + r32];
#pragma unroll
        for (int r = 0; r < 16; ++r) { bf16* dst = mixed + (size_t)(m0 + crow(r, hi)) * D + DCONV + h * DV + r32;
#pragma unroll
            for (int d = 0; d < 4; ++d) dst[d * 32] = f2bf(o[d][r] * ss[r] * gv[d]); }
    }
    __syncthreads();
}
}

struct Ctx { int lane, wave, tid, gw, NGW, wg, G; LAS unsigned char* lds; };

template <int MODE> __device__ __forceinline__ int drow_of(int n) {
    if (MODE == 1) { const int bj = n / 2048, c = n % 2048; return 256 * (c / 128) + 128 * bj + (c % 128); }
    if (MODE == 2) { const int k64 = n >> 6, w = n & 63; if (k64 % 3 != 2) return n; const int part = w >> 5, i = w & 31; return (k64 << 6) + 32 * (i >> 4) + 8 * ((i & 15) >> 2) + 4 * part + (i & 3); }
    if (MODE == 3) { return (n & 128) ? -1 : (n >> 8) * 128 + (n & 127); }
    if (MODE == 4) { return (n & 128) ? (n >> 8) * 128 + (n & 127) : -1; }
    return n;
}
__device__ __forceinline__ void transpose_load(const float* W, int K, int N, int item, int lane, f32x4 (&v)[8]) {
    const int nblk = N / 32, kb = item / nblk, nb = item % nblk, k0 = 64 * kb, n0 = 32 * nb;
#pragma unroll
    for (int i = 0; i < 8; ++i) v[i] = __builtin_nontemporal_load((const f32x4*)(W + (size_t)(k0 + i * 8 + (lane >> 3)) * N + n0 + (lane & 7) * 4));
}
template <int MODE, bool FP8OUT>
__device__ __forceinline__ void transpose_store(const f32x4 (&v)[8], int K, int N, void* WTv, LAS float* scr, int item, int lane) {
    const int nblk = N / 32, kb = item / nblk, nb = item % nblk, k0 = 64 * kb, n0 = 32 * nb;
#pragma unroll
    for (int i = 0; i < 8; ++i) { LAS float* d = scr + (i * 8 + (lane >> 3)) * 33 + (lane & 7) * 4; d[0] = v[i].x; d[1] = v[i].y; d[2] = v[i].z; d[3] = v[i].w; }
    LDS_WAIT(); asm volatile("" ::: "memory");
    const int c = lane & 7;
#pragma unroll
    for (int j = 0; j < 4; ++j) { const int n = (lane >> 3) + 8 * j; const LAS float* s = scr + (8 * c) * 33 + n;
        const int dr = drow_of<MODE>(n0 + n);
        if (FP8OUT) {
            int w0 = 0, w1 = 0;
            w0 = __builtin_amdgcn_cvt_pk_fp8_f32(s[0 * 33] * WSCALE, s[1 * 33] * WSCALE, w0, false); w0 = __builtin_amdgcn_cvt_pk_fp8_f32(s[2 * 33] * WSCALE, s[3 * 33] * WSCALE, w0, true);
            w1 = __builtin_amdgcn_cvt_pk_fp8_f32(s[4 * 33] * WSCALE, s[5 * 33] * WSCALE, w1, false); w1 = __builtin_amdgcn_cvt_pk_fp8_f32(s[6 * 33] * WSCALE, s[7 * 33] * WSCALE, w1, true);
            if (dr >= 0) *(u32x2*)((unsigned char*)WTv + (size_t)dr * K + k0 + 8 * c) = (u32x2){(unsigned)w0, (unsigned)w1};
        } else {
            u32x4 o; o.x = pg8::cvt_pk_bf16(s[0 * 33], s[1 * 33]); o.y = pg8::cvt_pk_bf16(s[2 * 33], s[3 * 33]); o.z = pg8::cvt_pk_bf16(s[4 * 33], s[5 * 33]); o.w = pg8::cvt_pk_bf16(s[6 * 33], s[7 * 33]);
            if (dr >= 0) *(u32x4*)((bf16*)WTv + (size_t)dr * K + k0 + 8 * c) = o;
        } }
    LDS_WAIT(); asm volatile("" ::: "memory");
}
template <int MODE, bool FP8OUT>
__device__ __forceinline__ void transpose_item(const Ctx& c, const float* W, int K, int N, void* WT, int item) {
    LAS float* scr = (LAS float*)(c.lds + c.wave * 16384);
    f32x4 v[8]; transpose_load(W, K, N, item, c.lane, v);
    transpose_store<MODE, FP8OUT>(v, K, N, WT, scr, item, c.lane);
}
__device__ __forceinline__ void transpose_item_kv(const Ctx& c, const float* W, bf16* Wkv, bf16* WkvK, bf16* WkvV, int item) {
    LAS float* scr = (LAS float*)(c.lds + c.wave * 16384);
    f32x4 v[8]; transpose_load(W, KVL, 2048, item, c.lane, v);
    transpose_store<0, false>(v, KVL, 2048, Wkv, scr, item, c.lane);
    transpose_store<3, false>(v, KVL, 2048, WkvK, scr, item, c.lane);
    transpose_store<4, false>(v, KVL, 2048, WkvV, scr, item, c.lane);
}

constexpr int CONV_SCR = 128 * 33 * 4;
__device__ __forceinline__ void t128_load(const float* W, int N, int item, int lane, f32x4 (&v)[16]) {
    const int nblk = N / 32, kb = item / nblk, nb = item % nblk, k0 = 128 * kb, n0 = 32 * nb;
#pragma unroll
    for (int i = 0; i < 16; ++i) v[i] = __builtin_nontemporal_load((const f32x4*)(W + (size_t)(k0 + i * 8 + (lane >> 3)) * N + n0 + (lane & 7) * 4));
}
template <int MODE>
__device__ __forceinline__ void t128_store(const Ctx& c, const f32x4 (&v)[16], int K, int N, unsigned char* WT, int item) {
    LAS float* scr = (LAS float*)(c.lds + c.wave * CONV_SCR);
    const int nblk = N / 32, kb = item / nblk, nb = item % nblk, k0 = 128 * kb, n0 = 32 * nb, lane = c.lane;
#pragma unroll
    for (int i = 0; i < 16; ++i) { LAS float* d = scr + (i * 8 + (lane >> 3)) * 33 + (lane & 7) * 4; d[0] = v[i].x; d[1] = v[i].y; d[2] = v[i].z; d[3] = v[i].w; }
    LDS_WAIT(); asm volatile("" ::: "memory");
    const int cc = lane & 7;
#pragma unroll
    for (int j = 0; j < 4; ++j) { const int n = (lane >> 3) + 8 * j; const LAS float* s = scr + (16 * cc) * 33 + n; int w[4];
#pragma unroll
        for (int q = 0; q < 4; ++q) { int t = 0; t = __builtin_amdgcn_cvt_pk_fp8_f32(s[(4 * q) * 33] * WSCALE, s[(4 * q + 1) * 33] * WSCALE, t, false);
            t = __builtin_amdgcn_cvt_pk_fp8_f32(s[(4 * q + 2) * 33] * WSCALE, s[(4 * q + 3) * 33] * WSCALE, t, true); w[q] = t; }
        const int dr = drow_of<MODE>(n0 + n);
        __builtin_nontemporal_store((u32x4){(unsigned)w[0], (unsigned)w[1], (unsigned)w[2], (unsigned)w[3]}, (u32x4*)(WT + (size_t)dr * K + k0 + 16 * cc)); }
    LDS_WAIT(); asm volatile("" ::: "memory");
}
static_assert(8 * CONV_SCR <= MISC_OFF, "conversion tiles vs LDS control words");

constexpr int I_GU = NE * (D / 128) * (4096 / 32), I_D = NE * (DFF / 128) * (D / 32);
constexpr int CONV_TOTAL = I_D + I_GU, CONV_SLOTS = 1024;
constexpr int STOPW_OFF = MISC_OFF + 1536;
constexpr unsigned STOP_AT = 96u;
__device__ __forceinline__ unsigned stop_poll(const Ctx& c, const unsigned* p) {
    volatile LAS unsigned* w = (volatile LAS unsigned*)(c.lds + STOPW_OFF);
    if (c.wave == 0) { const unsigned v = __hip_atomic_load(p, __ATOMIC_RELAXED, __HIP_MEMORY_SCOPE_AGENT); if (c.lane == 0) *w = v; return (unsigned)__builtin_amdgcn_readfirstlane((int)v); }
    return *w;
}
__device__ __forceinline__ void cs_load(int it, int lane, const float* w_gu, const float* w_d, f32x4 (&v)[16]) {
    if (it < I_D) { constexpr int per = (DFF / 128) * (D / 32); t128_load(w_d + (size_t)(it / per) * DFF * D, D, it % per, lane, v); }
    else { const int r = it - I_D; constexpr int per = (D / 128) * (4096 / 32); t128_load(w_gu + (size_t)(r / per) * D * 4096, 4096, r % per, lane, v); }
}
__device__ __forceinline__ void cs_store(const Ctx& c, int it, const f32x4 (&v)[16], unsigned char* Wgu, unsigned char* Wd) {
    if (it < I_D) { constexpr int per = (DFF / 128) * (D / 32); t128_store<0>(c, v, DFF, D, Wd + (size_t)(it / per) * D * DFF, it % per); }
    else { const int r = it - I_D; constexpr int per = (D / 128) * (4096 / 32); t128_store<1>(c, v, D, 4096, Wgu + (size_t)(r / per) * 4096 * D, r % per); }
}
__device__ __forceinline__ int conv_stream(const Ctx& c, int j, int first, int step, const unsigned* stop, const float* w_gu, const float* w_d, unsigned char* Wgu, unsigned char* Wd) {
    int i = first;
    if (j + CONV_SLOTS * i >= CONV_TOTAL) return i;
    if (stop && stop_poll(c, stop) >= STOP_AT) return i;
    f32x4 va[16], vb[16];
    cs_load(j + CONV_SLOTS * i, c.lane, w_gu, w_d, va);
    for (;;) {
        { const int i2 = i + step; const bool more = j + CONV_SLOTS * i2 < CONV_TOTAL && !(stop && stop_poll(c, stop) >= STOP_AT);
          cs_load(j + CONV_SLOTS * (more ? i2 : i), c.lane, w_gu, w_d, vb);
          cs_store(c, j + CONV_SLOTS * i, va, Wgu, Wd); i = i2; if (!more) break; }
        { const int i2 = i + step; const bool more = j + CONV_SLOTS * i2 < CONV_TOTAL && !(stop && stop_poll(c, stop) >= STOP_AT);
          cs_load(j + CONV_SLOTS * (more ? i2 : i), c.lane, w_gu, w_d, va);
          cs_store(c, j + CONV_SLOTS * i, vb, Wgu, Wd); i = i2; if (!more) break; }
    }
    return i;
}

__device__ __forceinline__ void norm1_rows2(int R0, int lane, const float* x, const float* meta, const float* g, bf16* hn) {
    f32x4 v[2][8]; float ss[2] = {0.f, 0.f};
#pragma unroll
    for (int q = 0; q < 2; ++q) { const int R = R0 + q; const float* src = R < M ? x + (size_t)R * D : meta + (size_t)(R - M) * D;
#pragma unroll
        for (int j = 0; j < 8; ++j) v[q][j] = __builtin_nontemporal_load((const f32x4*)(src + j * 256 + lane * 4)); }
#pragma unroll
    for (int q = 0; q < 2; ++q)
#pragma unroll
        for (int j = 0; j < 8; ++j) ss[q] += v[q][j].x * v[q][j].x + v[q][j].y * v[q][j].y + v[q][j].z * v[q][j].z + v[q][j].w * v[q][j].w;
#pragma unroll
    for (int q = 0; q < 2; ++q) { const float rstd = rsqrtf(wave_sum(ss[q]) * (1.f / D) + EPS);
#pragma unroll
        for (int j = 0; j < 8; ++j) { const f32x4 gg = *(const f32x4*)(g + j * 256 + lane * 4);
            u32x2 o; o.x = pk2(v[q][j].x * rstd * gg.x, v[q][j].y * rstd * gg.y); o.y = pk2(v[q][j].z * rstd * gg.z, v[q][j].w * rstd * gg.w);
            *(u32x2*)(hn + (size_t)(R0 + q) * D + j * 256 + lane * 4) = o; } }
}
constexpr int META_WGS = DIN / 64;
__device__ __forceinline__ void meta_proj(const Ctx& c, const float* __restrict__ meta, const float* __restrict__ g_mix, const float* __restrict__ w_in, bf16* __restrict__ proj) {
    LAS float* hmT = (LAS float*)c.lds;
    {
        f32x4 v[2][8];
#pragma unroll
        for (int q = 0; q < 2; ++q)
#pragma unroll
            for (int j = 0; j < 8; ++j) v[q][j] = *(const f32x4*)(meta + (size_t)(c.wave + 8 * q) * D + j * 256 + c.lane * 4);
#pragma unroll
        for (int q = 0; q < 2; ++q) { const int r = c.wave + 8 * q; float ss = 0.f;
#pragma unroll
            for (int j = 0; j < 8; ++j) ss += v[q][j].x * v[q][j].x + v[q][j].y * v[q][j].y + v[q][j].z * v[q][j].z + v[q][j].w * v[q][j].w;
            const float rstd = rsqrtf(wave_sum(ss) * (1.f / D) + EPS);
#pragma unroll
            for (int j = 0; j < 8; ++j) { const int k = j * 256 + c.lane * 4; const f32x4 gg = *(const f32x4*)(g_mix + k);
                hmT[(k + 0) * 16 + r] = v[q][j].x * rstd * gg.x; hmT[(k + 1) * 16 + r] = v[q][j].y * rstd * gg.y; hmT[(k + 2) * 16 + r] = v[q][j].z * rstd * gg.z; hmT[(k + 3) * 16 + r] = v[q][j].w * rstd * gg.w; } }
    }
    const int col = c.lane, ks = c.wave, n = c.wg * 64 + col;
    float acc[16];
#pragma unroll
    for (int r = 0; r < 16; ++r) acc[r] = 0.f;
    __syncthreads();
#pragma unroll 1
    for (int kb = 0; kb < 4; ++kb) {
        float w[64];
#pragma unroll
        for (int j = 0; j < 64; ++j) w[j] = __builtin_nontemporal_load(w_in + (size_t)(ks * 256 + kb * 64 + j) * DIN + n);
#pragma unroll
        for (int j = 0; j < 64; ++j) { const int k = ks * 256 + kb * 64 + j;
#pragma unroll
            for (int q = 0; q < 4; ++q) { const f32x4 h = *(const LAS f32x4*)(hmT + k * 16 + 4 * q);
                acc[4 * q + 0] += h.x * w[j]; acc[4 * q + 1] += h.y * w[j]; acc[4 * q + 2] += h.z * w[j]; acc[4 * q + 3] += h.w * w[j]; } }
    }
    __syncthreads();
    LAS float* part = (LAS float*)c.lds;
#pragma unroll
    for (int r = 0; r < 16; ++r) part[(ks * 16 + r) * 64 + col] = acc[r];
    __syncthreads();
    for (int o = c.tid; o < 16 * 64; o += NWAVES * 64) { const int r = o >> 6, cc = o & 63; float s = 0.f;
#pragma unroll
        for (int q = 0; q < 8; ++q) s += part[(q * 16 + r) * 64 + cc];
        proj[(size_t)(M + r) * DINP + c.wg * 64 + cc] = f2bf(s); }
    __syncthreads();
}

struct EpiKV {
    bf16* kn; bf16* vv; int roff;
    __device__ void operator()(int r, int n, float v) const {
        const int R = r + roff; if (R < M || R >= MR) return;
        const int h = n >> 8, part = (n >> 7) & 1, d = n & 127, pos = R - M; const bf16 o = f2bf(v);
        for (int b = 0; b < NB; ++b) {
            if (part) vv[((size_t)(b * NH + h) * 128 + d) * LP + pos] = o;
            else kn[((size_t)(b * LP + pos) * NH + h) * 128 + d] = o;
        }
    }
};
template <class Epi>
__device__ __forceinline__ void gemm_simple(const Ctx& c, const bf16* __restrict__ A, int lda, const bf16* __restrict__ Bt, int ldb, int K, int nMt, int nNt, const Epi& epi) {
    const int r = c.lane & 15, q = c.lane >> 4;
    for (int wt = c.gw; wt < nMt * nNt; wt += c.NGW) {
        const int m0 = (wt / nNt) * 32, n0 = (wt % nNt) * 32;
        f32x4 acc[2][2];
#pragma unroll
        for (int i = 0; i < 2; ++i)
#pragma unroll
            for (int j = 0; j < 2; ++j) acc[i][j] = (f32x4){0.f, 0.f, 0.f, 0.f};
        const bf16* a0 = A + (size_t)(m0 + r) * lda + 8 * q; const bf16* b0 = Bt + (size_t)(n0 + r) * ldb + 8 * q;
#pragma unroll 2
        for (int k0 = 0; k0 < K; k0 += 32) {
            bf16x8 a[2], b[2];
#pragma unroll
            for (int i = 0; i < 2; ++i) { a[i] = *(const bf16x8*)(a0 + (size_t)i * 16 * lda + k0); b[i] = *(const bf16x8*)(b0 + (size_t)i * 16 * ldb + k0); }
#pragma unroll
            for (int i = 0; i < 2; ++i)
#pragma unroll
                for (int j = 0; j < 2; ++j) acc[i][j] = __builtin_amdgcn_mfma_f32_16x16x32_bf16(a[i], b[j], acc[i][j], 0, 0, 0);
        }
#pragma unroll
        for (int i = 0; i < 2; ++i)
#pragma unroll
            for (int j = 0; j < 2; ++j)
#pragma unroll
                for (int t = 0; t < 4; ++t) epi(m0 + i * 16 + q * 4 + t, n0 + j * 16 + r, acc[i][j][t]);
    }
}

__device__ __forceinline__ float inv_freq(int i) { return powf(10000.0f, -(float)i / 32.0f); }

__device__ __forceinline__ void postproj_row(int R, int lane, const bf16* __restrict__ proj, const float* __restrict__ conv_w, const float* __restrict__ g_conv,
                                             const float* __restrict__ g_q, const float* __restrict__ g_kv,
                                             bf16* __restrict__ mixed, bf16* __restrict__ qn, bf16* __restrict__ kvn, bf16* __restrict__ kpe, const float* __restrict__ cosT, const float* __restrict__ sinT) {
    const bf16* pr = proj + (size_t)R * DINP;
    const bool meta = R >= M; const int b = meta ? 0 : R / S, t = meta ? 0 : R % S, pos = meta ? R - M : t + NMETA;
    {
        const u32x2 w = *(const u32x2*)(pr + O_KV + lane * 4);
        float f[4] = {__uint_as_float(w.x << 16), __uint_as_float(w.x & 0xffff0000u), __uint_as_float(w.y << 16), __uint_as_float(w.y & 0xffff0000u)};
        const float ss = wave_sum(f[0] * f[0] + f[1] * f[1] + f[2] * f[2] + f[3] * f[3]);
        const float rstd = rsqrtf(ss * (1.f / KVL) + EPS);
        const f32x4 g = *(const f32x4*)(g_kv + lane * 4);
        u32x2 o; o.x = pk2(f[0] * rstd * g.x, f[1] * rstd * g.y); o.y = pk2(f[2] * rstd * g.z, f[3] * rstd * g.w);
        *(u32x2*)(kvn + (size_t)R * KVL + lane * 4) = o;
    }
    if (lane < 32) {
        const float x1 = bf2f(pr[O_R + lane]), x2 = bf2f(pr[O_R + 32 + lane]);
        const float cs = cosT[pos * 32 + lane], sn = sinT[pos * 32 + lane];
        const bf16 o1 = f2bf(x1 * cs - x2 * sn), o2 = f2bf(x1 * sn + x2 * cs);
        if (!meta) { bf16* d = kpe + (size_t)(b * LP + pos) * ROPE; d[lane] = o1; d[32 + lane] = o2; }
        else { bf16* d0 = kpe + (size_t)(0 * LP + pos) * ROPE; bf16* d1 = kpe + (size_t)(1 * LP + pos) * ROPE; d0[lane] = o1; d0[32 + lane] = o2; d1[lane] = o1; d1[32 + lane] = o2; }
    }
    if (meta) return;
    {
        float f[8]; unpack8(*(const u32x4*)(pr + O_Q + lane * 8), f);
        float ss = 0.f;
#pragma unroll
        for (int i = 0; i < 8; ++i) ss += f[i] * f[i];
        const float rstd = rsqrtf(wave_sum(ss) * (1.f / QL) + EPS);
        const f32x4 g0 = *(const f32x4*)(g_q + lane * 8), g1 = *(const f32x4*)(g_q + lane * 8 + 4);
        u32x4 o; o.x = pk2(f[0] * rstd * g0.x, f[1] * rstd * g0.y); o.y = pk2(f[2] * rstd * g0.z, f[3] * rstd * g0.w);
        o.z = pk2(f[4] * rstd * g1.x, f[5] * rstd * g1.y); o.w = pk2(f[6] * rstd * g1.z, f[7] * rstd * g1.w);
        *(u32x4*)(qn + (size_t)R * QL + lane * 8) = o;
    }
    {
        const int r1 = (t >= 1) ? R - 1 : M + 15, r2 = (t >= 2) ? R - 2 : (t == 1 ? M + 15 : M + 14);
        const bf16* p1 = proj + (size_t)r1 * DINP; const bf16* p2 = proj + (size_t)r2 * DINP;
        const int c0 = lane * 16;
        float v[16]; float ss = 0.f;
#pragma unroll
        for (int hh = 0; hh < 2; ++hh) {
            const int c = c0 + hh * 8;
            float bg[8], cg0[8], ui0[8], cg1[8], ui1[8], cg2[8], ui2[8];
            unpack8(*(const u32x4*)(pr + c), bg); unpack8(*(const u32x4*)(pr + O_C + c), cg0); unpack8(*(const u32x4*)(pr + O_U + c), ui0);
            unpack8(*(const u32x4*)(p1 + O_C + c), cg1); unpack8(*(const u32x4*)(p1 + O_U + c), ui1);
            unpack8(*(const u32x4*)(p2 + O_C + c), cg2); unpack8(*(const u32x4*)(p2 + O_U + c), ui2);
#pragma unroll
            for (int i = 0; i < 8; ++i) {
                const float y = conv_w[2 * DCONV + c + i] * (cg0[i] * ui0[i]) + conv_w[1 * DCONV + c + i] * (cg1[i] * ui1[i]) + conv_w[0 * DCONV + c + i] * (cg2[i] * ui2[i]);
                const float o = bg[i] * y; v[hh * 8 + i] = o; ss += o * o;
            }
        }
        ss += __shfl_xor(ss, 1); ss += __shfl_xor(ss, 2);
        const float rstd = rsqrtf(ss * (1.f / 64.f) + EPS);
#pragma unroll
        for (int hh = 0; hh < 2; ++hh) {
            const int c = c0 + hh * 8;
            const f32x4 g0 = *(const f32x4*)(g_conv + c), g1 = *(const f32x4*)(g_conv + c + 4);
            u32x4 o; o.x = pk2(v[hh * 8 + 0] * rstd * g0.x, v[hh * 8 + 1] * rstd * g0.y); o.y = pk2(v[hh * 8 + 2] * rstd * g0.z, v[hh * 8 + 3] * rstd * g0.w);
            o.z = pk2(v[hh * 8 + 4] * rstd * g1.x, v[hh * 8 + 5] * rstd * g1.y); o.w = pk2(v[hh * 8 + 6] * rstd * g1.z, v[hh * 8 + 7] * rstd * g1.w);
            *(u32x4*)(mixed + (size_t)R * D + c) = o;
        }
    }
}

constexpr int RT_OFF = 0;
__device__ __forceinline__ void router_block(const Ctx& c, int blk, const float* __restrict__ h1, const float* __restrict__ g_ffn, const float* __restrict__ Wrt, const float* __restrict__ b_r,
                                             bf16* __restrict__ xn, unsigned* __restrict__ cnt, int* __restrict__ rowtok, int* __restrict__ tok_e, int* __restrict__ tok_p, float* __restrict__ gate) {
    LAS float* part = (LAS float*)(c.lds + RT_OFF); LAS float* srstd = part + 2 * 32 * 32;
    const int lane = c.lane, m0 = blk * 32;
#pragma unroll 1
    for (int r = 0; r < 4; ++r) {
        const int m = m0 + c.wave * 4 + r; const float* src = h1 + (size_t)m * D;
        f32x4 v[8]; float ss = 0.f;
#pragma unroll
        for (int j = 0; j < 8; ++j) { v[j] = *(const f32x4*)(src + j * 256 + lane * 4); ss += v[j].x * v[j].x + v[j].y * v[j].y + v[j].z * v[j].z + v[j].w * v[j].w; }
        const float rstd = rsqrtf(wave_sum(ss) * (1.f / D) + EPS);
#pragma unroll
        for (int j = 0; j < 8; ++j) { const f32x4 gg = *(const f32x4*)(g_ffn + j * 256 + lane * 4);
            int w = 0; w = __builtin_amdgcn_cvt_pk_fp8_f32(v[j].x * rstd * gg.x, v[j].y * rstd * gg.y, w, false); w = __builtin_amdgcn_cvt_pk_fp8_f32(v[j].z * rstd * gg.z, v[j].w * rstd * gg.w, w, true);
            *(int*)((unsigned char*)xn + (size_t)m * D + j * 256 + lane * 4) = w; }
        if (lane == 0) srstd[c.wave * 4 + r] = rstd;
    }
    {
        const int ti = c.wave & 3, rt = ti >> 1, et = ti & 1, kh = c.wave >> 2, row = lane & 15, kq = lane >> 4;
        const float* ap = h1 + (size_t)(m0 + rt * 16 + row) * D + kh * 1024 + 4 * kq;
        const float* bp = Wrt + (size_t)(et * 16 + row) * D + kh * 1024 + 4 * kq;
        f32x4 acc = (f32x4){0.f, 0.f, 0.f, 0.f};
#pragma unroll 4
        for (int j = 0; j < 64; ++j) {
            const f32x4 a4 = *(const f32x4*)(ap + 16 * j), b4 = *(const f32x4*)(bp + 16 * j);
            acc = __builtin_amdgcn_mfma_f32_16x16x4f32(a4.x, b4.x, acc, 0, 0, 0);
            acc = __builtin_amdgcn_mfma_f32_16x16x4f32(a4.y, b4.y, acc, 0, 0, 0);
            acc = __builtin_amdgcn_mfma_f32_16x16x4f32(a4.z, b4.z, acc, 0, 0, 0);
            acc = __builtin_amdgcn_mfma_f32_16x16x4f32(a4.w, b4.w, acc, 0, 0, 0);
        }
#pragma unroll
        for (int t = 0; t < 4; ++t) part[(kh * 32 + rt * 16 + kq * 4 + t) * 32 + et * 16 + row] = acc[t];
    }
    __syncthreads();
    LAS unsigned* lhist = (LAS unsigned*)(srstd + 32); LAS unsigned* lbase = lhist + 32;
    if (c.tid < 32) lhist[c.tid] = 0u;
    __syncthreads();
    int se[4][4]; unsigned sr[4][4]; float sg[4][4];
#pragma unroll
    for (int r = 0; r < 4; ++r) {
        const int lr = c.wave * 4 + r;
        float logit = -INFINITY;
        if (lane < NE) logit = (part[lr * 32 + lane] + part[(32 + lr) * 32 + lane]) * srstd[lr] + b_r[lane];
        float tv[4];
#pragma unroll
        for (int k = 0; k < 4; ++k) {
            const float mxv = wave_max(logit);
            const unsigned long long mask = __ballot(logit == mxv);
            const int idx = __ffsll((long long)mask) - 1;
            tv[k] = mxv; se[r][k] = idx;
            if (lane == idx) logit = -INFINITY;
        }
        float es = 0.f;
#pragma unroll
        for (int k = 0; k < 4; ++k) { sg[r][k] = expf(tv[k] - tv[0]); es += sg[r][k]; }
        const float inv = 1.0f / es;
#pragma unroll
        for (int k = 0; k < 4; ++k) { sg[r][k] *= inv; sr[r][k] = 0u; if (lane == 0) sr[r][k] = __hip_atomic_fetch_add(&lhist[se[r][k]], 1u, __ATOMIC_RELAXED, __HIP_MEMORY_SCOPE_WORKGROUP); }
    }
    __syncthreads();
    if (c.tid < NE) lbase[c.tid] = atomicAdd(&cnt[c.tid], lhist[c.tid]);
    __syncthreads();
    if (lane == 0) {
#pragma unroll
        for (int r = 0; r < 4; ++r) { const int m = m0 + c.wave * 4 + r;
#pragma unroll
            for (int k = 0; k < 4; ++k) { const int e = se[r][k]; const unsigned p = lbase[e] + sr[r][k];
                rowtok[e * M + p] = m; tok_e[m * 4 + k] = e; tok_p[m * 4 + k] = (int)p; gate[m * 4 + k] = sg[r][k]; } }
    }
    __syncthreads();
}

__device__ __forceinline__ void combine_row(int m, int lane, const float* __restrict__ h1, const bf16* __restrict__ y, const unsigned* __restrict__ cnt, const int* __restrict__ tok_e, const int* __restrict__ tok_p,
                                            const float* __restrict__ gate, const float* __restrict__ g_final, float* __restrict__ out) {
    size_t yrow[4]; float gk[4];
#pragma unroll
    for (int k = 0; k < 4; ++k) {
        const int e = tok_e[m * 4 + k]; int off = 0;
        for (int e2 = 0; e2 < e; ++e2) off += ((int)cnt[e2] + 255) / 256 * 256;
        yrow[k] = (size_t)(off + tok_p[m * 4 + k]) * D; gk[k] = gate[m * 4 + k];
    }
    f32x4 v[8]; float ss = 0.f;
#pragma unroll
    for (int j = 0; j < 8; ++j) {
        const int idx = j * 256 + lane * 4;
        f32x4 a = *(const f32x4*)(h1 + (size_t)m * D + idx);
#pragma unroll
        for (int k = 0; k < 4; ++k) { const u32x2 w = *(const u32x2*)(y + yrow[k] + idx);
            a.x += gk[k] * __uint_as_float(w.x << 16); a.y += gk[k] * __uint_as_float(w.x & 0xffff0000u); a.z += gk[k] * __uint_as_float(w.y << 16); a.w += gk[k] * __uint_as_float(w.y & 0xffff0000u); }
        v[j] = a; ss += a.x * a.x + a.y * a.y + a.z * a.z + a.w * a.w;
    }
    const float rstd = rsqrtf(wave_sum(ss) * (1.f / D) + EPS);
#pragma unroll
    for (int j = 0; j < 8; ++j) { const int idx = j * 256 + lane * 4; const f32x4 gg = *(const f32x4*)(g_final + idx);
        *(f32x4*)(out + (size_t)m * D + idx) = (f32x4){v[j].x * rstd * gg.x, v[j].y * rstd * gg.y, v[j].z * rstd * gg.z, v[j].w * rstd * gg.w}; }
}


constexpr int TAB_OFF = MISC_OFF + 128;
__device__ __forceinline__ const LAS int* build_expert_table(const Ctx& c, const unsigned* cnt) {
    LAS int* tab = (LAS int*)(c.lds + TAB_OFF);
    if (c.tid < 64) {
        const int n = c.lane < NE ? (int)cnt[c.lane] : 0; int t = (n + 255) / 256, incl = t;
#pragma unroll
        for (int o = 1; o < 32; o <<= 1) { const int v = __shfl_up(incl, o); if (c.lane >= o) incl += v; }
        if (c.lane < NE) tab[c.lane + 1] = incl;
        if (c.lane == 0) tab[0] = 0;
    }
    __syncthreads();
    return tab;
}

__device__ __forceinline__ Ctx make_ctx() {
    extern __shared__ __attribute__((aligned(16))) unsigned char lds_raw[];
    Ctx c; int t = threadIdx.x; asm volatile("" : "+v"(t));
    c.lds = (LAS unsigned char*)lds_raw; c.tid = t; c.lane = t & 63; c.wave = __builtin_amdgcn_readfirstlane(t >> 6);
    c.G = gridDim.x; c.wg = blockIdx.x; c.gw = c.wg * NWAVES + c.wave; c.NGW = c.G * NWAVES;
    return c;
}
constexpr bool SPLIT_P1 = true, SPLIT_P3 = true;
struct Args { const float* in[20]; float* out; unsigned char* ws; int ph_lo, ph_hi; };
#define KA() ({ const __attribute__((address_space(4))) Args* _p = (const __attribute__((address_space(4))) Args*)__builtin_amdgcn_kernarg_segment_ptr(); asm volatile("" : "+s"(_p)); _p; })
#define WSP(T, off) ((T*)(ws + (off)))
#define PHASE_PTRS \
    const auto ka = KA(); unsigned char* const ws = ka->ws; unsigned* const cnt = (unsigned*)(ws + WS_CTL) + CW_CNT; (void)cnt; \
    bf16* const Win = WSP(bf16, WS_WIN); bf16* const Wq = WSP(bf16, WS_WQ); bf16* const Wkv = WSP(bf16, WS_WKV); bf16* const Wout = WSP(bf16, WS_WOUT); bf16* const Wgu = WSP(bf16, WS_WGU); bf16* const Wd = WSP(bf16, WS_WD); \
    bf16* const hn = WSP(bf16, WS_HN); bf16* const proj = WSP(bf16, WS_PROJ); bf16* const mixed = WSP(bf16, WS_MIXED); bf16* const qn = WSP(bf16, WS_QN); bf16* const kvn = WSP(bf16, WS_KVN); \
    bf16* const WkvK = WSP(bf16, WS_WKVK); bf16* const WkvV = WSP(bf16, WS_WKVV); float* const cosT = WSP(float, WS_COS); float* const sinT = WSP(float, WS_SIN); float* const Wrt = WSP(float, WS_WRT); (void)Wrt; bf16* const Q = WSP(bf16, WS_Q); \
    bf16* const Kn = WSP(bf16, WS_KN); bf16* const V = WSP(bf16, WS_V); bf16* const Kpe = WSP(bf16, WS_KPE); float* const h1 = WSP(float, WS_H1); bf16* const xn = WSP(bf16, WS_XN); \
    int* const tok_e = WSP(int, WS_TOKE); int* const tok_p = WSP(int, WS_TOKP); float* const gate = WSP(float, WS_GATE); int* const rowtok = WSP(int, WS_ROWTOK); bf16* const act = WSP(bf16, WS_ACT); bf16* const y = WSP(bf16, WS_Y); \
    (void)Win; (void)Wq; (void)Wkv; (void)Wout; (void)Wgu; (void)Wd; (void)hn; (void)proj; (void)mixed; (void)qn; (void)kvn; (void)WkvK; (void)WkvV; (void)cosT; (void)sinT; (void)Q; (void)Kn; (void)V; (void)Kpe; \
    (void)h1; (void)xn; (void)tok_e; (void)tok_p; (void)gate; (void)rowtok; (void)act; (void)y
#define INP(k) (ka->in[k])
__device__ __forceinline__ void phase0() { const Ctx c = make_ctx(); PHASE_PTRS;
        const bool splitp0 = c.G >= 2 * META_WGS;
        if (c.wg < META_WGS || !splitp0) { for (int j = c.wg; j < META_WGS; j += (splitp0 ? META_WGS : c.G)) { Ctx cj = c; cj.wg = j; meta_proj(cj, INP(1), INP(2), INP(3), proj); } if (splitp0) return; }
        const int lgw = splitp0 ? c.gw - META_WGS * NWAVES : c.gw, lngw = splitp0 ? c.NGW - META_WGS * NWAVES : c.NGW;
        constexpr int I_IN = (D / 64) * (DIN / 32), I_OUT = (D / 64) * (D / 32), I_Q = (QL / 64) * (1536 / 32), I_KV = (KVL / 64) * (2048 / 32);
        constexpr int I_ROWS = MR / 2, I_ZERO = (DINP - DIN) * D / 8 / 64, I_ROPE = (S + NMETA) * 32 / 64, I_WRT = NE * D / 64;
        constexpr int E1 = 0, E2 = E1 + I_IN, E3 = E2 + I_OUT, E4 = E3 + I_Q, E5 = E4 + I_KV, E6 = E5 + I_ROWS, E7 = E6 + I_ZERO, E8 = E7 + I_ROPE, E9 = E8 + I_WRT;
        for (int it = lgw; it < E9; it += lngw) {
            if (false) {}
            else if (it < E2) transpose_item<0, false>(c, INP(3), D, DIN, Win, it - E1);
            else if (it < E3) transpose_item<0, false>(c, INP(11), D, D, Wout, it - E2);
            else if (it < E4) transpose_item<2, false>(c, INP(6), QL, 1536, Wq, it - E3);
            else if (it < E5) transpose_item_kv(c, INP(8), Wkv, WkvK, WkvV, it - E4);
            else if (it < E6) { const int R = 2 * (it - E5); norm1_rows2(R, c.lane, INP(0), INP(1), INP(2), hn); }
            else if (it < E7) { const int i = (it - E6) * 64 + c.lane; ((u32x4*)(Win + (size_t)DIN * D))[i] = (u32x4){0u, 0u, 0u, 0u}; }
            else if (it < E8) { const int i = (it - E7) * 64 + c.lane; const float ang = (float)(i >> 5) * inv_freq(i & 31); cosT[i] = cosf(ang); sinT[i] = sinf(ang); }
            else { const int i = (it - E8) * 64 + c.lane; const int e = i >> 11, k = i & (D - 1); Wrt[i] = INP(12)[k] * INP(13)[k * NE + e]; }
        }
    }
__device__ __forceinline__ void phase1() { const Ctx c = make_ctx(); PHASE_PTRS;
        unsigned* ctl = (unsigned*)(ws + WS_CTL);
        if (c.G != 256 || !SPLIT_P1) {
            pg8::Gemm g{hn, D * 2}; pg8::PlainSched Sc; Sc.init(Win, M, DINP, D, c.G, c.wg);
            pg8::gemm_phase<pg8::EpiStoreBf16, pg8::PlainSched, true>(c.lds, g, Sc, pg8::EpiStoreBf16{proj, DINP});
        } else if ((c.wg >> 3) < 16) {
            pg8::Gemm g{hn, D * 2}; pg8::PlainSched Sc; Sc.init(Win, M, DINP, D, 128, (c.wg >> 3) * 8 + (c.wg & 7));
            pg8::gemm_phase<pg8::EpiStoreBf16, pg8::PlainSched, true>(c.lds, g, Sc, pg8::EpiStoreBf16{proj, DINP});
            const Ctx c3 = make_ctx(); if (c3.tid == 0) __hip_atomic_fetch_add(ctl + CW_PDONE, 1u, __ATOMIC_RELAXED, __HIP_MEMORY_SCOPE_AGENT);
        } else {
            const int j = (((c.wg >> 3) - 16) * 8 + (c.wg & 7)) * NWAVES + c.wave;
            const int n = conv_stream(c, j, 0, 1, ctl + CW_PDONE, INP(15), INP(17), (unsigned char*)Wgu, (unsigned char*)Wd);
            if (c.lane == 0) ctl[CW_PROG + j] = (unsigned)n;
        }
    }
__device__ __forceinline__ void phase2() { const Ctx c = make_ctx(); PHASE_PTRS; for (int R = c.gw; R < MR; R += c.NGW) postproj_row(R, c.lane, proj, INP(4), INP(9), INP(5), INP(7), mixed, qn, kvn, Kpe, cosT, sinT); }
__device__ __forceinline__ void phase3() { const Ctx c = make_ctx(); PHASE_PTRS;
        unsigned* ctl = (unsigned*)(ws + WS_CTL);
        if (c.G != 256 || !SPLIT_P3) {
            { pg8::Gemm g{qn, QL * 2}; pg8::PlainSched Sc; Sc.init(Wq, M, 1536, QL, c.G, c.wg);
              pg8::gemm_phase<pg8::EpiQ, pg8::PlainSched, true>(c.lds, g, Sc, pg8::EpiQ{Q, cosT, sinT}); }
            { pg8::Gemm g{kvn, KVL * 2}; pg8::PlainSched Sc; Sc.init(WkvK, M, 1024, KVL, c.G, c.wg);
              pg8::gemm_phase<pg8::EpiKn, pg8::PlainSched, true>(c.lds, g, Sc, pg8::EpiKn{Kn}); }
            { pg8::Gemm g{WkvV, KVL * 2}; pg8::PlainSched Sc; Sc.init(kvn, 1024, M, KVL, c.G, (c.wg + c.G / 2) % c.G);
              pg8::gemm_phase<pg8::EpiVt, pg8::PlainSched, true>(c.lds, g, Sc, pg8::EpiVt{V}); }
            gemm_simple(c, kvn + (size_t)M * KVL, KVL, Wkv, KVL, KVL, 1, 2048 / 32, EpiKV{Kn, V, M});
        } else if ((c.wg >> 3) < 16) {
            const int cw = (c.wg >> 3) * 8 + (c.wg & 7);
            { pg8::Gemm g{qn, QL * 2}; pg8::PlainSched Sc; Sc.init(Wq, M, 1536, QL, 128, cw);
              pg8::gemm_phase<pg8::EpiQ, pg8::PlainSched, true>(c.lds, g, Sc, pg8::EpiQ{Q, cosT, sinT}); }
            { pg8::Gemm g{kvn, KVL * 2}; pg8::PlainSched Sc; Sc.init(WkvK, M, 1024, KVL, 128, cw);
              pg8::gemm_phase<pg8::EpiKn, pg8::PlainSched, true>(c.lds, g, Sc, pg8::EpiKn{Kn}); }
            { pg8::Gemm g{WkvV, KVL * 2}; pg8::PlainSched Sc; Sc.init(kvn, 1024, M, KVL, 128, cw);
              pg8::gemm_phase<pg8::EpiVt, pg8::PlainSched, true>(c.lds, g, Sc, pg8::EpiVt{V}); }
            { Ctx c2 = make_ctx(); c2.gw = cw * NWAVES + c2.wave; c2.NGW = 128 * NWAVES;
              gemm_simple(c2, kvn + (size_t)M * KVL, KVL, Wkv, KVL, KVL, 1, 2048 / 32, EpiKV{Kn, V, M});
              if (c2.tid == 0) __hip_atomic_fetch_add(ctl + CW_QDONE, 1u, __ATOMIC_RELAXED, __HIP_MEMORY_SCOPE_AGENT); }
        } else {
            const int j = (((c.wg >> 3) - 16) * 8 + (c.wg & 7)) * NWAVES + c.wave;
            *(volatile LAS unsigned*)(c.lds + STOPW_OFF) = 0u;
            const int n = conv_stream(c, j, (int)ctl[CW_PROG + j], 1, ctl + CW_QDONE, INP(15), INP(17), (unsigned char*)Wgu, (unsigned char*)Wd);
            if (c.lane == 0) ctl[CW_PROG + j] = (unsigned)n;
        }
    }
__device__ __forceinline__ void phase5() { const Ctx c = make_ctx(); PHASE_PTRS;
        unsigned* ctl = (unsigned*)(ws + WS_CTL);
        if (c.G != 256) {
            for (int u = c.wg; u < NB * NH * 16; u += c.G) { const int bh = u >> 4, qb = u & 15; att::attn_unit(c.lds, bh >> 3, bh & 7, qb, 0, 4 * qb + 5, Q, Kn, Kpe, V, INP(10), mixed); }
        } else if ((c.wg >> 3) < 16) {
            const int x = c.wg & 7, i = c.wg >> 3;
#pragma unroll 1
            for (int k = 0; k < 2; ++k) { const int bh = 2 * x + k, qb = k == 0 ? i : 15 - i;
                att::attn_unit(c.lds, bh >> 3, bh & 7, qb, 0, 4 * qb + 5, Q, Kn, Kpe, V, INP(10), mixed); }
            const Ctx c3 = make_ctx(); if (c3.tid == 0) __hip_atomic_fetch_add(ctl + CW_ADONE, 1u, __ATOMIC_RELAXED, __HIP_MEMORY_SCOPE_AGENT);
        } else {
            const int j = (((c.wg >> 3) - 16) * 8 + (c.wg & 7)) * NWAVES + c.wave;
            *(volatile LAS unsigned*)(c.lds + STOPW_OFF) = 0u;
            const int n = conv_stream(c, j, (int)ctl[CW_PROG + j], 1, ctl + CW_ADONE, INP(15), INP(17), (unsigned char*)Wgu, (unsigned char*)Wd);
            if (c.lane == 0) ctl[CW_PROG + j] = (unsigned)n;
        }
    }
__device__ __forceinline__ void phase6() { const Ctx c = make_ctx(); PHASE_PTRS;
        pg8::Gemm g{mixed, D * 2}; pg8::PlainSched Sc; Sc.init(Wout, M, D, D, c.G, c.wg);
        pg8::gemm_phase<pg8::EpiResF32, pg8::PlainSched, true>(c.lds, g, Sc, pg8::EpiResF32{INP(0), h1, D});
    }
__device__ __forceinline__ void phase7() { const Ctx c = make_ctx(); PHASE_PTRS;
    for (int blk = c.wg; blk < M / 32; blk += c.G) router_block(c, blk, h1, INP(12), Wrt, INP(14), xn, cnt, rowtok, tok_e, tok_p, gate);
    { const unsigned* ctl = (const unsigned*)(ws + WS_CTL);
      for (int g = c.gw; g < 2 * CONV_SLOTS; g += c.NGW) { const int j = g % CONV_SLOTS, h = g / CONV_SLOTS;
          conv_stream(c, j, (int)ctl[CW_PROG + j] + h, 2, nullptr, INP(15), INP(17), (unsigned char*)Wgu, (unsigned char*)Wd); }
    }
}
__device__ __forceinline__ void phase8() { const Ctx c = make_ctx(); PHASE_PTRS;
        const LAS int* tab = build_expert_table(c, cnt);
        pg8::Gemm g{xn, D}; pg8::MoeSched<true> Sc{Wgu, (size_t)4096 * D, cnt, rowtok, tab, D, 16, c.G, c.wg};
        pg8::gemm_phase<pg8::EpiMoe1, pg8::MoeSched<true>, true, true>(c.lds, g, Sc, pg8::EpiMoe1{(unsigned char*)act, INP(16)});
    }
__device__ __forceinline__ void phase9() { const Ctx c = make_ctx(); PHASE_PTRS;
        const LAS int* tab = build_expert_table(c, cnt);
        pg8::Gemm g{act, DFF}; pg8::MoeSched<false> Sc{Wd, (size_t)D * DFF, cnt, rowtok, tab, DFF, 8, c.G, c.wg};
        pg8::gemm_phase<pg8::EpiMoe2, pg8::MoeSched<false>, true, true>(c.lds, g, Sc, pg8::EpiMoe2{y, INP(18)});
    }
__device__ __forceinline__ void phase10() { const Ctx c = make_ctx(); PHASE_PTRS; for (int m = c.gw; m < M; m += c.NGW) combine_row(m, c.lane, h1, y, cnt, tok_e, tok_p, gate, INP(19), ka->out); }
#undef KA
#undef WSP
#undef PHASE_PTRS
#undef INP

constexpr int NPHASE = 10;
constexpr int REP_PHASE = -1, REP_N = 1;
constexpr int STAMP_PHASE = -1, STAMP_AMP = 4;
__global__ void __launch_bounds__(NWAVES * 64, 2) mk_fwd(Args a) {
    extern __shared__ __attribute__((aligned(16))) unsigned char lds_raw[];
    volatile LAS unsigned* MISC = (volatile LAS unsigned*)((LAS unsigned char*)lds_raw + MISC_OFF);
    if (threadIdx.x < 32) MISC[threadIdx.x] = 0u;
    if (threadIdx.x == 32) *(volatile LAS unsigned*)((LAS unsigned char*)lds_raw + STOPW_OFF) = 0u;
    __syncthreads();
    XcdBarrier bar = xcd_barrier_post((unsigned*)(a.ws + WS_CTL) + CW_BAR, MISC + 8);
    const int lo = a.ph_lo, hi = a.ph_hi;
#define IN(k) (lo <= (k) && (k) < hi)
#define SEAM(k) do { if (IN(k) && IN((k) + 1)) xcd_barrier(bar); } while (0)
#define RUN(k) do { if constexpr (STAMP_PHASE == k) { if (threadIdx.x == 0) *(volatile LAS unsigned long long*)(MISC + 16) = __builtin_amdgcn_s_memrealtime(); } if (IN(k)) { phase##k(); if constexpr (REP_PHASE == k) { for (int r_ = 1; r_ < REP_N; ++r_) phase##k(); } } } while (0)
#define STAMP_END(k) do { if constexpr (STAMP_PHASE == k) { if (threadIdx.x == 0) *(volatile LAS unsigned long long*)(MISC + 18) = __builtin_amdgcn_s_memrealtime(); } } while (0)
    RUN(0);
    SEAM(0); STAMP_END(0);
    RUN(1);
    SEAM(1); STAMP_END(1);
    RUN(2);
    SEAM(2); STAMP_END(2);
    RUN(3);
    SEAM(3); STAMP_END(3);
    RUN(5);
    SEAM(5); STAMP_END(5);
    RUN(6);
    SEAM(6); STAMP_END(6);
    RUN(7);
    SEAM(7); STAMP_END(7);
    RUN(8);
    SEAM(8); STAMP_END(8);
    RUN(9);
    SEAM(9); STAMP_END(9);
    RUN(10); STAMP_END(10);
    if constexpr (STAMP_PHASE >= 0) { if (blockIdx.x == 0 && threadIdx.x == 0) { const unsigned long long t0 = __builtin_amdgcn_s_memrealtime(), want = (*(volatile LAS unsigned long long*)(MISC + 18) - *(volatile LAS unsigned long long*)(MISC + 16)) * STAMP_AMP;
        while (__builtin_amdgcn_s_memrealtime() - t0 < want) __builtin_amdgcn_s_sleep(8); } }
#undef IN
#undef SEAM
#undef RUN
#undef STAMP_END
}

extern "C" void kernel_launch(void* const* d_in, const int* in_sizes, int n_in, void* d_out, int out_size, void* d_ws, size_t ws_size, hipStream_t stream) {
    static int grid = 0;
    if (grid == 0) {
        if (n_in != 20 || ws_size < WS_END) { fprintf(stderr, "kernel_launch: unexpected n_in %d / ws %zu (need %zu)\n", n_in, ws_size, (size_t)WS_END); grid = -1; return; }
        int dev = 0, cus = 0, per_cu = 0;
        if (hipGetDevice(&dev) != hipSuccess || hipDeviceGetAttribute(&cus, hipDeviceAttributeMultiprocessorCount, dev) != hipSuccess) { grid = -1; return; }
        if (hipFuncSetAttribute((const void*)mk_fwd, hipFuncAttributeMaxDynamicSharedMemorySize, LDS_BYTES) != hipSuccess) { fprintf(stderr, "kernel_launch: hipFuncSetAttribute failed\n"); grid = -1; return; }
        if (hipOccupancyMaxActiveBlocksPerMultiprocessor(&per_cu, (const void*)mk_fwd, NWAVES * 64, LDS_BYTES) != hipSuccess || per_cu < 1) { fprintf(stderr, "kernel_launch: occupancy query says %d\n", per_cu); (void)hipGetLastError(); grid = -1; return; }
        grid = cus;
    }
    if (grid < 0) return;
    if (hipMemsetAsync((char*)d_ws + WS_CTL, 0, CTL_BYTES, stream) != hipSuccess) return;
    Args a{};
    for (int i = 0; i < 20; ++i) a.in[i] = (const float*)d_in[i];
    a.out = (float*)d_out; a.ws = (unsigned char*)d_ws; a.ph_lo = 0; a.ph_hi = NPHASE + 1;
    hipLaunchKernelGGL(mk_fwd, dim3(grid), dim3(NWAVES * 64), LDS_BYTES, stream, a);
}
```

```cpp
#include <hip/hip_runtime.h>
#include <cstdint>
#include <cstdio>

typedef unsigned short bf16;
typedef short bf16x8 __attribute__((ext_vector_type(8)));
typedef float f32x4 __attribute__((ext_vector_type(4)));
typedef unsigned u32x4 __attribute__((ext_vector_type(4)));
typedef unsigned u32x2 __attribute__((ext_vector_type(2)));

constexpr int D = 2048, NB = 2, S = 4096, NMETA = 16, M = NB * S;
constexpr int MR = M + NMETA;
constexpr int MRP = 8256;
constexpr int DCONV = 1024, QL = 512, KVL = 256, ROPE = 64, NH = 8, DN = 128, DV = 128, DQK = 192;
constexpr int DIN = 3904, DINP = 4096;
constexpr int O_C = 1024, O_U = 2048, O_Q = 3072, O_KV = 3584, O_R = 3840;
constexpr int NE = 32, TOPK = 4, DFF = 2048;
constexpr int LP = 4224;
constexpr int RP = 41216;
constexpr float EPS = 1e-6f;
constexpr float WSCALE = 64.0f, WINV = 1.0f / 64.0f;

constexpr size_t MiB = 1u << 20;
constexpr size_t WS_CTL = 0, CTL_BYTES = 1 * MiB;
constexpr size_t WS_WIN = 2 * MiB;
constexpr size_t WS_WQ = WS_WIN + 16 * MiB;
constexpr size_t WS_WKV = WS_WQ + 2 * MiB;
constexpr size_t WS_WOUT = WS_WKV + 2 * MiB;
constexpr size_t WS_WGU = WS_WOUT + 8 * MiB;
constexpr size_t WS_WD = WS_WGU + 512 * MiB;
constexpr size_t WS_HN = WS_WD + 256 * MiB;
constexpr size_t WS_PROJ = WS_HN + 34 * MiB;
constexpr size_t WS_MIXED = WS_PROJ + 66 * MiB;
constexpr size_t WS_QN = WS_MIXED + 32 * MiB;
constexpr size_t WS_KVN = WS_QN + 8 * MiB;
constexpr size_t WS_QRAW = WS_KVN + 6 * MiB;
constexpr size_t WS_WKVK = WS_QRAW;
constexpr size_t WS_WKVV = WS_QRAW + 1 * MiB;
constexpr size_t WS_COS = WS_QRAW + 2 * MiB;
constexpr size_t WS_SIN = WS_QRAW + 3 * MiB;
constexpr size_t WS_WRT = WS_QRAW + 4 * MiB;
constexpr size_t WS_Q = WS_QRAW + 48 * MiB;
constexpr size_t WS_KN = WS_Q + 24 * MiB;
constexpr size_t WS_V = WS_KN + 18 * MiB;
constexpr size_t WS_KPE = WS_V + 18 * MiB;
constexpr size_t WS_H1 = WS_KPE + 2 * MiB;
constexpr size_t WS_XN = WS_H1 + 64 * MiB;
constexpr size_t WS_TOKE = WS_XN + 32 * MiB;
constexpr size_t WS_TOKP = WS_TOKE + 1 * MiB;
constexpr size_t WS_GATE = WS_TOKP + 1 * MiB;
constexpr size_t WS_ROWTOK = WS_GATE + 1 * MiB;
constexpr size_t WS_ACT = WS_ROWTOK + 1 * MiB;
constexpr size_t WS_Y = WS_ACT + 162 * MiB;
constexpr size_t WS_END = WS_Y + 162 * MiB;
constexpr int CW_CNT = 64;
constexpr int CW_PROG = 2048;
constexpr int CW_QDONE = 1408;
constexpr int CW_PDONE = 1344;
constexpr int CW_ADONE = 1280;
constexpr int CW_BAR = 4096;

__device__ __forceinline__ float bf2f(bf16 v) { return __uint_as_float((unsigned)v << 16); }
__device__ __forceinline__ bf16 f2bf(float f) { unsigned u = __float_as_uint(f); return (bf16)((u + 0x7fffu + ((u >> 16) & 1u)) >> 16); }
__device__ __forceinline__ float wave_sum(float v) {
#pragma unroll
    for (int o = 1; o < 64; o <<= 1) v += __shfl_xor(v, o);
    return v;
}
__device__ __forceinline__ float wave_max(float v) {
#pragma unroll
    for (int o = 1; o < 64; o <<= 1) v = fmaxf(v, __shfl_xor(v, o));
    return v;
}
__device__ __forceinline__ void unpack8(const u32x4 w, float (&f)[8]) {
    f[0] = __uint_as_float(w.x << 16); f[1] = __uint_as_float(w.x & 0xffff0000u);
    f[2] = __uint_as_float(w.y << 16); f[3] = __uint_as_float(w.y & 0xffff0000u);
    f[4] = __uint_as_float(w.z << 16); f[5] = __uint_as_float(w.z & 0xffff0000u);
    f[6] = __uint_as_float(w.w << 16); f[7] = __uint_as_float(w.w & 0xffff0000u);
}
__device__ __forceinline__ unsigned pk2(float lo, float hi) { return (unsigned)f2bf(lo) | ((unsigned)f2bf(hi) << 16); }


#define GAS __attribute__((address_space(1)))
#define LAS __attribute__((address_space(3)))
#define LDS_WAIT() asm volatile("s_waitcnt lgkmcnt(0)" ::: "memory")
#define VM_WAIT() asm volatile("s_waitcnt vmcnt(0)" ::: "memory")
constexpr int NWAVES = 8;
constexpr int LDS_BYTES = 147456;
constexpr int RING_BYTES = 131072, MISC_OFF = LDS_BYTES - 2048;

#define XB_TMO      128
#define XB_XCNT(j)  (256  + 64 * (j))
#define XB_XSUB(j)  (1280 + 64 * (j))
#define XB_XGEN(j)  (2304 + 64 * (j))
#define XB_TOP      3328
#define XB_TOPGEN   3392
#define XCD_BAR_WORDS 3456
#define XB_SPIN_CAP (1u << 18)

__device__ __forceinline__ unsigned xb_ld(unsigned* p)              { return __hip_atomic_load(p, __ATOMIC_RELAXED, __HIP_MEMORY_SCOPE_AGENT); }
__device__ __forceinline__ unsigned xb_add(unsigned* p, unsigned v) { return __hip_atomic_fetch_add(p, v, __ATOMIC_RELAXED, __HIP_MEMORY_SCOPE_AGENT); }
__device__ __forceinline__ unsigned xb_xcc_id() { return (unsigned)__builtin_amdgcn_s_getreg((3 << 11) | 20) & 0xFu; }
#define XB_SPIN(cond, bar) do { unsigned _sp = 0; while (cond) { __builtin_amdgcn_s_sleep(1); \
    if ((++_sp & 255u) == 0u) { if (xb_ld(&(bar)[XB_TMO])) break; if (_sp > XB_SPIN_CAP) { atomicAdd(&(bar)[XB_TMO], 1u); break; } } } } while (0)

struct XcdBarrier {
    unsigned* bar; unsigned x;
    volatile LAS unsigned* st;
};
__device__ __forceinline__ XcdBarrier xcd_barrier_post(unsigned* bar, volatile LAS unsigned* st) {
    XcdBarrier b; b.bar = bar; b.x = xb_xcc_id(); b.st = st;
    if (threadIdx.x == 0) (void)xb_add(&bar[XB_XCNT(b.x)], 1u);
    return b;
}
__device__ __forceinline__ void xcd_barrier_complete(unsigned* bar, unsigned x, unsigned& nloc, unsigned& nx) {
    const unsigned G = gridDim.x * gridDim.y * gridDim.z;
    unsigned sum, cnt, mine, sp = 0u;
    for (;;) {
        sum = 0u; cnt = 0u; mine = 0u;
#pragma unroll
        for (unsigned j = 0; j < 16; ++j) { const unsigned c = xb_ld(&bar[XB_XCNT(j)]); sum += c; cnt += (c > 0u) ? 1u : 0u; mine = (j == x) ? c : mine; }
        if (sum == G) break;
        __builtin_amdgcn_s_sleep(1);
        if ((++sp & 255u) == 0u) { if (xb_ld(&bar[XB_TMO])) break; if (sp > XB_SPIN_CAP) { atomicAdd(&bar[XB_TMO], 1u); break; } }
    }
    nloc = mine > 0u ? mine : 1u; nx = cnt > 0u ? cnt : 1u;
}
__device__ __forceinline__ void xcd_barrier(const XcdBarrier& b) {
    asm volatile("s_waitcnt vmcnt(0)" ::: "memory");
    __syncthreads();
    if (threadIdx.x == 0) {
        unsigned* bar = b.bar;
        __builtin_amdgcn_s_waitcnt(0);
        unsigned nloc = b.st[0], nx = b.st[1];
        if (nloc == 0u) { xcd_barrier_complete(bar, b.x, nloc, nx); b.st[0] = nloc; b.st[1] = nx; }
        const unsigned old = xb_add(&bar[XB_XSUB(b.x)], 1u);
        const unsigned gen = old / nloc;
        if (old + 1u == (gen + 1u) * nloc) {
            __builtin_amdgcn_fence(__ATOMIC_RELEASE, "agent");
            asm volatile("s_waitcnt vmcnt(0)" ::: "memory");
            const unsigned og = xb_add(&bar[XB_TOP], 1u);
            const unsigned tg = og / nx;
            if (og + 1u == (tg + 1u) * nx) xb_add(&bar[XB_TOPGEN], 1u);
            else XB_SPIN(xb_ld(&bar[XB_TOPGEN]) == tg, bar);
            __builtin_amdgcn_fence(__ATOMIC_ACQUIRE, "agent");
            xb_add(&bar[XB_XGEN(b.x)], 1u);
            asm volatile("s_waitcnt vmcnt(0)" ::: "memory");
        } else {
            XB_SPIN(xb_ld(&bar[XB_XGEN(b.x)]) == gen, bar);
            __builtin_amdgcn_fence(__ATOMIC_ACQUIRE, "agent");
            asm volatile("s_waitcnt vmcnt(0)" ::: "memory");
        }
    }
    __syncthreads();
}

namespace pg8 {
constexpr int BM = 256, BK = 64, HALF = 128, HTB = HALF * BK * 2  , STAGE_BYTES = 8 * HTB, NXCD = 8, WGM = 8;
__host__ __device__ __forceinline__ int lds_byte(int r, int c) { const int st = (r >> 4) * 2 + (c >> 5), rr = r & 15, cc = c & 31, ob = rr * 64 + cc * 2; return st * 1024 + (ob ^ (((ob >> 9) & 1) << 5)); }
__host__ __device__ __forceinline__ void stage_rc(int b, int& R, int& C) { const int st = b / 1024, sb = b % 1024, swz = sb ^ (((sb >> 9) & 1) << 5); R = (st >> 1) * 16 + swz / 64; C = (st & 1) * 32 + (swz % 64) / 2; }
__host__ __device__ __forceinline__ int perm32(int rho) { const int n = rho >> 4, i = rho & 15; return 8 * (i >> 2) + 4 * n + (i & 3); }

struct Unit { int pm, pn, e, nrows; };
struct Gemm { const void* A; int RB; };
typedef int v8i __attribute__((ext_vector_type(8)));
typedef int v4i __attribute__((ext_vector_type(4)));

__device__ __forceinline__ unsigned cvt_pk_bf16(float lo, float hi) { unsigned r; asm volatile("v_cvt_pk_bf16_f32 %0, %1, %2" : "=v"(r) : "v"(lo), "v"(hi)); return r; }

struct Frag16 { bf16x8 h[2]; };
template <bool FP8> struct FragT { typedef Frag16 T; };
template <> struct FragT<true> { typedef v8i T; };
__device__ __forceinline__ void frag_set(Frag16& f, int k, const bf16x8 v) { f.h[k] = v; }
__device__ __forceinline__ void frag_set(v8i& f, int k, const bf16x8 v) { const v4i w = __builtin_bit_cast(v4i, v); if (k == 0) { f[0] = w[0]; f[1] = w[1]; f[2] = w[2]; f[3] = w[3]; } else { f[4] = w[0]; f[5] = w[1]; f[6] = w[2]; f[7] = w[3]; } }
__device__ __forceinline__ f32x4 mma_fp8(const v8i& b, const v8i& a, const f32x4 c) { return __builtin_amdgcn_mfma_scale_f32_16x16x128_f8f6f4(b, a, c, 0, 0, 0, 0, 0, 0); }
__device__ __forceinline__ f32x4 mma_fp8(const Frag16&, const Frag16&, const f32x4 c) { return c; }
__device__ __forceinline__ f32x4 mma_bf16(const Frag16& b, const Frag16& a, int k, const f32x4 c) { return __builtin_amdgcn_mfma_f32_16x16x32_bf16(b.h[k], a.h[k], c, 0, 0, 0); }
__device__ __forceinline__ f32x4 mma_bf16(const v8i&, const v8i&, int, const f32x4 c) { return c; }
template <class Epi, class Sched, bool ALIGN_EPI, bool FP8 = false>
__device__ __forceinline__ void gemm_phase(LAS unsigned char* lds, const Gemm g, const Sched& S, const Epi& E) {
    int tid_ = threadIdx.x; asm volatile("" : "+v"(tid_));
    const int tid = tid_, wid = __builtin_amdgcn_readfirstlane(tid >> 6), lane = tid & 63, wr = wid >> 2, wc = wid & 3, fr = lane & 15, fq = lane >> 4;
    const int RB = g.RB, nt = RB / (BK * 2);
    int sR[2], sC[2]; unsigned voffB[2];
#pragma unroll
    for (int i = 0; i < 2; ++i) { stage_rc(tid * 16 + i * 8192, sR[i], sC[i]); const int Rb = Epi::PERM ? ((sR[i] & ~31) + perm32(sR[i] & 31)) : sR[i]; voffB[i] = (unsigned)(Rb * RB + sC[i] * 2); }
    const size_t kstep = (size_t)(BK * 2);
    const size_t hstep = (size_t)HALF * RB;
    const unsigned ldsw = (unsigned)wid * 1024u;
    const int aoff = lds_byte(wr * 64 + fr, fq * 8), boff = lds_byte(wc * 32 + fr, fq * 8);
    const char* Ab = (const char*)g.A;
#define PG8_SA(b, h) (((b) * 2 + (h)) * HTB)
#define PG8_SB(b, h) ((4 + (b) * 2 + (h)) * HTB)
#define PG8_STAGE(bufoff, gbase, voff) do { _Pragma("unroll") for (int _i = 0; _i < 2; ++_i) \
        __builtin_amdgcn_global_load_lds((const unsigned*)((const char*)(gbase) + (voff)[_i]), (LAS unsigned*)(lds + (bufoff) + ldsw + _i * 8192), 16, 0, 0); } while (0)
#define PG8_LDA(dst, b, h) do { _Pragma("unroll") for (int m = 0; m < 4; ++m) _Pragma("unroll") for (int k = 0; k < 2; ++k) frag_set(dst[m], k, *(const LAS bf16x8*)(lds + PG8_SA(b, h) + aoff + m * 2048 + k * 1024)); } while (0)
#define PG8_LDB(dst, b, h) do { _Pragma("unroll") for (int n = 0; n < 2; ++n) _Pragma("unroll") for (int k = 0; k < 2; ++k) frag_set(dst[n], k, *(const LAS bf16x8*)(lds + PG8_SB(b, h) + boff + n * 2048 + k * 1024)); } while (0)
#define PG8_MMA(ai, bj, At, Bt) do { __builtin_amdgcn_s_setprio(1); if constexpr (FP8) { _Pragma("unroll") for (int m = 0; m < 4; ++m) _Pragma("unroll") for (int n = 0; n < 2; ++n) \
        acc[ai][bj][m][n] = mma_fp8(Bt[n], At[m], acc[ai][bj][m][n]); } \
    else { _Pragma("unroll") for (int m = 0; m < 4; ++m) _Pragma("unroll") for (int n = 0; n < 2; ++n) _Pragma("unroll") for (int k = 0; k < 2; ++k) \
        acc[ai][bj][m][n] = mma_bf16(Bt[n], At[m], k, acc[ai][bj][m][n]); } __builtin_amdgcn_s_setprio(0); } while (0)
#define PG8_WAIT_V(n) asm volatile("s_waitcnt vmcnt(" #n ")" ::: "memory")
#define PG8_WAIT_L(n) asm volatile("s_waitcnt lgkmcnt(" #n ")" ::: "memory")
#define PG8_BAR __builtin_amdgcn_s_barrier()
#define PG8_SCHED __builtin_amdgcn_sched_barrier(0)
    Unit cur, nxt; int ui = 0;
    if (!S.next(0, cur)) return;
    f32x4 acc[2][2][4][2];
#pragma unroll
    for (int a = 0; a < 2; ++a)
#pragma unroll
        for (int b = 0; b < 2; ++b)
#pragma unroll
            for (int m = 0; m < 4; ++m)
#pragma unroll
                for (int n = 0; n < 2; ++n) acc[a][b][m][n] = (f32x4){0.f, 0.f, 0.f, 0.f};
    typename FragT<FP8>::T At[4], B0[2], B1[2];
    unsigned ao[2][2];
    S.a_off(cur, sR, sC, ao);
    const char* cB = S.b_base(cur);
    PG8_STAGE(PG8_SB(0, 0), cB, voffB); PG8_STAGE(PG8_SB(0, 1), cB + hstep, voffB); PG8_STAGE(PG8_SA(0, 0), Ab, ao[0]); PG8_STAGE(PG8_SA(0, 1), Ab, ao[1]);
    if (wr == 1) PG8_BAR;
    PG8_WAIT_V(2); PG8_BAR;
    PG8_STAGE(PG8_SB(1, 0), cB + kstep, voffB); PG8_STAGE(PG8_SA(1, 0), Ab + kstep, ao[0]); PG8_STAGE(PG8_SB(1, 1), cB + hstep + kstep, voffB);
    PG8_WAIT_V(6); PG8_BAR;
    for (;;) {
        const bool has_next = S.next(ui + 1, nxt);
        const char* nB = has_next ? S.b_base(nxt) : cB;
        const bool full = cur.nrows > HALF;
#pragma unroll 1
        for (int t = 0; t < nt; t += 2) {
            const bool last = (t == nt - 2);
            const char* a1 = Ab + (size_t)(t + 1) * kstep;
            PG8_LDB(B0, 0, 0); PG8_LDB(B1, 0, 1); PG8_SCHED; PG8_LDA(At, 0, 0); PG8_STAGE(PG8_SA(1, 1), a1, ao[1]);
            PG8_WAIT_V(8); PG8_WAIT_L(0); PG8_BAR; PG8_MMA(0, 0, At, B0); PG8_MMA(0, 1, At, B1); PG8_BAR; PG8_SCHED;
            const char* a2 = last ? Ab : Ab + (size_t)(t + 2) * kstep; const char* b2 = last ? nB : cB + (size_t)(t + 2) * kstep;
            if (last && has_next) { int t2 = tid; asm volatile("" : "+v"(t2)); int R2[2], C2[2];
#pragma unroll
                for (int i = 0; i < 2; ++i) stage_rc(t2 * 16 + i * 8192, R2[i], C2[i]);
                S.a_off(nxt, R2, C2, ao); }
            const char* a3 = a2 + kstep; const char* b3 = b2 + kstep;
            PG8_LDA(At, 0, 1); PG8_STAGE(PG8_SB(0, 0), b2, voffB); PG8_STAGE(PG8_SB(0, 1), b2 + hstep, voffB); PG8_STAGE(PG8_SA(0, 0), a2, ao[0]);
            PG8_WAIT_V(8); PG8_WAIT_L(0); PG8_BAR; if (full) { PG8_MMA(1, 0, At, B0); PG8_MMA(1, 1, At, B1); } PG8_BAR; PG8_SCHED;
            PG8_LDB(B0, 1, 0); PG8_LDB(B1, 1, 1); PG8_SCHED; PG8_LDA(At, 1, 0); PG8_STAGE(PG8_SA(0, 1), a2, ao[1]);
            PG8_WAIT_V(8); PG8_WAIT_L(0); PG8_BAR; PG8_MMA(0, 0, At, B0); PG8_MMA(0, 1, At, B1); PG8_BAR; PG8_SCHED;
            PG8_LDA(At, 1, 1); PG8_STAGE(PG8_SB(1, 0), b3, voffB); PG8_STAGE(PG8_SB(1, 1), b3 + hstep, voffB); PG8_STAGE(PG8_SA(1, 0), a3, ao[0]);
            PG8_WAIT_V(8); PG8_WAIT_L(0); PG8_BAR; if (full) { PG8_MMA(1, 0, At, B0); PG8_MMA(1, 1, At, B1); } PG8_BAR; PG8_SCHED;
        }
        if constexpr (ALIGN_EPI) { if (wr == 0) PG8_BAR; }
        E(acc, cur, wr, wc, fr, fq);
        if (!has_next) break;
#pragma unroll
        for (int a = 0; a < 2; ++a)
#pragma unroll
            for (int b = 0; b < 2; ++b)
#pragma unroll
                for (int m = 0; m < 4; ++m)
#pragma unroll
                    for (int n = 0; n < 2; ++n) acc[a][b][m][n] = (f32x4){0.f, 0.f, 0.f, 0.f};
        cur = nxt; cB = nB; ++ui;
        if constexpr (ALIGN_EPI) { if (wr == 1) PG8_BAR; }
    }
    PG8_WAIT_V(0);
    if constexpr (!ALIGN_EPI) { if (wr == 0) PG8_BAR; }
    PG8_BAR;
#undef PG8_SA
#undef PG8_SB
#undef PG8_STAGE
#undef PG8_LDA
#undef PG8_LDB
#undef PG8_MMA
#undef PG8_WAIT_V
#undef PG8_WAIT_L
#undef PG8_BAR
#undef PG8_SCHED
}

struct PlainSched {
    const bf16* Bt; int RB, nM, nN, nwg, G, c;
    __device__ void init(const bf16* Bt_, int M_, int N_, int K_, int G_, int c_) { Bt = Bt_; RB = K_ * 2; nM = M_ / BM; nN = N_ / BM; nwg = nM * nN; G = G_; c = c_; }
    __device__ __forceinline__ bool next(int i, Unit& u) const {
        const long L = (long)i * G + c; if (L >= nwg) return false;
        int wgid = (int)L; { const int q = nwg / NXCD, r = nwg % NXCD, xcd = wgid % NXCD, off = wgid / NXCD; wgid = (xcd < r ? xcd * (q + 1) : r * (q + 1) + (xcd - r) * q) + off; }
        const int nig = WGM * nN, gid = wgid / nig, fm = gid * WGM, gsz = (nM - fm) < WGM ? (nM - fm) : WGM;
        u.pm = fm + ((wgid % nig) % gsz); u.pn = (wgid % nig) / gsz; u.e = 0; u.nrows = BM; return true;
    }
    __device__ __forceinline__ void a_off(const Unit& u, const int (&R)[2], const int (&C)[2], unsigned (&off)[2][2]) const {
#pragma unroll
        for (int h = 0; h < 2; ++h)
#pragma unroll
            for (int i = 0; i < 2; ++i) off[h][i] = (unsigned)((u.pm * BM + h * HALF + R[i]) * RB + C[i] * 2);
    }
    __device__ __forceinline__ const char* b_base(const Unit& u) const { return (const char*)Bt + (size_t)u.pn * BM * RB; }
};

struct EpiStoreBf16 {
    static constexpr bool PERM = true;
    bf16* O; int ldc;
    __device__ __forceinline__ void operator()(const f32x4 (&acc)[2][2][4][2], const Unit& u, int wr, int wc, int fr, int fq) const {
        const int row0 = u.pm * BM + wr * 64 + fr, col0 = u.pn * BM + wc * 32 + 8 * fq;
#pragma unroll
        for (int ai = 0; ai < 2; ++ai)
#pragma unroll
            for (int m = 0; m < 4; ++m) { bf16* rowp = O + (size_t)(row0 + ai * HALF + m * 16) * ldc + col0;
#pragma unroll
                for (int bj = 0; bj < 2; ++bj) { const f32x4 v0 = acc[ai][bj][m][0], v1 = acc[ai][bj][m][1];
                    u32x4 w; w.x = cvt_pk_bf16(v0[0], v0[1]); w.y = cvt_pk_bf16(v0[2], v0[3]); w.z = cvt_pk_bf16(v1[0], v1[1]); w.w = cvt_pk_bf16(v1[2], v1[3]);
                    *(u32x4*)(rowp + bj * HALF) = w; } }
    }
};
struct EpiResF32 {
    static constexpr bool PERM = false;
    const float* base; float* out; int ldc;
    __device__ __forceinline__ void operator()(const f32x4 (&acc)[2][2][4][2], const Unit& u, int wr, int wc, int fr, int fq) const {
        const int row0 = u.pm * BM + wr * 64 + fr, col0 = u.pn * BM + wc * 32 + 4 * fq;
#pragma unroll
        for (int ai = 0; ai < 2; ++ai)
#pragma unroll
            for (int m = 0; m < 4; ++m) { const size_t off = (size_t)(row0 + ai * HALF + m * 16) * ldc + col0;
#pragma unroll
                for (int bj = 0; bj < 2; ++bj)
#pragma unroll
                    for (int n = 0; n < 2; ++n) { const f32x4 b = *(const f32x4*)(base + off + bj * HALF + n * 16); *(f32x4*)(out + off + bj * HALF + n * 16) = b + acc[ai][bj][m][n]; } }
    }
};
struct EpiQ {
    static constexpr bool PERM = true;
    bf16* Q; const float* cosT; const float* sinT;
    __device__ __forceinline__ void operator()(const f32x4 (&acc)[2][2][4][2], const Unit& u, int wr, int wc, int fr, int fq) const {
        const int row0 = u.pm * BM + wr * 64 + fr;
#pragma unroll
        for (int bj = 0; bj < 2; ++bj) {
            const int k64 = 4 * u.pn + 2 * bj + (wc >> 1), head = k64 / 3, type = k64 % 3, blk = wc & 1;
            if (type < 2) {
                const int dim = 64 * type + 32 * blk + 8 * fq;
#pragma unroll
                for (int ai = 0; ai < 2; ++ai)
#pragma unroll
                    for (int m = 0; m < 4; ++m) { const int r = row0 + ai * HALF + m * 16; const f32x4 v0 = acc[ai][bj][m][0], v1 = acc[ai][bj][m][1];
                        u32x4 w; w.x = cvt_pk_bf16(v0[0], v0[1]); w.y = cvt_pk_bf16(v0[2], v0[3]); w.z = cvt_pk_bf16(v1[0], v1[1]); w.w = cvt_pk_bf16(v1[2], v1[3]);
                        *(u32x4*)(Q + ((size_t)r * NH + head) * DQK + dim) = w; }
            } else {
                const int i0 = 16 * blk + 4 * fq;
#pragma unroll
                for (int ai = 0; ai < 2; ++ai)
#pragma unroll
                    for (int m = 0; m < 4; ++m) { const int r = row0 + ai * HALF + m * 16, pos = (r % S) + NMETA;
                        const f32x4 cs = *(const f32x4*)(cosT + pos * 32 + i0), sn = *(const f32x4*)(sinT + pos * 32 + i0);
                        const f32x4 x1 = acc[ai][bj][m][0], x2 = acc[ai][bj][m][1];
                        const f32x4 o1 = x1 * cs - x2 * sn, o2 = x1 * sn + x2 * cs;
                        bf16* dst = Q + ((size_t)r * NH + head) * DQK + 128 + i0;
                        u32x2 w1; w1.x = cvt_pk_bf16(o1[0], o1[1]); w1.y = cvt_pk_bf16(o1[2], o1[3]); *(u32x2*)(dst) = w1;
                        u32x2 w2; w2.x = cvt_pk_bf16(o2[0], o2[1]); w2.y = cvt_pk_bf16(o2[2], o2[3]); *(u32x2*)(dst + 32) = w2; }
            }
        }
    }
};
struct EpiKn {
    static constexpr bool PERM = true;
    bf16* kn;
    __device__ __forceinline__ void operator()(const f32x4 (&acc)[2][2][4][2], const Unit& u, int wr, int wc, int fr, int fq) const {
        const int row0 = u.pm * BM + wr * 64 + fr, col0 = u.pn * BM + wc * 32 + 8 * fq;
#pragma unroll
        for (int ai = 0; ai < 2; ++ai)
#pragma unroll
            for (int m = 0; m < 4; ++m) { const int r = row0 + ai * HALF + m * 16, b = r / S, pos = (r % S) + NMETA; bf16* rowp = kn + (size_t)(b * LP + pos) * (NH * 128) + col0;
#pragma unroll
                for (int bj = 0; bj < 2; ++bj) { const f32x4 v0 = acc[ai][bj][m][0], v1 = acc[ai][bj][m][1];
                    u32x4 w; w.x = cvt_pk_bf16(v0[0], v0[1]); w.y = cvt_pk_bf16(v0[2], v0[3]); w.z = cvt_pk_bf16(v1[0], v1[1]); w.w = cvt_pk_bf16(v1[2], v1[3]);
                    *(u32x4*)(rowp + bj * HALF) = w; } }
    }
};
struct EpiVt {
    static constexpr bool PERM = true;
    bf16* vt;
    __device__ __forceinline__ void operator()(const f32x4 (&acc)[2][2][4][2], const Unit& u, int wr, int wc, int fr, int fq) const {
        const int f0 = u.pm * BM + wr * 64 + fr, tk0 = u.pn * BM + wc * 32 + 8 * fq;
#pragma unroll
        for (int ai = 0; ai < 2; ++ai)
#pragma unroll
            for (int m = 0; m < 4; ++m) { const int f = f0 + ai * HALF + m * 16;
#pragma unroll
                for (int bj = 0; bj < 2; ++bj) { const int tk = tk0 + bj * HALF, b = tk / S, t = tk % S; const f32x4 v0 = acc[ai][bj][m][0], v1 = acc[ai][bj][m][1];
                    u32x4 w; w.x = cvt_pk_bf16(v0[0], v0[1]); w.y = cvt_pk_bf16(v0[2], v0[3]); w.z = cvt_pk_bf16(v1[0], v1[1]); w.w = cvt_pk_bf16(v1[2], v1[3]);
                    *(u32x4*)(vt + ((size_t)b * (NH * 128) + f) * LP + NMETA + t) = w; } }
    }
};
template <bool GATHER>
struct MoeSched {
    const void* W; size_t wbytes;
    const unsigned* cnt; const int* rowtok; const LAS int* tab;
    int RB, nN, G, c;
    __device__ __forceinline__ bool next(int i, Unit& u) const {
        const int total = tab[32] * nN; const int L = i * G + c; if (L >= total) return false;
        const int gt = L / nN; int e = 0;
#pragma unroll
        for (int j = 1; j < 32; ++j) e += (gt >= tab[j]) ? 1 : 0;
        e = __builtin_amdgcn_readfirstlane(e);
        u.pm = __builtin_amdgcn_readfirstlane(gt); u.pn = __builtin_amdgcn_readfirstlane(L % nN); u.e = e;
        u.nrows = __builtin_amdgcn_readfirstlane((int)cnt[e] - (gt - tab[e]) * BM);
        return true;
    }
    __device__ __forceinline__ void a_off(const Unit& u, const int (&R)[2], const int (&C)[2], unsigned (&off)[2][2]) const {
#pragma unroll
        for (int h = 0; h < 2; ++h)
#pragma unroll
            for (int i = 0; i < 2; ++i) {
                if (GATHER) { const int lt = (u.pm - tab[u.e]) * BM; int li = h * HALF + R[i]; li = li < u.nrows ? li : u.nrows - 1;
                    const int tok = rowtok[u.e * M + lt + li]; off[h][i] = (unsigned)(tok * RB + C[i] * 2); }
                else off[h][i] = (unsigned)((u.pm * BM + h * HALF + R[i]) * RB + C[i] * 2);
            }
    }
    __device__ __forceinline__ const char* b_base(const Unit& u) const { return (const char*)W + (size_t)u.e * wbytes + (size_t)u.pn * BM * RB; }
};
struct EpiMoe1 {
    static constexpr bool PERM = true;
    unsigned char* act; const float* b_gu;
    __device__ __forceinline__ void operator()(const f32x4 (&acc)[2][2][4][2], const Unit& u, int wr, int wc, int fr, int fq) const {
        const int row0 = u.pm * BM + wr * 64 + fr, cc = u.pn * HALF + wc * 32 + 8 * fq;
        const float* bias = b_gu + (size_t)u.e * 4096 + cc;
        const f32x4 bg0 = *(const f32x4*)(bias), bg1 = *(const f32x4*)(bias + 4), bl0 = *(const f32x4*)(bias + 2048), bl1 = *(const f32x4*)(bias + 2048 + 4);
#pragma unroll
        for (int ai = 0; ai < 2; ++ai)
#pragma unroll
            for (int m = 0; m < 4; ++m) {
                f32x4 o[2];
#pragma unroll
                for (int n = 0; n < 2; ++n) { const f32x4 gv = acc[ai][0][m][n] * WINV + (n ? bg1 : bg0), lv = acc[ai][1][m][n] * WINV + (n ? bl1 : bl0);
#pragma unroll
                    for (int j = 0; j < 4; ++j) { const float g = fminf(gv[j], 7.0f), l = fminf(fmaxf(lv[j], -7.0f), 7.0f);
                        o[n][j] = (l + 1.0f) * g * __builtin_amdgcn_rcpf(1.0f + __builtin_amdgcn_exp2f(-1.702f * 1.4426950408889634f * g)); } }
                int w0 = 0, w1 = 0;
                w0 = __builtin_amdgcn_cvt_pk_fp8_f32(o[0][0], o[0][1], w0, false); w0 = __builtin_amdgcn_cvt_pk_fp8_f32(o[0][2], o[0][3], w0, true);
                w1 = __builtin_amdgcn_cvt_pk_fp8_f32(o[1][0], o[1][1], w1, false); w1 = __builtin_amdgcn_cvt_pk_fp8_f32(o[1][2], o[1][3], w1, true);
                *(u32x2*)(act + (size_t)(row0 + ai * HALF + m * 16) * DFF + cc) = (u32x2){(unsigned)w0, (unsigned)w1};
            }
    }
};
struct EpiMoe2 {
    static constexpr bool PERM = true;
    bf16* y; const float* b_d;
    __device__ __forceinline__ void operator()(const f32x4 (&acc)[2][2][4][2], const Unit& u, int wr, int wc, int fr, int fq) const {
        const int row0 = u.pm * BM + wr * 64 + fr, col0 = u.pn * BM + wc * 32 + 8 * fq;
        const float* bias = b_d + (size_t)u.e * D + col0;
        f32x4 bv[2][2];
#pragma unroll
        for (int bj = 0; bj < 2; ++bj)
#pragma unroll
            for (int n = 0; n < 2; ++n) bv[bj][n] = *(const f32x4*)(bias + bj * HALF + 4 * n);
#pragma unroll
        for (int ai = 0; ai < 2; ++ai)
#pragma unroll
            for (int m = 0; m < 4; ++m) { bf16* rowp = y + (size_t)(row0 + ai * HALF + m * 16) * D + col0;
#pragma unroll
                for (int bj = 0; bj < 2; ++bj) { const f32x4 v0 = acc[ai][bj][m][0] * WINV + bv[bj][0], v1 = acc[ai][bj][m][1] * WINV + bv[bj][1];
                    u32x4 w; w.x = cvt_pk_bf16(v0[0], v0[1]); w.y = cvt_pk_bf16(v0[2], v0[3]); w.z = cvt_pk_bf16(v1[0], v1[1]); w.w = cvt_pk_bf16(v1[2], v1[3]);
                    *(u32x4*)(rowp + bj * HALF) = w; } }
    }
};
}

namespace att {
typedef float f32x16 __attribute__((ext_vector_type(16)));
typedef float f32x2 __attribute__((ext_vector_type(2)));
constexpr int KPITCH = 400, VPITCH = 144;
constexpr int KBYTES = 64 * KPITCH, VBYTES = 128 * VPITCH, STAGE = KBYTES + VBYTES;
constexpr int WSF_OFF = 2 * STAGE;
static_assert(WSF_OFF + 8 * 256 <= RING_BYTES, "attention LDS");
constexpr float SC = 0.07216878364870322f * 1.4426950408889634f;

__device__ __forceinline__ int crow(int r, int hi) { return (r & 3) + 8 * (r >> 2) + 4 * hi; }

__device__ __forceinline__ void attn_unit(LAS unsigned char* lds, int b, int h, int qb, int ta, int tb, const bf16* __restrict__ Q, const bf16* __restrict__ Kn, const bf16* __restrict__ Kpe,
                                          const bf16* __restrict__ Vt, const float* __restrict__ g_attn, bf16* __restrict__ mixed) {
    const int tid = threadIdx.x, lane = tid & 63, r32 = lane & 31, hi = lane >> 5, wid = __builtin_amdgcn_readfirstlane(tid >> 6);
    const int t0 = qb * 256 + wid * 32;
    const int m0 = b * S + t0;
    const int wave_max_pos = t0 + 31 + NMETA, wave_min_pos = t0 + NMETA;
    LAS float* wsf = (LAS float*)(lds + WSF_OFF) + wid * 64;
    unsigned koff[3], kdst[3], kstr[3];
#pragma unroll
    for (int i = 0; i < 3; ++i) { const int id = tid + 512 * i, key = id / 24, c = id % 24;
        koff[i] = c < 16 ? (unsigned)((((b * LP + key) * NH + h) * 128 + c * 8) * 2) : (unsigned)(WS_KPE - WS_KN) + (unsigned)(((b * LP + key) * ROPE + (c - 16) * 8) * 2);
        kstr[i] = c < 16 ? 64u * NH * 128 * 2 : 64u * ROPE * 2;
        const int row = (key & ~12) | ((key & 4) << 1) | ((key & 8) >> 1);
        kdst[i] = (unsigned)(row * KPITCH + c * 16); }
    unsigned voff[2], vdst[2];
#pragma unroll
    for (int i = 0; i < 2; ++i) { const int id = tid + 512 * i, d = id >> 3, kc = id & 7;
        voff[i] = (unsigned)((((b * NH + h) * 128 + d) * LP + kc * 8) * 2); vdst[i] = (unsigned)(KBYTES + d * VPITCH + kc * 16); }
    const char* const Knb = (const char*)Kn; const char* const Vtb = (const char*)Vt;
    bf16x8 qf[12];
    { const bf16* qp = Q + ((size_t)(m0 + r32) * NH + h) * DQK + 8 * hi;
#pragma unroll
      for (int ks = 0; ks < 12; ++ks) qf[ks] = *(const bf16x8*)(qp + ks * 16); }
    f32x16 o[4];
#pragma unroll
    for (int d = 0; d < 4; ++d)
#pragma unroll
        for (int r = 0; r < 16; ++r) o[d][r] = 0.f;
    float mrow = -1.0e30f, lsum = 0.f;
    u32x4 kreg[3], vreg[2];
#pragma unroll
    for (int i = 0; i < 3; ++i) kreg[i] = *(const u32x4*)(Knb + (koff[i] + (unsigned)ta * kstr[i]));
#pragma unroll
    for (int i = 0; i < 2; ++i) vreg[i] = *(const u32x4*)(Vtb + (voff[i] + (unsigned)ta * 128u));
#pragma unroll
    for (int i = 0; i < 3; ++i) *(LAS u32x4*)(lds + kdst[i]) = kreg[i];
#pragma unroll
    for (int i = 0; i < 2; ++i) *(LAS u32x4*)(lds + vdst[i]) = vreg[i];
    __syncthreads();
    for (int t = ta; t < tb; ++t) {
        const bool more = t + 1 < tb; const int st = (t - ta) & 1;
        if (more) {
#pragma unroll
            for (int i = 0; i < 3; ++i) kreg[i] = *(const u32x4*)(Knb + (koff[i] + (unsigned)(t + 1) * kstr[i]));
#pragma unroll
            for (int i = 0; i < 2; ++i) vreg[i] = *(const u32x4*)(Vtb + (voff[i] + (unsigned)(t + 1) * 128u));
        }
        const int kb = t * 64;
        if (kb <= wave_max_pos) {
            const LAS unsigned char* Kb = lds + st * STAGE; const LAS unsigned char* Vb = Kb + KBYTES;
            f32x16 p0, p1;
#pragma unroll
            for (int r = 0; r < 16; ++r) { p0[r] = 0.f; p1[r] = 0.f; }
            const LAS unsigned char* kp = Kb + r32 * KPITCH + hi * 16;
#pragma unroll
            for (int ks = 0; ks < 12; ++ks) {
                const bf16x8 k0 = *(const LAS bf16x8*)(kp + ks * 32), k1 = *(const LAS bf16x8*)(kp + 32 * KPITCH + ks * 32);
                p0 = __builtin_amdgcn_mfma_f32_32x32x16_bf16(k0, qf[ks], p0, 0, 0, 0);
                p1 = __builtin_amdgcn_mfma_f32_32x32x16_bf16(k1, qf[ks], p1, 0, 0, 0);
            }
            if (kb + 63 > wave_min_pos) {
                const int qpos = t0 + r32 + NMETA, kbase = kb + 8 * hi;
#pragma unroll
                for (int r = 0; r < 16; ++r) { const int key = kbase + 16 * (r >> 3) + (r & 7); if (key > qpos) p0[r] = -INFINITY; if (key + 32 > qpos) p1[r] = -INFINITY; }
            }
            float mx = fmaxf(p0[0], p1[0]);
#pragma unroll
            for (int r = 1; r < 16; ++r) mx = fmaxf(mx, fmaxf(p0[r], p1[r]));
            mx = fmaxf(mx, __shfl_xor(mx, 32));
            const float mnew = fmaxf(mrow, mx);
            const bool grew = __any(mnew > mrow);
            if (grew) {
                const float corr = __builtin_amdgcn_exp2f((mrow - mnew) * SC);
                lsum *= corr; mrow = mnew;
                if (hi == 0) wsf[r32] = corr;
                asm volatile("s_waitcnt lgkmcnt(0)" ::: "memory");
#pragma unroll
                for (int g = 0; g < 4; ++g) { const f32x4 f = *(const LAS f32x4*)(wsf + 8 * g + 4 * hi);
#pragma unroll
                    for (int d = 0; d < 4; ++d) { o[d][4 * g + 0] *= f.x; o[d][4 * g + 1] *= f.y; o[d][4 * g + 2] *= f.z; o[d][4 * g + 3] *= f.w; } }
            }
            const float nm = -mrow * SC;
            float ps = 0.f;
#pragma unroll
            for (int r = 0; r < 16; ++r) { p0[r] = __builtin_amdgcn_exp2f(__builtin_fmaf(p0[r], SC, nm)); p1[r] = __builtin_amdgcn_exp2f(__builtin_fmaf(p1[r], SC, nm)); ps += p0[r] + p1[r]; }
            lsum += ps;
            u32x4 pa[4];
            pa[0] = (u32x4){pg8::cvt_pk_bf16(p0[0], p0[1]), pg8::cvt_pk_bf16(p0[2], p0[3]), pg8::cvt_pk_bf16(p0[4], p0[5]), pg8::cvt_pk_bf16(p0[6], p0[7])};
            pa[1] = (u32x4){pg8::cvt_pk_bf16(p0[8], p0[9]), pg8::cvt_pk_bf16(p0[10], p0[11]), pg8::cvt_pk_bf16(p0[12], p0[13]), pg8::cvt_pk_bf16(p0[14], p0[15])};
            pa[2] = (u32x4){pg8::cvt_pk_bf16(p1[0], p1[1]), pg8::cvt_pk_bf16(p1[2], p1[3]), pg8::cvt_pk_bf16(p1[4], p1[5]), pg8::cvt_pk_bf16(p1[6], p1[7])};
            pa[3] = (u32x4){pg8::cvt_pk_bf16(p1[8], p1[9]), pg8::cvt_pk_bf16(p1[10], p1[11]), pg8::cvt_pk_bf16(p1[12], p1[13]), pg8::cvt_pk_bf16(p1[14], p1[15])};
            const LAS unsigned char* vp = Vb + r32 * VPITCH + hi * 16;
#pragma unroll
            for (int d = 0; d < 4; ++d)
#pragma unroll
                for (int s = 0; s < 4; ++s) { const bf16x8 vf = *(const LAS bf16x8*)(vp + d * 32 * VPITCH + s * 32);
                    o[d] = __builtin_amdgcn_mfma_f32_32x32x16_bf16(__builtin_bit_cast(bf16x8, pa[s]), vf, o[d], 0, 0, 0); }
        }
        if (more) {
            LAS unsigned char* nb = lds + (st ^ 1) * STAGE;
#pragma unroll
            for (int i = 0; i < 3; ++i) *(LAS u32x4*)(nb + kdst[i]) = kreg[i];
#pragma unroll
            for (int i = 0; i < 2; ++i) *(LAS u32x4*)(nb + vdst[i]) = vreg[i];
        }
        __syncthreads();
    }
    lsum += __shfl_xor(lsum, 32);
    {
        if (hi == 0) wsf[r32] = 1.0f / lsum;
        asm volatile("s_waitcnt lgkmcnt(0)" ::: "memory");
        float ss[16];
#pragma unroll
        for (int g = 0; g < 4; ++g) { const f32x4 f = *(const LAS f32x4*)(wsf + 8 * g + 4 * hi);
#pragma unroll
            for (int j = 0; j < 4; ++j) { const float il = j == 0 ? f.x : j == 1 ? f.y : j == 2 ? f.z : f.w; float a = 0.f;
#pragma unroll
                for (int d = 0; d < 4; ++d) { o[d][4 * g + j] *= il; a += o[d][4 * g + j] * o[d][4 * g + j]; }
                ss[4 * g + j] = a; } }
#pragma unroll
        for (int r = 0; r < 16; ++r) {
#pragma unroll
            for (int of = 1; of < 32; of <<= 1) ss[r] += __shfl_xor(ss[r], of);
            ss[r] = rsqrtf(ss[r] * (1.f / 128.f) + EPS);
        }
        float gv[4];
#pragma unroll
        for (int d = 0; d < 4; ++d) gv[d] = g_attn[h * DV + d * 32 + r32];
#pragma unroll
        for (int r = 0; r < 16; ++r) { bf16* dst = mixed + (size_t)(m0 + crow(r, hi)) * D + DCONV + h * DV + r32;
#pragma unroll
            for (int d = 0; d < 4; ++d) dst[d * 32] = f2bf(o[d][r] * ss[r] * gv[d]); }
    }
    __syncthreads();
}
}

struct Ctx { int lane, wave, tid, gw, NGW, wg, G; LAS unsigned char* lds; };

template <int MODE> __device__ __forceinline__ int drow_of(int n) {
    if (MODE == 1) { const int bj = n / 2048, c = n % 2048; return 256 * (c / 128) + 128 * bj + (c % 128); }
    if (MODE == 2) { const int k64 = n >> 6, w = n & 63; if (k64 % 3 != 2) return n; const int part = w >> 5, i = w & 31; return (k64 << 6) + 32 * (i >> 4) + 8 * ((i & 15) >> 2) + 4 * part + (i & 3); }
    if (MODE == 3) { return (n & 128) ? -1 : (n >> 8) * 128 + (n & 127); }
    if (MODE == 4) { return (n & 128) ? (n >> 8) * 128 + (n & 127) : -1; }
    return n;
}
__device__ __forceinline__ void transpose_load(const float* W, int K, int N, int item, int lane, f32x4 (&v)[8]) {
    const int nblk = N / 32, kb = item / nblk, nb = item % nblk, k0 = 64 * kb, n0 = 32 * nb;
#pragma unroll
    for (int i = 0; i < 8; ++i) v[i] = __builtin_nontemporal_load((const f32x4*)(W + (size_t)(k0 + i * 8 + (lane >> 3)) * N + n0 + (lane & 7) * 4));
}
template <int MODE, bool FP8OUT>
__device__ __forceinline__ void transpose_store(const f32x4 (&v)[8], int K, int N, void* WTv, LAS float* scr, int item, int lane) {
    const int nblk = N / 32, kb = item / nblk, nb = item % nblk, k0 = 64 * kb, n0 = 32 * nb;
#pragma unroll
    for (int i = 0; i < 8; ++i) { LAS float* d = scr + (i * 8 + (lane >> 3)) * 33 + (lane & 7) * 4; d[0] = v[i].x; d[1] = v[i].y; d[2] = v[i].z; d[3] = v[i].w; }
    LDS_WAIT(); asm volatile("" ::: "memory");
    const int c = lane & 7;
#pragma unroll
    for (int j = 0; j < 4; ++j) { const int n = (lane >> 3) + 8 * j; const LAS float* s = scr + (8 * c) * 33 + n;
        const int dr = drow_of<MODE>(n0 + n);
        if (FP8OUT) {
            int w0 = 0, w1 = 0;
            w0 = __builtin_amdgcn_cvt_pk_fp8_f32(s[0 * 33] * WSCALE, s[1 * 33] * WSCALE, w0, false); w0 = __builtin_amdgcn_cvt_pk_fp8_f32(s[2 * 33] * WSCALE, s[3 * 33] * WSCALE, w0, true);
            w1 = __builtin_amdgcn_cvt_pk_fp8_f32(s[4 * 33] * WSCALE, s[5 * 33] * WSCALE, w1, false); w1 = __builtin_amdgcn_cvt_pk_fp8_f32(s[6 * 33] * WSCALE, s[7 * 33] * WSCALE, w1, true);
            if (dr >= 0) *(u32x2*)((unsigned char*)WTv + (size_t)dr * K + k0 + 8 * c) = (u32x2){(unsigned)w0, (unsigned)w1};
        } else {
            u32x4 o; o.x = pg8::cvt_pk_bf16(s[0 * 33], s[1 * 33]); o.y = pg8::cvt_pk_bf16(s[2 * 33], s[3 * 33]); o.z = pg8::cvt_pk_bf16(s[4 * 33], s[5 * 33]); o.w = pg8::cvt_pk_bf16(s[6 * 33], s[7 * 33]);
            if (dr >= 0) *(u32x4*)((bf16*)WTv + (size_t)dr * K + k0 + 8 * c) = o;
        } }
    LDS_WAIT(); asm volatile("" ::: "memory");
}
template <int MODE, bool FP8OUT>
__device__ __forceinline__ void transpose_item(const Ctx& c, const float* W, int K, int N, void* WT, int item) {
    LAS float* scr = (LAS float*)(c.lds + c.wave * 16384);
    f32x4 v[8]; transpose_load(W, K, N, item, c.lane, v);
    transpose_store<MODE, FP8OUT>(v, K, N, WT, scr, item, c.lane);
}
__device__ __forceinline__ void transpose_item_kv(const Ctx& c, const float* W, bf16* Wkv, bf16* WkvK, bf16* WkvV, int item) {
    LAS float* scr = (LAS float*)(c.lds + c.wave * 16384);
    f32x4 v[8]; transpose_load(W, KVL, 2048, item, c.lane, v);
    transpose_store<0, false>(v, KVL, 2048, Wkv, scr, item, c.lane);
    transpose_store<3, false>(v, KVL, 2048, WkvK, scr, item, c.lane);
    transpose_store<4, false>(v, KVL, 2048, WkvV, scr, item, c.lane);
}

constexpr int CONV_SCR = 128 * 33 * 4;
__device__ __forceinline__ void t128_load(const float* W, int N, int item, int lane, f32x4 (&v)[16]) {
    const int nblk = N / 32, kb = item / nblk, nb = item % nblk, k0 = 128 * kb, n0 = 32 * nb;
#pragma unroll
    for (int i = 0; i < 16; ++i) v[i] = __builtin_nontemporal_load((const f32x4*)(W + (size_t)(k0 + i * 8 + (lane >> 3)) * N + n0 + (lane & 7) * 4));
}
template <int MODE>
__device__ __forceinline__ void t128_store(const Ctx& c, const f32x4 (&v)[16], int K, int N, unsigned char* WT, int item) {
    LAS float* scr = (LAS float*)(c.lds + c.wave * CONV_SCR);
    const int nblk = N / 32, kb = item / nblk, nb = item % nblk, k0 = 128 * kb, n0 = 32 * nb, lane = c.lane;
#pragma unroll
    for (int i = 0; i < 16; ++i) { LAS float* d = scr + (i * 8 + (lane >> 3)) * 33 + (lane & 7) * 4; d[0] = v[i].x; d[1] = v[i].y; d[2] = v[i].z; d[3] = v[i].w; }
    LDS_WAIT(); asm volatile("" ::: "memory");
    const int cc = lane & 7;
#pragma unroll
    for (int j = 0; j < 4; ++j) { const int n = (lane >> 3) + 8 * j; const LAS float* s = scr + (16 * cc) * 33 + n; int w[4];
#pragma unroll
        for (int q = 0; q < 4; ++q) { int t = 0; t = __builtin_amdgcn_cvt_pk_fp8_f32(s[(4 * q) * 33] * WSCALE, s[(4 * q + 1) * 33] * WSCALE, t, false);
            t = __builtin_amdgcn_cvt_pk_fp8_f32(s[(4 * q + 2) * 33] * WSCALE, s[(4 * q + 3) * 33] * WSCALE, t, true); w[q] = t; }
        const int dr = drow_of<MODE>(n0 + n);
        __builtin_nontemporal_store((u32x4){(unsigned)w[0], (unsigned)w[1], (unsigned)w[2], (unsigned)w[3]}, (u32x4*)(WT + (size_t)dr * K + k0 + 16 * cc)); }
    LDS_WAIT(); asm volatile("" ::: "memory");
}
static_assert(8 * CONV_SCR <= MISC_OFF, "conversion tiles vs LDS control words");

constexpr int I_GU = NE * (D / 128) * (4096 / 32), I_D = NE * (DFF / 128) * (D / 32);
constexpr int CONV_TOTAL = I_D + I_GU, CONV_SLOTS = 1024;
constexpr int STOPW_OFF = MISC_OFF + 1536;
constexpr unsigned STOP_AT = 96u;
__device__ __forceinline__ unsigned stop_poll(const Ctx& c, const unsigned* p) {
    volatile LAS unsigned* w = (volatile LAS unsigned*)(c.lds + STOPW_OFF);
    if (c.wave == 0) { const unsigned v = __hip_atomic_load(p, __ATOMIC_RELAXED, __HIP_MEMORY_SCOPE_AGENT); if (c.lane == 0) *w = v; return (unsigned)__builtin_amdgcn_readfirstlane((int)v); }
    return *w;
}
__device__ __forceinline__ void cs_load(int it, int lane, const float* w_gu, const float* w_d, f32x4 (&v)[16]) {
    if (it < I_D) { constexpr int per = (DFF / 128) * (D / 32); t128_load(w_d + (size_t)(it / per) * DFF * D, D, it % per, lane, v); }
    else { const int r = it - I_D; constexpr int per = (D / 128) * (4096 / 32); t128_load(w_gu + (size_t)(r / per) * D * 4096, 4096, r % per, lane, v); }
}
__device__ __forceinline__ void cs_store(const Ctx& c, int it, const f32x4 (&v)[16], unsigned char* Wgu, unsigned char* Wd) {
    if (it < I_D) { constexpr int per = (DFF / 128) * (D / 32); t128_store<0>(c, v, DFF, D, Wd + (size_t)(it / per) * D * DFF, it % per); }
    else { const int r = it - I_D; constexpr int per = (D / 128) * (4096 / 32); t128_store<1>(c, v, D, 4096, Wgu + (size_t)(r / per) * 4096 * D, r % per); }
}
__device__ __forceinline__ int conv_stream(const Ctx& c, int j, int first, int step, const unsigned* stop, const float* w_gu, const float* w_d, unsigned char* Wgu, unsigned char* Wd) {
    int i = first;
    if (j + CONV_SLOTS * i >= CONV_TOTAL) return i;
    if (stop && stop_poll(c, stop) >= STOP_AT) return i;
    f32x4 va[16], vb[16];
    cs_load(j + CONV_SLOTS * i, c.lane, w_gu, w_d, va);
    for (;;) {
        { const int i2 = i + step; const bool more = j + CONV_SLOTS * i2 < CONV_TOTAL && !(stop && stop_poll(c, stop) >= STOP_AT);
          cs_load(j + CONV_SLOTS * (more ? i2 : i), c.lane, w_gu, w_d, vb);
          cs_store(c, j + CONV_SLOTS * i, va, Wgu, Wd); i = i2; if (!more) break; }
        { const int i2 = i + step; const bool more = j + CONV_SLOTS * i2 < CONV_TOTAL && !(stop && stop_poll(c, stop) >= STOP_AT);
          cs_load(j + CONV_SLOTS * (more ? i2 : i), c.lane, w_gu, w_d, va);
          cs_store(c, j + CONV_SLOTS * i, vb, Wgu, Wd); i = i2; if (!more) break; }
    }
    return i;
}

__device__ __forceinline__ void norm1_rows2(int R0, int lane, const float* x, const float* meta, const float* g, bf16* hn) {
    f32x4 v[2][8]; float ss[2] = {0.f, 0.f};
#pragma unroll
    for (int q = 0; q < 2; ++q) { const int R = R0 + q; const float* src = R < M ? x + (size_t)R * D : meta + (size_t)(R - M) * D;
#pragma unroll
        for (int j = 0; j < 8; ++j) v[q][j] = __builtin_nontemporal_load((const f32x4*)(src + j * 256 + lane * 4)); }
#pragma unroll
    for (int q = 0; q < 2; ++q)
#pragma unroll
        for (int j = 0; j < 8; ++j) ss[q] += v[q][j].x * v[q][j].x + v[q][j].y * v[q][j].y + v[q][j].z * v[q][j].z + v[q][j].w * v[q][j].w;
#pragma unroll
    for (int q = 0; q < 2; ++q) { const float rstd = rsqrtf(wave_sum(ss[q]) * (1.f / D) + EPS);
#pragma unroll
        for (int j = 0; j < 8; ++j) { const f32x4 gg = *(const f32x4*)(g + j * 256 + lane * 4);
            u32x2 o; o.x = pk2(v[q][j].x * rstd * gg.x, v[q][j].y * rstd * gg.y); o.y = pk2(v[q][j].z * rstd * gg.z, v[q][j].w * rstd * gg.w);
            *(u32x2*)(hn + (size_t)(R0 + q) * D + j * 256 + lane * 4) = o; } }
}
constexpr int META_WGS = DIN / 64;
__device__ __forceinline__ void meta_proj(const Ctx& c, const float* __restrict__ meta, const float* __restrict__ g_mix, const float* __restrict__ w_in, bf16* __restrict__ proj) {
    LAS float* hmT = (LAS float*)c.lds;
    {
        f32x4 v[2][8];
#pragma unroll
        for (int q = 0; q < 2; ++q)
#pragma unroll
            for (int j = 0; j < 8; ++j) v[q][j] = *(const f32x4*)(meta + (size_t)(c.wave + 8 * q) * D + j * 256 + c.lane * 4);
#pragma unroll
        for (int q = 0; q < 2; ++q) { const int r = c.wave + 8 * q; float ss = 0.f;
#pragma unroll
            for (int j = 0; j < 8; ++j) ss += v[q][j].x * v[q][j].x + v[q][j].y * v[q][j].y + v[q][j].z * v[q][j].z + v[q][j].w * v[q][j].w;
            const float rstd = rsqrtf(wave_sum(ss) * (1.f / D) + EPS);
#pragma unroll
            for (int j = 0; j < 8; ++j) { const int k = j * 256 + c.lane * 4; const f32x4 gg = *(const f32x4*)(g_mix + k);
                hmT[(k + 0) * 16 + r] = v[q][j].x * rstd * gg.x; hmT[(k + 1) * 16 + r] = v[q][j].y * rstd * gg.y; hmT[(k + 2) * 16 + r] = v[q][j].z * rstd * gg.z; hmT[(k + 3) * 16 + r] = v[q][j].w * rstd * gg.w; } }
    }
    const int col = c.lane, ks = c.wave, n = c.wg * 64 + col;
    float acc[16];
#pragma unroll
    for (int r = 0; r < 16; ++r) acc[r] = 0.f;
    __syncthreads();
#pragma unroll 1
    for (int kb = 0; kb < 4; ++kb) {
        float w[64];
#pragma unroll
        for (int j = 0; j < 64; ++j) w[j] = __builtin_nontemporal_load(w_in + (size_t)(ks * 256 + kb * 64 + j) * DIN + n);
#pragma unroll
        for (int j = 0; j < 64; ++j) { const int k = ks * 256 + kb * 64 + j;
#pragma unroll
            for (int q = 0; q < 4; ++q) { const f32x4 h = *(const LAS f32x4*)(hmT + k * 16 + 4 * q);
                acc[4 * q + 0] += h.x * w[j]; acc[4 * q + 1] += h.y * w[j]; acc[4 * q + 2] += h.z * w[j]; acc[4 * q + 3] += h.w * w[j]; } }
    }
    __syncthreads();
    LAS float* part = (LAS float*)c.lds;
#pragma unroll
    for (int r = 0; r < 16; ++r) part[(ks * 16 + r) * 64 + col] = acc[r];
    __syncthreads();
    for (int o = c.tid; o < 16 * 64; o += NWAVES * 64) { const int r = o >> 6, cc = o & 63; float s = 0.f;
#pragma unroll
        for (int q = 0; q < 8; ++q) s += part[(q * 16 + r) * 64 + cc];
        proj[(size_t)(M + r) * DINP + c.wg * 64 + cc] = f2bf(s); }
    __syncthreads();
}

struct EpiKV {
    bf16* kn; bf16* vv; int roff;
    __device__ void operator()(int r, int n, float v) const {
        const int R = r + roff; if (R < M || R >= MR) return;
        const int h = n >> 8, part = (n >> 7) & 1, d = n & 127, pos = R - M; const bf16 o = f2bf(v);
        for (int b = 0; b < NB; ++b) {
            if (part) vv[((size_t)(b * NH + h) * 128 + d) * LP + pos] = o;
            else kn[((size_t)(b * LP + pos) * NH + h) * 128 + d] = o;
        }
    }
};
template <class Epi>
__device__ __forceinline__ void gemm_simple(const Ctx& c, const bf16* __restrict__ A, int lda, const bf16* __restrict__ Bt, int ldb, int K, int nMt, int nNt, const Epi& epi) {
    const int r = c.lane & 15, q = c.lane >> 4;
    for (int wt = c.gw; wt < nMt * nNt; wt += c.NGW) {
        const int m0 = (wt / nNt) * 32, n0 = (wt % nNt) * 32;
        f32x4 acc[2][2];
#pragma unroll
        for (int i = 0; i < 2; ++i)
#pragma unroll
            for (int j = 0; j < 2; ++j) acc[i][j] = (f32x4){0.f, 0.f, 0.f, 0.f};
        const bf16* a0 = A + (size_t)(m0 + r) * lda + 8 * q; const bf16* b0 = Bt + (size_t)(n0 + r) * ldb + 8 * q;
#pragma unroll 2
        for (int k0 = 0; k0 < K; k0 += 32) {
            bf16x8 a[2], b[2];
#pragma unroll
            for (int i = 0; i < 2; ++i) { a[i] = *(const bf16x8*)(a0 + (size_t)i * 16 * lda + k0); b[i] = *(const bf16x8*)(b0 + (size_t)i * 16 * ldb + k0); }
#pragma unroll
            for (int i = 0; i < 2; ++i)
#pragma unroll
                for (int j = 0; j < 2; ++j) acc[i][j] = __builtin_amdgcn_mfma_f32_16x16x32_bf16(a[i], b[j], acc[i][j], 0, 0, 0);
        }
#pragma unroll
        for (int i = 0; i < 2; ++i)
#pragma unroll
            for (int j = 0; j < 2; ++j)
#pragma unroll
                for (int t = 0; t < 4; ++t) epi(m0 + i * 16 + q * 4 + t, n0 + j * 16 + r, acc[i][j][t]);
    }
}

__device__ __forceinline__ float inv_freq(int i) { return powf(10000.0f, -(float)i / 32.0f); }

__device__ __forceinline__ void postproj_row(int R, int lane, const bf16* __restrict__ proj, const float* __restrict__ conv_w, const float* __restrict__ g_conv,
                                             const float* __restrict__ g_q, const float* __restrict__ g_kv,
                                             bf16* __restrict__ mixed, bf16* __restrict__ qn, bf16* __restrict__ kvn, bf16* __restrict__ kpe, const float* __restrict__ cosT, const float* __restrict__ sinT) {
    const bf16* pr = proj + (size_t)R * DINP;
    const bool meta = R >= M; const int b = meta ? 0 : R / S, t = meta ? 0 : R % S, pos = meta ? R - M : t + NMETA;
    {
        const u32x2 w = *(const u32x2*)(pr + O_KV + lane * 4);
        float f[4] = {__uint_as_float(w.x << 16), __uint_as_float(w.x & 0xffff0000u), __uint_as_float(w.y << 16), __uint_as_float(w.y & 0xffff0000u)};
        const float ss = wave_sum(f[0] * f[0] + f[1] * f[1] + f[2] * f[2] + f[3] * f[3]);
        const float rstd = rsqrtf(ss * (1.f / KVL) + EPS);
        const f32x4 g = *(const f32x4*)(g_kv + lane * 4);
        u32x2 o; o.x = pk2(f[0] * rstd * g.x, f[1] * rstd * g.y); o.y = pk2(f[2] * rstd * g.z, f[3] * rstd * g.w);
        *(u32x2*)(kvn + (size_t)R * KVL + lane * 4) = o;
    }
    if (lane < 32) {
        const float x1 = bf2f(pr[O_R + lane]), x2 = bf2f(pr[O_R + 32 + lane]);
        const float cs = cosT[pos * 32 + lane], sn = sinT[pos * 32 + lane];
        const bf16 o1 = f2bf(x1 * cs - x2 * sn), o2 = f2bf(x1 * sn + x2 * cs);
        if (!meta) { bf16* d = kpe + (size_t)(b * LP + pos) * ROPE; d[lane] = o1; d[32 + lane] = o2; }
        else { bf16* d0 = kpe + (size_t)(0 * LP + pos) * ROPE; bf16* d1 = kpe + (size_t)(1 * LP + pos) * ROPE; d0[lane] = o1; d0[32 + lane] = o2; d1[lane] = o1; d1[32 + lane] = o2; }
    }
    if (meta) return;
    {
        float f[8]; unpack8(*(const u32x4*)(pr + O_Q + lane * 8), f);
        float ss = 0.f;
#pragma unroll
        for (int i = 0; i < 8; ++i) ss += f[i] * f[i];
        const float rstd = rsqrtf(wave_sum(ss) * (1.f / QL) + EPS);
        const f32x4 g0 = *(const f32x4*)(g_q + lane * 8), g1 = *(const f32x4*)(g_q + lane * 8 + 4);
        u32x4 o; o.x = pk2(f[0] * rstd * g0.x, f[1] * rstd * g0.y); o.y = pk2(f[2] * rstd * g0.z, f[3] * rstd * g0.w);
        o.z = pk2(f[4] * rstd * g1.x, f[5] * rstd * g1.y); o.w = pk2(f[6] * rstd * g1.z, f[7] * rstd * g1.w);
        *(u32x4*)(qn + (size_t)R * QL + lane * 8) = o;
    }
    {
        const int r1 = (t >= 1) ? R - 1 : M + 15, r2 = (t >= 2) ? R - 2 : (t == 1 ? M + 15 : M + 14);
        const bf16* p1 = proj + (size_t)r1 * DINP; const bf16* p2 = proj + (size_t)r2 * DINP;
        const int c0 = lane * 16;
        float v[16]; float ss = 0.f;
#pragma unroll
        for (int hh = 0; hh < 2; ++hh) {
            const int c = c0 + hh * 8;
            float bg[8], cg0[8], ui0[8], cg1[8], ui1[8], cg2[8], ui2[8];
            unpack8(*(const u32x4*)(pr + c), bg); unpack8(*(const u32x4*)(pr + O_C + c), cg0); unpack8(*(const u32x4*)(pr + O_U + c), ui0);
            unpack8(*(const u32x4*)(p1 + O_C + c), cg1); unpack8(*(const u32x4*)(p1 + O_U + c), ui1);
            unpack8(*(const u32x4*)(p2 + O_C + c), cg2); unpack8(*(const u32x4*)(p2 + O_U + c), ui2);
#pragma unroll
            for (int i = 0; i < 8; ++i) {
                const float y = conv_w[2 * DCONV + c + i] * (cg0[i] * ui0[i]) + conv_w[1 * DCONV + c + i] * (cg1[i] * ui1[i]) + conv_w[0 * DCONV + c + i] * (cg2[i] * ui2[i]);
                const float o = bg[i] * y; v[hh * 8 + i] = o; ss += o * o;
            }
        }
        ss += __shfl_xor(ss, 1); ss += __shfl_xor(ss, 2);
        const float rstd = rsqrtf(ss * (1.f / 64.f) + EPS);
#pragma unroll
        for (int hh = 0; hh < 2; ++hh) {
            const int c = c0 + hh * 8;
            const f32x4 g0 = *(const f32x4*)(g_conv + c), g1 = *(const f32x4*)(g_conv + c + 4);
            u32x4 o; o.x = pk2(v[hh * 8 + 0] * rstd * g0.x, v[hh * 8 + 1] * rstd * g0.y); o.y = pk2(v[hh * 8 + 2] * rstd * g0.z, v[hh * 8 + 3] * rstd * g0.w);
            o.z = pk2(v[hh * 8 + 4] * rstd * g1.x, v[hh * 8 + 5] * rstd * g1.y); o.w = pk2(v[hh * 8 + 6] * rstd * g1.z, v[hh * 8 + 7] * rstd * g1.w);
            *(u32x4*)(mixed + (size_t)R * D + c) = o;
        }
    }
}

constexpr int RT_OFF = 0;
__device__ __forceinline__ void router_block(const Ctx& c, int blk, const float* __restrict__ h1, const float* __restrict__ g_ffn, const float* __restrict__ Wrt, const float* __restrict__ b_r,
                                             bf16* __restrict__ xn, unsigned* __restrict__ cnt, int* __restrict__ rowtok, int* __restrict__ tok_e, int* __restrict__ tok_p, float* __restrict__ gate) {
    LAS float* part = (LAS float*)(c.lds + RT_OFF); LAS float* srstd = part + 2 * 32 * 32;
    const int lane = c.lane, m0 = blk * 32;
#pragma unroll 1
    for (int r = 0; r < 4; ++r) {
        const int m = m0 + c.wave * 4 + r; const float* src = h1 + (size_t)m * D;
        f32x4 v[8]; float ss = 0.f;
#pragma unroll
        for (int j = 0; j < 8; ++j) { v[j] = *(const f32x4*)(src + j * 256 + lane * 4); ss += v[j].x * v[j].x + v[j].y * v[j].y + v[j].z * v[j].z + v[j].w * v[j].w; }
        const float rstd = rsqrtf(wave_sum(ss) * (1.f / D) + EPS);
#pragma unroll
        for (int j = 0; j < 8; ++j) { const f32x4 gg = *(const f32x4*)(g_ffn + j * 256 + lane * 4);
            int w = 0; w = __builtin_amdgcn_cvt_pk_fp8_f32(v[j].x * rstd * gg.x, v[j].y * rstd * gg.y, w, false); w = __builtin_amdgcn_cvt_pk_fp8_f32(v[j].z * rstd * gg.z, v[j].w * rstd * gg.w, w, true);
            *(int*)((unsigned char*)xn + (size_t)m * D + j * 256 + lane * 4) = w; }
        if (lane == 0) srstd[c.wave * 4 + r] = rstd;
    }
    {
        const int ti = c.wave & 3, rt = ti >> 1, et = ti & 1, kh = c.wave >> 2, row = lane & 15, kq = lane >> 4;
        const float* ap = h1 + (size_t)(m0 + rt * 16 + row) * D + kh * 1024 + 4 * kq;
        const float* bp = Wrt + (size_t)(et * 16 + row) * D + kh * 1024 + 4 * kq;
        f32x4 acc = (f32x4){0.f, 0.f, 0.f, 0.f};
#pragma unroll 4
        for (int j = 0; j < 64; ++j) {
            const f32x4 a4 = *(const f32x4*)(ap + 16 * j), b4 = *(const f32x4*)(bp + 16 * j);
            acc = __builtin_amdgcn_mfma_f32_16x16x4f32(a4.x, b4.x, acc, 0, 0, 0);
            acc = __builtin_amdgcn_mfma_f32_16x16x4f32(a4.y, b4.y, acc, 0, 0, 0);
            acc = __builtin_amdgcn_mfma_f32_16x16x4f32(a4.z, b4.z, acc, 0, 0, 0);
            acc = __builtin_amdgcn_mfma_f32_16x16x4f32(a4.w, b4.w, acc, 0, 0, 0);
        }
#pragma unroll
        for (int t = 0; t < 4; ++t) part[(kh * 32 + rt * 16 + kq * 4 + t) * 32 + et * 16 + row] = acc[t];
    }
    __syncthreads();
    LAS unsigned* lhist = (LAS unsigned*)(srstd + 32); LAS unsigned* lbase = lhist + 32;
    if (c.tid < 32) lhist[c.tid] = 0u;
    __syncthreads();
    int se[4][4]; unsigned sr[4][4]; float sg[4][4];
#pragma unroll
    for (int r = 0; r < 4; ++r) {
        const int lr = c.wave * 4 + r;
        float logit = -INFINITY;
        if (lane < NE) logit = (part[lr * 32 + lane] + part[(32 + lr) * 32 + lane]) * srstd[lr] + b_r[lane];
        float tv[4];
#pragma unroll
        for (int k = 0; k < 4; ++k) {
            const float mxv = wave_max(logit);
            const unsigned long long mask = __ballot(logit == mxv);
            const int idx = __ffsll((long long)mask) - 1;
            tv[k] = mxv; se[r][k] = idx;
            if (lane == idx) logit = -INFINITY;
        }
        float es = 0.f;
#pragma unroll
        for (int k = 0; k < 4; ++k) { sg[r][k] = expf(tv[k] - tv[0]); es += sg[r][k]; }
        const float inv = 1.0f / es;
#pragma unroll
        for (int k = 0; k < 4; ++k) { sg[r][k] *= inv; sr[r][k] = 0u; if (lane == 0) sr[r][k] = __hip_atomic_fetch_add(&lhist[se[r][k]], 1u, __ATOMIC_RELAXED, __HIP_MEMORY_SCOPE_WORKGROUP); }
    }
    __syncthreads();
    if (c.tid < NE) lbase[c.tid] = atomicAdd(&cnt[c.tid], lhist[c.tid]);
    __syncthreads();
    if (lane == 0) {
#pragma unroll
        for (int r = 0; r < 4; ++r) { const int m = m0 + c.wave * 4 + r;
#pragma unroll
            for (int k = 0; k < 4; ++k) { const int e = se[r][k]; const unsigned p = lbase[e] + sr[r][k];
                rowtok[e * M + p] = m; tok_e[m * 4 + k] = e; tok_p[m * 4 + k] = (int)p; gate[m * 4 + k] = sg[r][k]; } }
    }
    __syncthreads();
}

__device__ __forceinline__ void combine_row(int m, int lane, const float* __restrict__ h1, const bf16* __restrict__ y, const unsigned* __restrict__ cnt, const int* __restrict__ tok_e, const int* __restrict__ tok_p,
                                            const float* __restrict__ gate, const float* __restrict__ g_final, float* __restrict__ out) {
    size_t yrow[4]; float gk[4];
#pragma unroll
    for (int k = 0; k < 4; ++k) {
        const int e = tok_e[m * 4 + k]; int off = 0;
        for (int e2 = 0; e2 < e; ++e2) off += ((int)cnt[e2] + 255) / 256 * 256;
        yrow[k] = (size_t)(off + tok_p[m * 4 + k]) * D; gk[k] = gate[m * 4 + k];
    }
    f32x4 v[8]; float ss = 0.f;
#pragma unroll
    for (int j = 0; j < 8; ++j) {
        const int idx = j * 256 + lane * 4;
        f32x4 a = *(const f32x4*)(h1 + (size_t)m * D + idx);
#pragma unroll
        for (int k = 0; k < 4; ++k) { const u32x2 w = *(const u32x2*)(y + yrow[k] + idx);
            a.x += gk[k] * __uint_as_float(w.x << 16); a.y += gk[k] * __uint_as_float(w.x & 0xffff0000u); a.z += gk[k] * __uint_as_float(w.y << 16); a.w += gk[k] * __uint_as_float(w.y & 0xffff0000u); }
        v[j] = a; ss += a.x * a.x + a.y * a.y + a.z * a.z + a.w * a.w;
    }
    const float rstd = rsqrtf(wave_sum(ss) * (1.f / D) + EPS);
#pragma unroll
    for (int j = 0; j < 8; ++j) { const int idx = j * 256 + lane * 4; const f32x4 gg = *(const f32x4*)(g_final + idx);
        *(f32x4*)(out + (size_t)m * D + idx) = (f32x4){v[j].x * rstd * gg.x, v[j].y * rstd * gg.y, v[j].z * rstd * gg.z, v[j].w * rstd * gg.w}; }
}


constexpr int TAB_OFF = MISC_OFF + 128;
__device__ __forceinline__ const LAS int* build_expert_table(const Ctx& c, const unsigned* cnt) {
    LAS int* tab = (LAS int*)(c.lds + TAB_OFF);
    if (c.tid < 64) {
        const int n = c.lane < NE ? (int)cnt[c.lane] : 0; int t = (n + 255) / 256, incl = t;
#pragma unroll
        for (int o = 1; o < 32; o <<= 1) { const int v = __shfl_up(incl, o); if (c.lane >= o) incl += v; }
        if (c.lane < NE) tab[c.lane + 1] = incl;
        if (c.lane == 0) tab[0] = 0;
    }
    __syncthreads();
    return tab;
}

__device__ __forceinline__ Ctx make_ctx() {
    extern __shared__ __attribute__((aligned(16))) unsigned char lds_raw[];
    Ctx c; int t = threadIdx.x; asm volatile("" : "+v"(t));
    c.lds = (LAS unsigned char*)lds_raw; c.tid = t; c.lane = t & 63; c.wave = __builtin_amdgcn_readfirstlane(t >> 6);
    c.G = gridDim.x; c.wg = blockIdx.x; c.gw = c.wg * NWAVES + c.wave; c.NGW = c.G * NWAVES;
    return c;
}
constexpr bool SPLIT_P1 = true, SPLIT_P3 = true;
struct Args { const float* in[20]; float* out; unsigned char* ws; int ph_lo, ph_hi; };
#define KA() ({ const __attribute__((address_space(4))) Args* _p = (const __attribute__((address_space(4))) Args*)__builtin_amdgcn_kernarg_segment_ptr(); asm volatile("" : "+s"(_p)); _p; })
#define WSP(T, off) ((T*)(ws + (off)))
#define PHASE_PTRS \
    const auto ka = KA(); unsigned char* const ws = ka->ws; unsigned* const cnt = (unsigned*)(ws + WS_CTL) + CW_CNT; (void)cnt; \
    bf16* const Win = WSP(bf16, WS_WIN); bf16* const Wq = WSP(bf16, WS_WQ); bf16* const Wkv = WSP(bf16, WS_WKV); bf16* const Wout = WSP(bf16, WS_WOUT); bf16* const Wgu = WSP(bf16, WS_WGU); bf16* const Wd = WSP(bf16, WS_WD); \
    bf16* const hn = WSP(bf16, WS_HN); bf16* const proj = WSP(bf16, WS_PROJ); bf16* const mixed = WSP(bf16, WS_MIXED); bf16* const qn = WSP(bf16, WS_QN); bf16* const kvn = WSP(bf16, WS_KVN); \
    bf16* const WkvK = WSP(bf16, WS_WKVK); bf16* const WkvV = WSP(bf16, WS_WKVV); float* const cosT = WSP(float, WS_COS); float* const sinT = WSP(float, WS_SIN); float* const Wrt = WSP(float, WS_WRT); (void)Wrt; bf16* const Q = WSP(bf16, WS_Q); \
    bf16* const Kn = WSP(bf16, WS_KN); bf16* const V = WSP(bf16, WS_V); bf16* const Kpe = WSP(bf16, WS_KPE); float* const h1 = WSP(float, WS_H1); bf16* const xn = WSP(bf16, WS_XN); \
    int* const tok_e = WSP(int, WS_TOKE); int* const tok_p = WSP(int, WS_TOKP); float* const gate = WSP(float, WS_GATE); int* const rowtok = WSP(int, WS_ROWTOK); bf16* const act = WSP(bf16, WS_ACT); bf16* const y = WSP(bf16, WS_Y); \
    (void)Win; (void)Wq; (void)Wkv; (void)Wout; (void)Wgu; (void)Wd; (void)hn; (void)proj; (void)mixed; (void)qn; (void)kvn; (void)WkvK; (void)WkvV; (void)cosT; (void)sinT; (void)Q; (void)Kn; (void)V; (void)Kpe; \
    (void)h1; (void)xn; (void)tok_e; (void)tok_p; (void)gate; (void)rowtok; (void)act; (void)y
#define INP(k) (ka->in[k])
__device__ __forceinline__ void phase0() { const Ctx c = make_ctx(); PHASE_PTRS;
        const bool splitp0 = c.G >= 2 * META_WGS;
        if (c.wg < META_WGS || !splitp0) { for (int j = c.wg; j < META_WGS; j += (splitp0 ? META_WGS : c.G)) { Ctx cj = c; cj.wg = j; meta_proj(cj, INP(1), INP(2), INP(3), proj); } if (splitp0) return; }
        const int lgw = splitp0 ? c.gw - META_WGS * NWAVES : c.gw, lngw = splitp0 ? c.NGW - META_WGS * NWAVES : c.NGW;
        constexpr int I_IN = (D / 64) * (DIN / 32), I_OUT = (D / 64) * (D / 32), I_Q = (QL / 64) * (1536 / 32), I_KV = (KVL / 64) * (2048 / 32);
        constexpr int I_ROWS = MR / 2, I_ZERO = (DINP - DIN) * D / 8 / 64, I_ROPE = (S + NMETA) * 32 / 64, I_WRT = NE * D / 64;
        constexpr int E1 = 0, E2 = E1 + I_IN, E3 = E2 + I_OUT, E4 = E3 + I_Q, E5 = E4 + I_KV, E6 = E5 + I_ROWS, E7 = E6 + I_ZERO, E8 = E7 + I_ROPE, E9 = E8 + I_WRT;
        for (int it = lgw; it < E9; it += lngw) {
            if (false) {}
            else if (it < E2) transpose_item<0, false>(c, INP(3), D, DIN, Win, it - E1);
            else if (it < E3) transpose_item<0, false>(c, INP(11), D, D, Wout, it - E2);
            else if (it < E4) transpose_item<2, false>(c, INP(6), QL, 1536, Wq, it - E3);
            else if (it < E5) transpose_item_kv(c, INP(8), Wkv, WkvK, WkvV, it - E4);
            else if (it < E6) { const int R = 2 * (it - E5); norm1_rows2(R, c.lane, INP(0), INP(1), INP(2), hn); }
            else if (it < E7) { const int i = (it - E6) * 64 + c.lane; ((u32x4*)(Win + (size_t)DIN * D))[i] = (u32x4){0u, 0u, 0u, 0u}; }
            else if (it < E8) { const int i = (it - E7) * 64 + c.lane; const float ang = (float)(i >> 5) * inv_freq(i & 31); cosT[i] = cosf(ang); sinT[i] = sinf(ang); }
            else { const int i = (it - E8) * 64 + c.lane; const int e = i >> 11, k = i & (D - 1); Wrt[i] = INP(12)[k] * INP(13)[k * NE + e]; }
        }
    }
__device__ __forceinline__ void phase1() { const Ctx c = make_ctx(); PHASE_PTRS;
        unsigned* ctl = (unsigned*)(ws + WS_CTL);
        if (c.G != 256 || !SPLIT_P1) {
            pg8::Gemm g{hn, D * 2}; pg8::PlainSched Sc; Sc.init(Win, M, DINP, D, c.G, c.wg);
            pg8::gemm_phase<pg8::EpiStoreBf16, pg8::PlainSched, true>(c.lds, g, Sc, pg8::EpiStoreBf16{proj, DINP});
        } else if ((c.wg >> 3) < 16) {
            pg8::Gemm g{hn, D * 2}; pg8::PlainSched Sc; Sc.init(Win, M, DINP, D, 128, (c.wg >> 3) * 8 + (c.wg & 7));
            pg8::gemm_phase<pg8::EpiStoreBf16, pg8::PlainSched, true>(c.lds, g, Sc, pg8::EpiStoreBf16{proj, DINP});
            const Ctx c3 = make_ctx(); if (c3.tid == 0) __hip_atomic_fetch_add(ctl + CW_PDONE, 1u, __ATOMIC_RELAXED, __HIP_MEMORY_SCOPE_AGENT);
        } else {
            const int j = (((c.wg >> 3) - 16) * 8 + (c.wg & 7)) * NWAVES + c.wave;
            const int n = conv_stream(c, j, 0, 1, ctl + CW_PDONE, INP(15), INP(17), (unsigned char*)Wgu, (unsigned char*)Wd);
            if (c.lane == 0) ctl[CW_PROG + j] = (unsigned)n;
        }
    }
__device__ __forceinline__ void phase2() { const Ctx c = make_ctx(); PHASE_PTRS; for (int R = c.gw; R < MR; R += c.NGW) postproj_row(R, c.lane, proj, INP(4), INP(9), INP(5), INP(7), mixed, qn, kvn, Kpe, cosT, sinT); }
__device__ __forceinline__ void phase3() { const Ctx c = make_ctx(); PHASE_PTRS;
        unsigned* ctl = (unsigned*)(ws + WS_CTL);
        if (c.G != 256 || !SPLIT_P3) {
            { pg8::Gemm g{qn, QL * 2}; pg8::PlainSched Sc; Sc.init(Wq, M, 1536, QL, c.G, c.wg);
              pg8::gemm_phase<pg8::EpiQ, pg8::PlainSched, true>(c.lds, g, Sc, pg8::EpiQ{Q, cosT, sinT}); }
            { pg8::Gemm g{kvn, KVL * 2}; pg8::PlainSched Sc; Sc.init(WkvK, M, 1024, KVL, c.G, c.wg);
              pg8::gemm_phase<pg8::EpiKn, pg8::PlainSched, true>(c.lds, g, Sc, pg8::EpiKn{Kn}); }
            { pg8::Gemm g{WkvV, KVL * 2}; pg8::PlainSched Sc; Sc.init(kvn, 1024, M, KVL, c.G, (c.wg + c.G / 2) % c.G);
              pg8::gemm_phase<pg8::EpiVt, pg8::PlainSched, true>(c.lds, g, Sc, pg8::EpiVt{V}); }
            gemm_simple(c, kvn + (size_t)M * KVL, KVL, Wkv, KVL, KVL, 1, 2048 / 32, EpiKV{Kn, V, M});
        } else if ((c.wg >> 3) < 16) {
            const int cw = (c.wg >> 3) * 8 + (c.wg & 7);
            { pg8::Gemm g{qn, QL * 2}; pg8::PlainSched Sc; Sc.init(Wq, M, 1536, QL, 128, cw);
              pg8::gemm_phase<pg8::EpiQ, pg8::PlainSched, true>(c.lds, g, Sc, pg8::EpiQ{Q, cosT, sinT}); }
            { pg8::Gemm g{kvn, KVL * 2}; pg8::PlainSched Sc; Sc.init(WkvK, M, 1024, KVL, 128, cw);
              pg8::gemm_phase<pg8::EpiKn, pg8::PlainSched, true>(c.lds, g, Sc, pg8::EpiKn{Kn}); }
            { pg8::Gemm g{WkvV, KVL * 2}; pg8::PlainSched Sc; Sc.init(kvn, 1024, M, KVL, 128, cw);
              pg8::gemm_phase<pg8::EpiVt, pg8::PlainSched, true>(c.lds, g, Sc, pg8::EpiVt{V}); }
            { Ctx c2 = make_ctx(); c2.gw = cw * NWAVES + c2.wave; c2.NGW = 128 * NWAVES;
              gemm_simple(c2, kvn + (size_t)M * KVL, KVL, Wkv, KVL, KVL, 1, 2048 / 32, EpiKV{Kn, V, M});
              if (c2.tid == 0) __hip_atomic_fetch_add(ctl + CW_QDONE, 1u, __ATOMIC_RELAXED, __HIP_MEMORY_SCOPE_AGENT); }
        } else {
            const int j = (((c.wg >> 3) - 16) * 8 + (c.wg & 7)) * NWAVES + c.wave;
            *(volatile LAS unsigned*)(c.lds + STOPW_OFF) = 0u;
            const int n = conv_stream(c, j, (int)ctl[CW_PROG + j], 1, ctl + CW_QDONE, INP(15), INP(17), (unsigned char*)Wgu, (unsigned char*)Wd);
            if (c.lane == 0) ctl[CW_PROG + j] = (unsigned)n;
        }
    }
__device__ __forceinline__ void phase5() { const Ctx c = make_ctx(); PHASE_PTRS;
        unsigned* ctl = (unsigned*)(ws + WS_CTL);
        if (c.G != 256) {
            for (int u = c.wg; u < NB * NH * 16; u += c.G) { const int bh = u >> 4, qb = u & 15; att::attn_unit(c.lds, bh >> 3, bh & 7, qb, 0, 4 * qb + 5, Q, Kn, Kpe, V, INP(10), mixed); }
        } else if ((c.wg >> 3) < 16) {
            const int x = c.wg & 7, i = c.wg >> 3;
#pragma unroll 1
            for (int k = 0; k < 2; ++k) { const int bh = 2 * x + k, qb = k == 0 ? i : 15 - i;
                att::attn_unit(c.lds, bh >> 3, bh & 7, qb, 0, 4 * qb + 5, Q, Kn, Kpe, V, INP(10), mixed); }
            const Ctx c3 = make_ctx(); if (c3.tid == 0) __hip_atomic_fetch_add(ctl + CW_ADONE, 1u, __ATOMIC_RELAXED, __HIP_MEMORY_SCOPE_AGENT);
        } else {
            const int j = (((c.wg >> 3) - 16) * 8 + (c.wg & 7)) * NWAVES + c.wave;
            *(volatile LAS unsigned*)(c.lds + STOPW_OFF) = 0u;
            const int n = conv_stream(c, j, (int)ctl[CW_PROG + j], 1, ctl + CW_ADONE, INP(15), INP(17), (unsigned char*)Wgu, (unsigned char*)Wd);
            if (c.lane == 0) ctl[CW_PROG + j] = (unsigned)n;
        }
    }
__device__ __forceinline__ void phase6() { const Ctx c = make_ctx(); PHASE_PTRS;
        pg8::Gemm g{mixed, D * 2}; pg8::PlainSched Sc; Sc.init(Wout, M, D, D, c.G, c.wg);
        pg8::gemm_phase<pg8::EpiResF32, pg8::PlainSched, true>(c.lds, g, Sc, pg8::EpiResF32{INP(0), h1, D});
    }
__device__ __forceinline__ void phase7() { const Ctx c = make_ctx(); PHASE_PTRS;
    for (int blk = c.wg; blk < M / 32; blk += c.G) router_block(c, blk, h1, INP(12), Wrt, INP(14), xn, cnt, rowtok, tok_e, tok_p, gate);
    { const unsigned* ctl = (const unsigned*)(ws + WS_CTL);
      for (int g = c.gw; g < 2 * CONV_SLOTS; g += c.NGW) { const int j = g % CONV_SLOTS, h = g / CONV_SLOTS;
          conv_stream(c, j, (int)ctl[CW_PROG + j] + h, 2, nullptr, INP(15), INP(17), (unsigned char*)Wgu, (unsigned char*)Wd); }
    }
}
__device__ __forceinline__ void phase8() { const Ctx c = make_ctx(); PHASE_PTRS;
        const LAS int* tab = build_expert_table(c, cnt);
        pg8::Gemm g{xn, D}; pg8::MoeSched<true> Sc{Wgu, (size_t)4096 * D, cnt, rowtok, tab, D, 16, c.G, c.wg};
        pg8::gemm_phase<pg8::EpiMoe1, pg8::MoeSched<true>, true, true>(c.lds, g, Sc, pg8::EpiMoe1{(unsigned char*)act, INP(16)});
    }
__device__ __forceinline__ void phase9() { const Ctx c = make_ctx(); PHASE_PTRS;
        const LAS int* tab = build_expert_table(c, cnt);
        pg8::Gemm g{act, DFF}; pg8::MoeSched<false> Sc{Wd, (size_t)D * DFF, cnt, rowtok, tab, DFF, 8, c.G, c.wg};
        pg8::gemm_phase<pg8::EpiMoe2, pg8::MoeSched<false>, true, true>(c.lds, g, Sc, pg8::EpiMoe2{y, INP(18)});
    }
__device__ __forceinline__ void phase10() { const Ctx c = make_ctx(); PHASE_PTRS; for (int m = c.gw; m < M; m += c.NGW) combine_row(m, c.lane, h1, y, cnt, tok_e, tok_p, gate, INP(19), ka->out); }
#undef KA
#undef WSP
#undef PHASE_PTRS
#undef INP

constexpr int NPHASE = 10;
constexpr int REP_PHASE = -1, REP_N = 1;
constexpr int STAMP_PHASE = -1, STAMP_AMP = 4;
__global__ void __launch_bounds__(NWAVES * 64, 2) mk_fwd(Args a) {
    extern __shared__ __attribute__((aligned(16))) unsigned char lds_raw[];
    volatile LAS unsigned* MISC = (volatile LAS unsigned*)((LAS unsigned char*)lds_raw + MISC_OFF);
    if (threadIdx.x < 32) MISC[threadIdx.x] = 0u;
    if (threadIdx.x == 32) *(volatile LAS unsigned*)((LAS unsigned char*)lds_raw + STOPW_OFF) = 0u;
    __syncthreads();
    XcdBarrier bar = xcd_barrier_post((unsigned*)(a.ws + WS_CTL) + CW_BAR, MISC + 8);
    const int lo = a.ph_lo, hi = a.ph_hi;
#define IN(k) (lo <= (k) && (k) < hi)
#define SEAM(k) do { if (IN(k) && IN((k) + 1)) xcd_barrier(bar); } while (0)
#define RUN(k) do { if constexpr (STAMP_PHASE == k) { if (threadIdx.x == 0) *(volatile LAS unsigned long long*)(MISC + 16) = __builtin_amdgcn_s_memrealtime(); } if (IN(k)) { phase##k(); if constexpr (REP_PHASE == k) { for (int r_ = 1; r_ < REP_N; ++r_) phase##k(); } } } while (0)
#define STAMP_END(k) do { if constexpr (STAMP_PHASE == k) { if (threadIdx.x == 0) *(volatile LAS unsigned long long*)(MISC + 18) = __builtin_amdgcn_s_memrealtime(); } } while (0)
    RUN(0);
    SEAM(0); STAMP_END(0);
    RUN(1);
    SEAM(1); STAMP_END(1);
    RUN(2);
    SEAM(2); STAMP_END(2);
    RUN(3);
    SEAM(3); STAMP_END(3);
    RUN(5);
    SEAM(5); STAMP_END(5);
    RUN(6);
    SEAM(6); STAMP_END(6);
    RUN(7);
    SEAM(7); STAMP_END(7);
    RUN(8);
    SEAM(8); STAMP_END(8);
    RUN(9);
    SEAM(9); STAMP_END(9);
    RUN(10); STAMP_END(10);
    if constexpr (STAMP_PHASE >= 0) { if (blockIdx.x == 0 && threadIdx.x == 0) { const unsigned long long t0 = __builtin_amdgcn_s_memrealtime(), want = (*(volatile LAS unsigned long long*)(MISC + 18) - *(volatile LAS unsigned long long*)(MISC + 16)) * STAMP_AMP;
        while (__builtin_amdgcn_s_memrealtime() - t0 < want) __builtin_amdgcn_s_sleep(8); } }
#undef IN
#undef SEAM
#undef RUN
#undef STAMP_END
}

extern "C" void kernel_launch(void* const* d_in, const int* in_sizes, int n_in, void* d_out, int out_size, void* d_ws, size_t ws_size, hipStream_t stream) {
    static int grid = 0;
    if (grid == 0) {
        if (n_in != 20 || ws_size < WS_END) { fprintf(stderr, "kernel_launch: unexpected n_in %d / ws %zu (need %zu)\n", n_in, ws_size, (size_t)WS_END); grid = -1; return; }
        int dev = 0, cus = 0, per_cu = 0;
        if (hipGetDevice(&dev) != hipSuccess || hipDeviceGetAttribute(&cus, hipDeviceAttributeMultiprocessorCount, dev) != hipSuccess) { grid = -1; return; }
        if (hipFuncSetAttribute((const void*)mk_fwd, hipFuncAttributeMaxDynamicSharedMemorySize, LDS_BYTES) != hipSuccess) { fprintf(stderr, "kernel_launch: hipFuncSetAttribute failed\n"); grid = -1; return; }
        if (hipOccupancyMaxActiveBlocksPerMultiprocessor(&per_cu, (const void*)mk_fwd, NWAVES * 64, LDS_BYTES) != hipSuccess || per_cu < 1) { fprintf(stderr, "kernel_launch: occupancy query says %d\n", per_cu); (void)hipGetLastError(); grid = -1; return; }
        grid = cus;
    }
    if (grid < 0) return;
    if (hipMemsetAsync((char*)d_ws + WS_CTL, 0, CTL_BYTES, stream) != hipSuccess) return;
    Args a{};
    for (int i = 0; i < 20; ++i) a.in[i] = (const float*)d_in[i];
    a.out = (float*)d_out; a.ws = (unsigned char*)d_ws; a.ph_lo = 0; a.ph_hi = NPHASE + 1;
    hipLaunchKernelGGL(mk_fwd, dim3(grid), dim3(NWAVES * 64), LDS_BYTES, stream, a);
}
```

```cpp
#include <hip/hip_runtime.h>
#include <cstdint>
#include <cstdio>

typedef unsigned short bf16;
typedef short bf16x8 __attribute__((ext_vector_type(8)));
typedef float f32x4 __attribute__((ext_vector_type(4)));
typedef float f32x2 __attribute__((ext_vector_type(2)));
typedef unsigned u32x4 __attribute__((ext_vector_type(4)));
typedef unsigned u32x2 __attribute__((ext_vector_type(2)));

constexpr int D = 2048, NB = 2, S = 4096, NMETA = 16, M = NB * S;
constexpr int MR = M + NMETA;
constexpr int MRP = 8256;
constexpr int DCONV = 1024, QL = 512, KVL = 256, ROPE = 64, NH = 8, DN = 128, DV = 128, DQK = 192;
constexpr int DIN = 3904, DINP = 4096;
constexpr int O_C = 1024, O_U = 2048, O_Q = 3072, O_KV = 3584, O_R = 3840;
constexpr int NE = 32, TOPK = 4, DFF = 2048;
constexpr int LP = 4224;
constexpr int RP = 41216;
constexpr float EPS = 1e-6f;
constexpr float WSCALE = 64.0f, WINV = 1.0f / 64.0f;

constexpr size_t MiB = 1u << 20;
constexpr size_t WS_CTL = 0, CTL_BYTES = 1 * MiB;
constexpr size_t WS_WIN = 2 * MiB;
constexpr size_t WS_WQ = WS_WIN + 16 * MiB;
constexpr size_t WS_WKV = WS_WQ + 2 * MiB;
constexpr size_t WS_WOUT = WS_WKV + 2 * MiB;
constexpr size_t WS_WGU = WS_WOUT + 8 * MiB;
constexpr size_t WS_WD = WS_WGU + 512 * MiB;
constexpr size_t WS_HN = WS_WD + 256 * MiB;
constexpr size_t WS_PROJ = WS_HN + 34 * MiB;
constexpr size_t WS_MIXED = WS_PROJ + 66 * MiB;
constexpr size_t WS_QN = WS_MIXED + 32 * MiB;
constexpr size_t WS_KVN = WS_QN + 8 * MiB;
constexpr size_t WS_QRAW = WS_KVN + 6 * MiB;
constexpr size_t WS_WKVK = WS_QRAW;
constexpr size_t WS_WKVV = WS_QRAW + 1 * MiB;
constexpr size_t WS_COS = WS_QRAW + 2 * MiB;
constexpr size_t WS_SIN = WS_QRAW + 3 * MiB;
constexpr size_t WS_WRT = WS_QRAW + 4 * MiB;
constexpr size_t WS_Q = WS_QRAW + 48 * MiB;
constexpr size_t WS_KN = WS_Q + 24 * MiB;
constexpr size_t WS_V = WS_KN + 18 * MiB;
constexpr size_t WS_KPE = WS_V + 18 * MiB;
constexpr size_t WS_H1 = WS_KPE + 2 * MiB;
constexpr size_t WS_XN = WS_H1 + 64 * MiB;
constexpr size_t WS_TOKE = WS_XN + 32 * MiB;
constexpr size_t WS_TOKP = WS_TOKE + 1 * MiB;
constexpr size_t WS_GATE = WS_TOKP + 1 * MiB;
constexpr size_t WS_ROWTOK = WS_GATE + 1 * MiB;
constexpr size_t WS_ACT = WS_ROWTOK + 1 * MiB;
constexpr size_t WS_Y = WS_ACT + 162 * MiB;
constexpr size_t WS_END = WS_Y + 162 * MiB;
constexpr int CW_CNT = 64, CNT_STRIDE = 32;
constexpr int CW_OFFT = 1472;
constexpr int CW_PROG = 2048;
constexpr int CW_QDONE = 1408;
constexpr int CW_PDONE = 1344;
constexpr int CW_ADONE = 1280;
constexpr int CW_TILE = 8192;
constexpr int CW_BAR2 = 12288;
constexpr int CW_BAR = 4096;

__device__ __forceinline__ float bf2f(bf16 v) { return __uint_as_float((unsigned)v << 16); }
__device__ __forceinline__ bf16 f2bf(float f) { unsigned u = __float_as_uint(f); return (bf16)((u + 0x7fffu + ((u >> 16) & 1u)) >> 16); }
__device__ __forceinline__ float wave_sum(float v) {
#pragma unroll
    for (int o = 1; o < 64; o <<= 1) v += __shfl_xor(v, o);
    return v;
}
__device__ __forceinline__ float wave_max(float v) {
#pragma unroll
    for (int o = 1; o < 64; o <<= 1) v = fmaxf(v, __shfl_xor(v, o));
    return v;
}
__device__ __forceinline__ void unpack8(const u32x4 w, float (&f)[8]) {
    f[0] = __uint_as_float(w.x << 16); f[1] = __uint_as_float(w.x & 0xffff0000u);
    f[2] = __uint_as_float(w.y << 16); f[3] = __uint_as_float(w.y & 0xffff0000u);
    f[4] = __uint_as_float(w.z << 16); f[5] = __uint_as_float(w.z & 0xffff0000u);
    f[6] = __uint_as_float(w.w << 16); f[7] = __uint_as_float(w.w & 0xffff0000u);
}
__device__ __forceinline__ unsigned pk2(float lo, float hi) { return (unsigned)f2bf(lo) | ((unsigned)f2bf(hi) << 16); }


#define GAS __attribute__((address_space(1)))
#define LAS __attribute__((address_space(3)))
#define LDS_WAIT() asm volatile("s_waitcnt lgkmcnt(0)" ::: "memory")
#define VM_WAIT() asm volatile("s_waitcnt vmcnt(0)" ::: "memory")
constexpr int NWAVES = 8;
constexpr int LDS_BYTES = 147456;
constexpr int RING_BYTES = 131072, MISC_OFF = LDS_BYTES - 2048;

#define XB_TMO      128
#define XB_XCNT(j)  (256  + 64 * (j))
#define XB_XSUB(j)  (1280 + 64 * (j))
#define XB_XGEN(j)  (2304 + 64 * (j))
#define XB_TOP      3328
#define XB_TOPGEN   3392
#define XCD_BAR_WORDS 3456
#define XB_SPIN_CAP (1u << 18)

__device__ __forceinline__ unsigned xb_ld(unsigned* p)              { return __hip_atomic_load(p, __ATOMIC_RELAXED, __HIP_MEMORY_SCOPE_AGENT); }
__device__ __forceinline__ unsigned xb_add(unsigned* p, unsigned v) { return __hip_atomic_fetch_add(p, v, __ATOMIC_RELAXED, __HIP_MEMORY_SCOPE_AGENT); }
__device__ __forceinline__ unsigned xb_xcc_id() { return (unsigned)__builtin_amdgcn_s_getreg((3 << 11) | 20) & 0xFu; }
#define XB_SPIN(cond, bar) do { unsigned _sp = 0; while (cond) { __builtin_amdgcn_s_sleep(1); \
    if ((++_sp & 255u) == 0u) { if (xb_ld(&(bar)[XB_TMO])) break; if (_sp > XB_SPIN_CAP) { atomicAdd(&(bar)[XB_TMO], 1u); break; } } } } while (0)

struct XcdBarrier {
    unsigned* bar; unsigned x, total;
    volatile LAS unsigned* st;
};
__device__ __forceinline__ XcdBarrier xcd_barrier_post(unsigned* bar, volatile LAS unsigned* st, unsigned total, bool member = true) {
    XcdBarrier b; b.bar = bar; b.x = xb_xcc_id(); b.st = st; b.total = total;
    if (member && threadIdx.x == 0) (void)xb_add(&bar[XB_XCNT(b.x)], 1u);
    return b;
}
__device__ __forceinline__ void xcd_barrier_complete(unsigned* bar, unsigned x, unsigned G, unsigned& nloc, unsigned& nx) {
    unsigned sum, cnt, mine, sp = 0u;
    for (;;) {
        sum = 0u; cnt = 0u; mine = 0u;
#pragma unroll
        for (unsigned j = 0; j < 16; ++j) { const unsigned c = xb_ld(&bar[XB_XCNT(j)]); sum += c; cnt += (c > 0u) ? 1u : 0u; mine = (j == x) ? c : mine; }
        if (sum == G) break;
        __builtin_amdgcn_s_sleep(1);
        if ((++sp & 255u) == 0u) { if (xb_ld(&bar[XB_TMO])) break; if (sp > XB_SPIN_CAP) { atomicAdd(&bar[XB_TMO], 1u); break; } }
    }
    nloc = mine > 0u ? mine : 1u; nx = cnt > 0u ? cnt : 1u;
}
__device__ __forceinline__ void xcd_barrier(const XcdBarrier& b) {
    asm volatile("s_waitcnt vmcnt(0)" ::: "memory");
    __syncthreads();
    if (threadIdx.x == 0) {
        unsigned* bar = b.bar;
        __builtin_amdgcn_s_waitcnt(0);
        unsigned nloc = b.st[0], nx = b.st[1];
        if (nloc == 0u) { xcd_barrier_complete(bar, b.x, b.total, nloc, nx); b.st[0] = nloc; b.st[1] = nx; }
        const unsigned old = xb_add(&bar[XB_XSUB(b.x)], 1u);
        const unsigned gen = old / nloc;
        if (old + 1u == (gen + 1u) * nloc) {
            __builtin_amdgcn_fence(__ATOMIC_RELEASE, "agent");
            asm volatile("s_waitcnt vmcnt(0)" ::: "memory");
            const unsigned og = xb_add(&bar[XB_TOP], 1u);
            const unsigned tg = og / nx;
            if (og + 1u == (tg + 1u) * nx) xb_add(&bar[XB_TOPGEN], 1u);
            else XB_SPIN(xb_ld(&bar[XB_TOPGEN]) == tg, bar);
            __builtin_amdgcn_fence(__ATOMIC_ACQUIRE, "agent");
            xb_add(&bar[XB_XGEN(b.x)], 1u);
            asm volatile("s_waitcnt vmcnt(0)" ::: "memory");
        } else {
            XB_SPIN(xb_ld(&bar[XB_XGEN(b.x)]) == gen, bar);
            __builtin_amdgcn_fence(__ATOMIC_ACQUIRE, "agent");
            asm volatile("s_waitcnt vmcnt(0)" ::: "memory");
        }
    }
    __syncthreads();
}

namespace pg8 {
constexpr int AUX_OFF = 131072;
constexpr int BM = 256, BK = 64, HALF = 128, HTB = HALF * BK * 2  , STAGE_BYTES = 8 * HTB, NXCD = 8, WGM = 4;
__host__ __device__ __forceinline__ int lds_byte(int r, int c) { const int st = (r >> 4) * 2 + (c >> 5), rr = r & 15, cc = c & 31, ob = rr * 64 + cc * 2; return st * 1024 + (ob ^ (((ob >> 9) & 1) << 5)); }
__host__ __device__ __forceinline__ void stage_rc(int b, int& R, int& C) { const int st = b / 1024, sb = b % 1024, swz = sb ^ (((sb >> 9) & 1) << 5); R = (st >> 1) * 16 + swz / 64; C = (st & 1) * 32 + (swz % 64) / 2; }
__host__ __device__ __forceinline__ int perm32(int rho) { const int n = rho >> 4, i = rho & 15; return 8 * (i >> 2) + 4 * n + (i & 3); }

struct Unit { int pm, pn, e, nrows; };
struct Gemm { const void* A; int RB; };
typedef int v8i __attribute__((ext_vector_type(8)));
typedef int v4i __attribute__((ext_vector_type(4)));

__device__ __forceinline__ unsigned cvt_pk_bf16(float lo, float hi) { unsigned r; asm volatile("v_cvt_pk_bf16_f32 %0, %1, %2" : "=v"(r) : "v"(lo), "v"(hi)); return r; }

struct Frag16 { bf16x8 h[2]; };
template <bool FP8> struct FragT { typedef Frag16 T; };
template <> struct FragT<true> { typedef v8i T; };
__device__ __forceinline__ void frag_set(Frag16& f, int k, const bf16x8 v) { f.h[k] = v; }
__device__ __forceinline__ void frag_set(v8i& f, int k, const bf16x8 v) { const v4i w = __builtin_bit_cast(v4i, v); if (k == 0) { f[0] = w[0]; f[1] = w[1]; f[2] = w[2]; f[3] = w[3]; } else { f[4] = w[0]; f[5] = w[1]; f[6] = w[2]; f[7] = w[3]; } }
__device__ __forceinline__ f32x4 mma_fp8(const v8i& b, const v8i& a, const f32x4 c) { return __builtin_amdgcn_mfma_scale_f32_16x16x128_f8f6f4(b, a, c, 0, 0, 0, 0, 0, 0); }
__device__ __forceinline__ f32x4 mma_fp8(const Frag16&, const Frag16&, const f32x4 c) { return c; }
__device__ __forceinline__ f32x4 mma_bf16(const Frag16& b, const Frag16& a, int k, const f32x4 c) { return __builtin_amdgcn_mfma_f32_16x16x32_bf16(b.h[k], a.h[k], c, 0, 0, 0); }
__device__ __forceinline__ f32x4 mma_bf16(const v8i&, const v8i&, int, const f32x4 c) { return c; }
template <class Epi, class Sched, bool ALIGN_EPI, bool FP8 = false>
__device__ __forceinline__ void gemm_phase(LAS unsigned char* lds, const Gemm g, const Sched& S, const Epi& E) {
    int tid_ = threadIdx.x; asm volatile("" : "+v"(tid_));
    const int tid = tid_, wid = __builtin_amdgcn_readfirstlane(tid >> 6), lane = tid & 63, wr = wid >> 2, wc = wid & 3, fr = lane & 15, fq = lane >> 4;
    const int RB = g.RB, nt = RB / (BK * 2);
    int sR[2], sC[2]; unsigned voffB[2];
#pragma unroll
    for (int i = 0; i < 2; ++i) { stage_rc(tid * 16 + i * 8192, sR[i], sC[i]); const int Rb = Epi::PERM ? ((sR[i] & ~31) + perm32(sR[i] & 31)) : sR[i]; voffB[i] = (unsigned)(Rb * RB + sC[i] * 2); }
    const size_t kstep = (size_t)(BK * 2);
    const size_t hstep = (size_t)HALF * RB;
    const unsigned ldsw = (unsigned)wid * 1024u;
    const int aoff = lds_byte(wr * 64 + fr, fq * 8), boff = lds_byte(wc * 32 + fr, fq * 8);
    const char* Ab = (const char*)g.A;
#define PG8_SA(b, h) (((b) * 2 + (h)) * HTB)
#define PG8_SB(b, h) ((4 + (b) * 2 + (h)) * HTB)
#define PG8_STAGE(bufoff, gbase, voff) do { _Pragma("unroll") for (int _i = 0; _i < 2; ++_i) \
        __builtin_amdgcn_global_load_lds((const unsigned*)((const char*)(gbase) + (voff)[_i]), (LAS unsigned*)(lds + (bufoff) + ldsw + _i * 8192), 16, 0, 0); } while (0)
#define PG8_LDA(dst, b, h) do { _Pragma("unroll") for (int m = 0; m < 4; ++m) _Pragma("unroll") for (int k = 0; k < 2; ++k) frag_set(dst[m], k, *(const LAS bf16x8*)(lds + PG8_SA(b, h) + aoff + m * 2048 + k * 1024)); } while (0)
#define PG8_LDB(dst, b, h) do { _Pragma("unroll") for (int n = 0; n < 2; ++n) _Pragma("unroll") for (int k = 0; k < 2; ++k) frag_set(dst[n], k, *(const LAS bf16x8*)(lds + PG8_SB(b, h) + boff + n * 2048 + k * 1024)); } while (0)
#define PG8_MMA(ai, bj, At, Bt) do { __builtin_amdgcn_s_setprio(1); if constexpr (FP8) { _Pragma("unroll") for (int m = 0; m < 4; ++m) _Pragma("unroll") for (int n = 0; n < 2; ++n) \
        acc[ai][bj][m][n] = mma_fp8(Bt[n], At[m], acc[ai][bj][m][n]); } \
    else { _Pragma("unroll") for (int m = 0; m < 4; ++m) _Pragma("unroll") for (int n = 0; n < 2; ++n) _Pragma("unroll") for (int k = 0; k < 2; ++k) \
        acc[ai][bj][m][n] = mma_bf16(Bt[n], At[m], k, acc[ai][bj][m][n]); } __builtin_amdgcn_s_setprio(0); } while (0)
#define PG8_WAIT_V(n) asm volatile("s_waitcnt vmcnt(" #n ")" ::: "memory")
#define PG8_WAIT_L(n) asm volatile("s_waitcnt lgkmcnt(" #n ")" ::: "memory")
#define PG8_BAR __builtin_amdgcn_s_barrier()
#define PG8_SCHED __builtin_amdgcn_sched_barrier(0)
    Unit cur, nxt; int ui = 0, prev_pm = 0;
    if (!S.next(0, cur)) return;
    f32x4 acc[2][2][4][2];
#pragma unroll
    for (int a = 0; a < 2; ++a)
#pragma unroll
        for (int b = 0; b < 2; ++b)
#pragma unroll
            for (int m = 0; m < 4; ++m)
#pragma unroll
                for (int n = 0; n < 2; ++n) acc[a][b][m][n] = (f32x4){0.f, 0.f, 0.f, 0.f};
    typename FragT<FP8>::T At[4], B0[2], B1[2];
    unsigned ao[2][2];
    S.a_off(cur, sR, sC, ao);
    const char* cB = S.b_base(cur);
    PG8_STAGE(PG8_SB(0, 0), cB, voffB); PG8_STAGE(PG8_SB(0, 1), cB + hstep, voffB); PG8_STAGE(PG8_SA(0, 0), Ab, ao[0]); PG8_STAGE(PG8_SA(0, 1), Ab, ao[1]);
    if (wr == 1) PG8_BAR;
    PG8_WAIT_V(2); PG8_BAR;
    PG8_STAGE(PG8_SB(1, 0), cB + kstep, voffB); PG8_STAGE(PG8_SA(1, 0), Ab + kstep, ao[0]); PG8_STAGE(PG8_SB(1, 1), cB + hstep + kstep, voffB);
    PG8_WAIT_V(6); PG8_BAR;
    for (;;) {
        const bool has_next = S.next(ui + 1, nxt);
        S.prefetch(lds + AUX_OFF, cur, has_next, nxt, ui, wid, lane);
        const char* nB = has_next ? S.b_base(nxt) : cB;
        const bool do0 = cur.nrows > 64 * wr, full = cur.nrows > HALF + 64 * wr;
#pragma unroll 1
        for (int t = 0; t < nt; t += 2) {
            const bool last = (t == nt - 2);
            const char* a1 = Ab + (size_t)(t + 1) * kstep;
            PG8_LDB(B0, 0, 0); PG8_LDB(B1, 0, 1); PG8_SCHED; PG8_LDA(At, 0, 0); PG8_STAGE(PG8_SA(1, 1), a1, ao[1]);
            PG8_WAIT_V(8); PG8_WAIT_L(0); PG8_BAR; if (do0) { PG8_MMA(0, 0, At, B0); PG8_MMA(0, 1, At, B1); } PG8_BAR; PG8_SCHED;
            const char* a2 = last ? Ab : Ab + (size_t)(t + 2) * kstep; const char* b2 = last ? nB : cB + (size_t)(t + 2) * kstep;
            if (last && has_next) { int t2 = tid; asm volatile("" : "+v"(t2)); int R2[2], C2[2];
#pragma unroll
                for (int i = 0; i < 2; ++i) stage_rc(t2 * 16 + i * 8192, R2[i], C2[i]);
                S.a_off_next(nxt, R2, C2, ao, lds + AUX_OFF); }
            const char* a3 = a2 + kstep; const char* b3 = b2 + kstep;
            PG8_LDA(At, 0, 1); PG8_STAGE(PG8_SB(0, 0), b2, voffB); PG8_STAGE(PG8_SB(0, 1), b2 + hstep, voffB); PG8_STAGE(PG8_SA(0, 0), a2, ao[0]);
            PG8_WAIT_V(8); PG8_WAIT_L(0); PG8_BAR; if (full) { PG8_MMA(1, 0, At, B0); PG8_MMA(1, 1, At, B1); } PG8_BAR; PG8_SCHED;
            PG8_LDB(B0, 1, 0); PG8_LDB(B1, 1, 1); PG8_SCHED; PG8_LDA(At, 1, 0); PG8_STAGE(PG8_SA(0, 1), a2, ao[1]);
            PG8_WAIT_V(8); PG8_WAIT_L(0); PG8_BAR; if (do0) { PG8_MMA(0, 0, At, B0); PG8_MMA(0, 1, At, B1); } PG8_BAR; PG8_SCHED;
            PG8_LDA(At, 1, 1); PG8_STAGE(PG8_SB(1, 0), b3, voffB); PG8_STAGE(PG8_SB(1, 1), b3 + hstep, voffB); PG8_STAGE(PG8_SA(1, 0), a3, ao[0]);
            PG8_WAIT_V(8); PG8_WAIT_L(0); PG8_BAR; if (full) { PG8_MMA(1, 0, At, B0); PG8_MMA(1, 1, At, B1); } PG8_BAR; PG8_SCHED;
        }
        if (ui > 0) S.unit_done(prev_pm, lane);
        prev_pm = cur.pm;
        if constexpr (ALIGN_EPI) { if (wr == 0) PG8_BAR; }
        E(acc, cur, wr, wc, fr, fq, (const LAS float*)(lds + AUX_OFF + 1024 + (ui & 1) * 1024));
        if (!has_next) break;
#pragma unroll
        for (int a = 0; a < 2; ++a)
#pragma unroll
            for (int b = 0; b < 2; ++b)
#pragma unroll
                for (int m = 0; m < 4; ++m)
#pragma unroll
                    for (int n = 0; n < 2; ++n) acc[a][b][m][n] = (f32x4){0.f, 0.f, 0.f, 0.f};
        cur = nxt; cB = nB; ++ui;
        if constexpr (ALIGN_EPI) { if (wr == 1) PG8_BAR; }
    }
    PG8_WAIT_V(0);
    S.unit_done(prev_pm, lane);
    if constexpr (!ALIGN_EPI) { if (wr == 0) PG8_BAR; }
    PG8_BAR;
#undef PG8_SA
#undef PG8_SB
#undef PG8_STAGE
#undef PG8_LDA
#undef PG8_LDB
#undef PG8_MMA
#undef PG8_WAIT_V
#undef PG8_WAIT_L
#undef PG8_BAR
#undef PG8_SCHED
}

struct PlainSched {
    const bf16* Bt; int RB, nM, nN, nwg, G, c;
    __device__ void init(const bf16* Bt_, int M_, int N_, int K_, int G_, int c_) { Bt = Bt_; RB = K_ * 2; nM = M_ / BM; nN = N_ / BM; nwg = nM * nN; G = G_; c = c_; }
    __device__ __forceinline__ bool next(int i, Unit& u) const {
        const long L = (long)i * G + c; if (L >= nwg) return false;
        int wgid = (int)L; { const int q = nwg / NXCD, r = nwg % NXCD, xcd = wgid % NXCD, off = wgid / NXCD; wgid = (xcd < r ? xcd * (q + 1) : r * (q + 1) + (xcd - r) * q) + off; }
        const int nig = WGM * nN, gid = wgid / nig, fm = gid * WGM, gsz = (nM - fm) < WGM ? (nM - fm) : WGM;
        u.pm = fm + ((wgid % nig) % gsz); u.pn = (wgid % nig) / gsz; u.e = 0; u.nrows = BM; return true;
    }
    __device__ __forceinline__ void a_off(const Unit& u, const int (&R)[2], const int (&C)[2], unsigned (&off)[2][2]) const {
#pragma unroll
        for (int h = 0; h < 2; ++h)
#pragma unroll
            for (int i = 0; i < 2; ++i) off[h][i] = (unsigned)((u.pm * BM + h * HALF + R[i]) * RB + C[i] * 2);
    }
    __device__ __forceinline__ const char* b_base(const Unit& u) const { return (const char*)Bt + (size_t)u.pn * BM * RB; }
    __device__ __forceinline__ void prefetch(LAS unsigned char*, const Unit&, bool, const Unit&, int, int, int) const {}
    __device__ __forceinline__ void unit_done(int, int) const {}
    __device__ __forceinline__ void a_off_next(const Unit& u, const int (&R)[2], const int (&C)[2], unsigned (&off)[2][2], LAS unsigned char*) const { a_off(u, R, C, off); }
};

struct EpiStoreBf16 {
    static constexpr bool PERM = true;
    bf16* O; int ldc;
    __device__ __forceinline__ void operator()(const f32x4 (&acc)[2][2][4][2], const Unit& u, int wr, int wc, int fr, int fq, const LAS float* bl) const {
        const int row0 = u.pm * BM + wr * 64 + fr, col0 = u.pn * BM + wc * 32 + 8 * fq;
#pragma unroll
        for (int ai = 0; ai < 2; ++ai)
#pragma unroll
            for (int m = 0; m < 4; ++m) { bf16* rowp = O + (size_t)(row0 + ai * HALF + m * 16) * ldc + col0;
#pragma unroll
                for (int bj = 0; bj < 2; ++bj) { const f32x4 v0 = acc[ai][bj][m][0], v1 = acc[ai][bj][m][1];
                    u32x4 w; w.x = cvt_pk_bf16(v0[0], v0[1]); w.y = cvt_pk_bf16(v0[2], v0[3]); w.z = cvt_pk_bf16(v1[0], v1[1]); w.w = cvt_pk_bf16(v1[2], v1[3]);
                    *(u32x4*)(rowp + bj * HALF) = w; } }
    }
};
struct EpiResF32 {
    static constexpr bool PERM = false;
    const float* __restrict__ base; float* __restrict__ out; int ldc;
    __device__ __forceinline__ void operator()(const f32x4 (&acc)[2][2][4][2], const Unit& u, int wr, int wc, int fr, int fq, const LAS float* bl) const {
        const int row0 = u.pm * BM + wr * 64 + fr, col0 = u.pn * BM + wc * 32 + 4 * fq;
#pragma unroll
        for (int ai = 0; ai < 2; ++ai) {
            f32x4 res[4][2][2];
#pragma unroll
            for (int m = 0; m < 4; ++m) { const size_t off = (size_t)(row0 + ai * HALF + m * 16) * ldc + col0;
#pragma unroll
                for (int bj = 0; bj < 2; ++bj)
#pragma unroll
                    for (int n = 0; n < 2; ++n) res[m][bj][n] = __builtin_nontemporal_load((const f32x4*)(base + off + bj * HALF + n * 16)); }
#pragma unroll
            for (int m = 0; m < 4; ++m) { const size_t off = (size_t)(row0 + ai * HALF + m * 16) * ldc + col0;
#pragma unroll
                for (int bj = 0; bj < 2; ++bj)
#pragma unroll
                    for (int n = 0; n < 2; ++n) *(f32x4*)(out + off + bj * HALF + n * 16) = res[m][bj][n] + acc[ai][bj][m][n]; }
        }
    }
};
struct EpiQ {
    static constexpr bool PERM = true;
    bf16* Q; const float* cosT; const float* sinT;
    __device__ __forceinline__ void operator()(const f32x4 (&acc)[2][2][4][2], const Unit& u, int wr, int wc, int fr, int fq, const LAS float* bl) const {
        const int row0 = u.pm * BM + wr * 64 + fr;
#pragma unroll
        for (int bj = 0; bj < 2; ++bj) {
            const int k64 = 4 * u.pn + 2 * bj + (wc >> 1), head = k64 / 3, type = k64 % 3, blk = wc & 1;
            if (type < 2) {
                const int dim = 64 * type + 32 * blk + 8 * fq;
#pragma unroll
                for (int ai = 0; ai < 2; ++ai)
#pragma unroll
                    for (int m = 0; m < 4; ++m) { const int r = row0 + ai * HALF + m * 16; const f32x4 v0 = acc[ai][bj][m][0], v1 = acc[ai][bj][m][1];
                        u32x4 w; w.x = cvt_pk_bf16(v0[0], v0[1]); w.y = cvt_pk_bf16(v0[2], v0[3]); w.z = cvt_pk_bf16(v1[0], v1[1]); w.w = cvt_pk_bf16(v1[2], v1[3]);
                        *(u32x4*)(Q + ((size_t)r * NH + head) * DQK + dim) = w; }
            } else {
                const int i0 = 16 * blk + 4 * fq;
#pragma unroll
                for (int ai = 0; ai < 2; ++ai)
#pragma unroll
                    for (int m = 0; m < 4; ++m) { const int r = row0 + ai * HALF + m * 16, pos = (r % S) + NMETA;
                        const f32x4 cs = *(const f32x4*)(cosT + pos * 32 + i0), sn = *(const f32x4*)(sinT + pos * 32 + i0);
                        const f32x4 x1 = acc[ai][bj][m][0], x2 = acc[ai][bj][m][1];
                        const f32x4 o1 = x1 * cs - x2 * sn, o2 = x1 * sn + x2 * cs;
                        bf16* dst = Q + ((size_t)r * NH + head) * DQK + 128 + i0;
                        u32x2 w1; w1.x = cvt_pk_bf16(o1[0], o1[1]); w1.y = cvt_pk_bf16(o1[2], o1[3]); *(u32x2*)(dst) = w1;
                        u32x2 w2; w2.x = cvt_pk_bf16(o2[0], o2[1]); w2.y = cvt_pk_bf16(o2[2], o2[3]); *(u32x2*)(dst + 32) = w2; }
            }
        }
    }
};
struct EpiKn {
    static constexpr bool PERM = true;
    bf16* kn;
    __device__ __forceinline__ void operator()(const f32x4 (&acc)[2][2][4][2], const Unit& u, int wr, int wc, int fr, int fq, const LAS float* bl) const {
        const int row0 = u.pm * BM + wr * 64 + fr, col0 = u.pn * BM + wc * 32 + 8 * fq;
#pragma unroll
        for (int ai = 0; ai < 2; ++ai)
#pragma unroll
            for (int m = 0; m < 4; ++m) { const int r = row0 + ai * HALF + m * 16, b = r / S, pos = (r % S) + NMETA; bf16* rowp = kn + (size_t)(b * LP + pos) * (NH * 128) + col0;
#pragma unroll
                for (int bj = 0; bj < 2; ++bj) { const f32x4 v0 = acc[ai][bj][m][0], v1 = acc[ai][bj][m][1];
                    u32x4 w; w.x = cvt_pk_bf16(v0[0], v0[1]); w.y = cvt_pk_bf16(v0[2], v0[3]); w.z = cvt_pk_bf16(v1[0], v1[1]); w.w = cvt_pk_bf16(v1[2], v1[3]);
                    *(u32x4*)(rowp + bj * HALF) = w; } }
    }
};
struct EpiVt {
    static constexpr bool PERM = true;
    bf16* vt;
    __device__ __forceinline__ void operator()(const f32x4 (&acc)[2][2][4][2], const Unit& u, int wr, int wc, int fr, int fq, const LAS float* bl) const {
        const int f0 = u.pm * BM + wr * 64 + fr, tk0 = u.pn * BM + wc * 32 + 8 * fq;
#pragma unroll
        for (int ai = 0; ai < 2; ++ai)
#pragma unroll
            for (int m = 0; m < 4; ++m) { const int f = f0 + ai * HALF + m * 16;
#pragma unroll
                for (int bj = 0; bj < 2; ++bj) { const int tk = tk0 + bj * HALF, b = tk / S, t = tk % S; const f32x4 v0 = acc[ai][bj][m][0], v1 = acc[ai][bj][m][1];
                    u32x4 w; w.x = cvt_pk_bf16(v0[0], v0[1]); w.y = cvt_pk_bf16(v0[2], v0[3]); w.z = cvt_pk_bf16(v1[0], v1[1]); w.w = cvt_pk_bf16(v1[2], v1[3]);
                    *(u32x4*)(vt + ((size_t)b * (NH * 128) + f) * LP + NMETA + t) = w; } }
    }
};
constexpr int TMAP_REL = (656 - 128) / 4;
template <bool GATHER>
struct MoeSched {
    const void* W; size_t wbytes;
    const unsigned* cnt; const int* rowtok; const LAS int* tab;
    int RB, nN, G, c;
    const float* bias;
    unsigned* tilecnt;
    __device__ __forceinline__ void unit_done(int pm, int lane) const {
        if (GATHER) { asm volatile("" ::: "memory"); if (lane == 0) __hip_atomic_fetch_add(tilecnt + pm * 16, 1u, __ATOMIC_RELAXED, __HIP_MEMORY_SCOPE_AGENT); } }
    __device__ __forceinline__ void wait_tile(int pm) const {
        if (!GATHER) { while (__hip_atomic_load(tilecnt + pm * 16, __ATOMIC_RELAXED, __HIP_MEMORY_SCOPE_AGENT) < 128u) __builtin_amdgcn_s_sleep(2); asm volatile("" ::: "memory"); } }
    __device__ __forceinline__ bool next(int i, Unit& u) const {
        const int total = tab[32] * nN; const int L = i * G + c; if (L >= total) return false;
        const int pk = __builtin_amdgcn_readfirstlane(tab[TMAP_REL + L / nN]);
        u.pm = pk & 255; u.e = (pk >> 8) & 255; u.nrows = pk >> 16; u.pn = __builtin_amdgcn_readfirstlane(L % nN);
        return true;
    }
    __device__ __forceinline__ void a_off(const Unit& u, const int (&R)[2], const int (&C)[2], unsigned (&off)[2][2]) const { wait_tile(u.pm); a_off_plain(u, R, C, off); }
    __device__ __forceinline__ void a_off_plain(const Unit& u, const int (&R)[2], const int (&C)[2], unsigned (&off)[2][2]) const {
#pragma unroll
        for (int h = 0; h < 2; ++h)
#pragma unroll
            for (int i = 0; i < 2; ++i) {
                if (GATHER) { const int lt = (u.pm - tab[u.e]) * BM; int li = h * HALF + R[i]; li = li < u.nrows ? li : u.nrows - 1;
                    const int tok = rowtok[u.e * M + lt + li]; off[h][i] = (unsigned)(tok * RB + C[i] * 2); }
                else off[h][i] = (unsigned)((u.pm * BM + h * HALF + R[i]) * RB + C[i] * 2);
            }
    }
    __device__ __forceinline__ const char* b_base(const Unit& u) const { return (const char*)W + (size_t)u.e * wbytes + (size_t)u.pn * BM * RB; }
    __device__ __forceinline__ void prefetch(LAS unsigned char* aux, const Unit& cur, bool has_next, const Unit& nxt, int ui, int wid, int lane) const {
        if (GATHER && has_next && wid == 0) { const int lt = (nxt.pm - tab[nxt.e]) * BM;
            __builtin_amdgcn_global_load_lds((const unsigned*)(rowtok + nxt.e * M + lt + 4 * lane), (LAS unsigned*)aux, 16, 0, 0); }
        if (!GATHER && has_next && wid == 2 && lane == 0)
            __builtin_amdgcn_global_load_lds((const unsigned*)(tilecnt + nxt.pm * 16), (LAS unsigned*)(aux + 3072), 4, 0, 16);
        if (wid == 1) { const float* src = GATHER ? bias + (size_t)cur.e * 4096 + (lane < 32 ? 0 : 2048 - 128) + cur.pn * HALF + 4 * lane
                                                  : bias + (size_t)cur.e * D + cur.pn * BM + 4 * lane;
            __builtin_amdgcn_global_load_lds((const unsigned*)src, (LAS unsigned*)(aux + 1024 + (ui & 1) * 1024), 16, 0, 0); }
    }
    __device__ __forceinline__ void a_off_next(const Unit& u, const int (&R)[2], const int (&C)[2], unsigned (&off)[2][2], LAS unsigned char* aux) const {
        if (!GATHER) { if (*(const volatile LAS unsigned*)(aux + 3072) < 128u) wait_tile(u.pm);
            a_off_plain(u, R, C, off); return; }
        const LAS int* tok = (const LAS int*)aux;
#pragma unroll
        for (int h = 0; h < 2; ++h)
#pragma unroll
            for (int i = 0; i < 2; ++i) { int li = h * HALF + R[i]; li = li < u.nrows ? li : u.nrows - 1; off[h][i] = (unsigned)(tok[li] * RB + C[i] * 2); }
    }
};
struct EpiMoe1 {
    static constexpr bool PERM = true;
    unsigned char* act; const float* b_gu;
    __device__ __forceinline__ void operator()(const f32x4 (&acc)[2][2][4][2], const Unit& u, int wr, int wc, int fr, int fq, const LAS float* bl) const {
        const int row0 = u.pm * BM + wr * 64 + fr, cc = u.pn * HALF + wc * 32 + 8 * fq;
        const LAS float* bias = bl + wc * 32 + 8 * fq;
        const f32x4 bg0 = *(const LAS f32x4*)(bias), bg1 = *(const LAS f32x4*)(bias + 4), bl0 = *(const LAS f32x4*)(bias + 128), bl1 = *(const LAS f32x4*)(bias + 128 + 4);
        const int par = fq & 1;
#pragma unroll
        for (int ai = 0; ai < 2; ++ai)
#pragma unroll
            for (int mp = 0; mp < 2; ++mp) {
                int wv[2][2];
#pragma unroll
                for (int mm = 0; mm < 2; ++mm) { const int m = 2 * mp + mm;
                    f32x4 o[2];
#pragma unroll
                    for (int n = 0; n < 2; ++n) { const f32x4 ag = acc[ai][0][m][n], al = acc[ai][1][m][n], bgv = n ? bg1 : bg0, blv = n ? bl1 : bl0;
#pragma unroll
                        for (int h = 0; h < 2; ++h) {
                            f32x2 g = __builtin_elementwise_fma((f32x2){ag[2 * h], ag[2 * h + 1]}, (f32x2){WINV, WINV}, (f32x2){bgv[2 * h], bgv[2 * h + 1]});
                            f32x2 l = __builtin_elementwise_fma((f32x2){al[2 * h], al[2 * h + 1]}, (f32x2){WINV, WINV}, (f32x2){blv[2 * h] + 1.0f, blv[2 * h + 1] + 1.0f});
                            g = (f32x2){fminf(g.x, 7.0f), fminf(g.y, 7.0f)};
                            l = (f32x2){__builtin_amdgcn_fmed3f(l.x, -6.0f, 8.0f), __builtin_amdgcn_fmed3f(l.y, -6.0f, 8.0f)};
                            const f32x2 a = g * (f32x2){-1.702f * 1.4426950408889634f, -1.702f * 1.4426950408889634f};
                            const f32x2 d = (f32x2){__builtin_amdgcn_exp2f(a.x), __builtin_amdgcn_exp2f(a.y)} + (f32x2){1.0f, 1.0f};
                            const f32x2 r = (f32x2){__builtin_amdgcn_rcpf(d.x), __builtin_amdgcn_rcpf(d.y)};
                            const f32x2 ov = (l * g) * r;
                            o[n][2 * h] = ov.x; o[n][2 * h + 1] = ov.y; } }
                    int w0 = 0, w1 = 0;
                    w0 = __builtin_amdgcn_cvt_pk_fp8_f32(o[0][0], o[0][1], w0, false); w0 = __builtin_amdgcn_cvt_pk_fp8_f32(o[0][2], o[0][3], w0, true);
                    w1 = __builtin_amdgcn_cvt_pk_fp8_f32(o[1][0], o[1][1], w1, false); w1 = __builtin_amdgcn_cvt_pk_fp8_f32(o[1][2], o[1][3], w1, true);
                    wv[mm][0] = w0; wv[mm][1] = w1; }
                const int s0 = par ? wv[0][0] : wv[1][0], s1 = par ? wv[0][1] : wv[1][1];
                const int r0 = __shfl_xor(s0, 16), r1 = __shfl_xor(s1, 16);
                const u32x4 wq = par ? (u32x4){(unsigned)r0, (unsigned)r1, (unsigned)wv[1][0], (unsigned)wv[1][1]} : (u32x4){(unsigned)wv[0][0], (unsigned)wv[0][1], (unsigned)r0, (unsigned)r1};
                unsigned char* const wp = act + (size_t)(row0 + ai * HALF + (2 * mp + par) * 16) * DFF + cc - 8 * par;
                asm volatile("global_store_dwordx4 %0, %1, off sc1\n\ts_nop 1" :: "v"(wp), "v"(wq) : "memory");
            }
    }
};
struct EpiMoe2 {
    static constexpr bool PERM = true;
    bf16* y; const float* b_d;
    __device__ __forceinline__ void operator()(const f32x4 (&acc)[2][2][4][2], const Unit& u, int wr, int wc, int fr, int fq, const LAS float* bl) const {
        const int row0 = u.pm * BM + wr * 64 + fr, col0 = u.pn * BM + wc * 32 + 8 * fq;
        const LAS float* bias = bl + wc * 32 + 8 * fq;
        f32x4 bv[2][2];
#pragma unroll
        for (int bj = 0; bj < 2; ++bj)
#pragma unroll
            for (int n = 0; n < 2; ++n) bv[bj][n] = *(const LAS f32x4*)(bias + bj * HALF + 4 * n);
#pragma unroll
        for (int ai = 0; ai < 2; ++ai)
#pragma unroll
            for (int m = 0; m < 4; ++m) { bf16* rowp = y + (size_t)(row0 + ai * HALF + m * 16) * D + col0;
#pragma unroll
                for (int bj = 0; bj < 2; ++bj) { f32x4 v0, v1;
#pragma unroll
                    for (int h = 0; h < 2; ++h) { const f32x4 a0 = acc[ai][bj][m][0], a1 = acc[ai][bj][m][1], b0 = bv[bj][0], b1 = bv[bj][1];
                        const f32x2 p0 = __builtin_elementwise_fma((f32x2){a0[2 * h], a0[2 * h + 1]}, (f32x2){WINV, WINV}, (f32x2){b0[2 * h], b0[2 * h + 1]});
                        const f32x2 p1 = __builtin_elementwise_fma((f32x2){a1[2 * h], a1[2 * h + 1]}, (f32x2){WINV, WINV}, (f32x2){b1[2 * h], b1[2 * h + 1]});
                        v0[2 * h] = p0.x; v0[2 * h + 1] = p0.y; v1[2 * h] = p1.x; v1[2 * h + 1] = p1.y; }
                    u32x4 w; w.x = cvt_pk_bf16(v0[0], v0[1]); w.y = cvt_pk_bf16(v0[2], v0[3]); w.z = cvt_pk_bf16(v1[0], v1[1]); w.w = cvt_pk_bf16(v1[2], v1[3]);
                    *(u32x4*)(rowp + bj * HALF) = w; } }
    }
};
}

namespace att {
typedef float f32x16 __attribute__((ext_vector_type(16)));
typedef float f32x2 __attribute__((ext_vector_type(2)));
constexpr int KPITCH = 400, VPITCH = 144;
constexpr int KBYTES = 64 * KPITCH, VBYTES = 128 * VPITCH, STAGE = KBYTES + VBYTES;
constexpr int WSF_OFF = 2 * STAGE;
static_assert(WSF_OFF + 8 * 256 <= RING_BYTES, "attention LDS");
constexpr float SC = 0.07216878364870322f * 1.4426950408889634f;

__device__ __forceinline__ int crow(int r, int hi) { return (r & 3) + 8 * (r >> 2) + 4 * hi; }

__device__ __forceinline__ void attn_unit(LAS unsigned char* lds, int b, int h, int qb, int ta, int tb, const bf16* __restrict__ Q, const bf16* __restrict__ Kn, const bf16* __restrict__ Kpe,
                                          const bf16* __restrict__ Vt, const float* __restrict__ g_attn, bf16* __restrict__ mixed) {
    const int tid = threadIdx.x, lane = tid & 63, r32 = lane & 31, hi = lane >> 5, wid = __builtin_amdgcn_readfirstlane(tid >> 6);
    const int t0 = qb * 256 + wid * 32;
    const int m0 = b * S + t0;
    const int wave_max_pos = t0 + 31 + NMETA, wave_min_pos = t0 + NMETA;
    LAS float* wsf = (LAS float*)(lds + WSF_OFF) + wid * 64;
    unsigned koff[3], kdst[3], kstr[3];
#pragma unroll
    for (int i = 0; i < 3; ++i) { const int id = tid + 512 * i, key = id / 24, c = id % 24;
        koff[i] = c < 16 ? (unsigned)((((b * LP + key) * NH + h) * 128 + c * 8) * 2) : (unsigned)(WS_KPE - WS_KN) + (unsigned)(((b * LP + key) * ROPE + (c - 16) * 8) * 2);
        kstr[i] = c < 16 ? 64u * NH * 128 * 2 : 64u * ROPE * 2;
        const int row = (key & ~12) | ((key & 4) << 1) | ((key & 8) >> 1);
        kdst[i] = (unsigned)(row * KPITCH + c * 16); }
    unsigned voff[2], vdst[2];
#pragma unroll
    for (int i = 0; i < 2; ++i) { const int id = tid + 512 * i, d = id >> 3, kc = id & 7;
        voff[i] = (unsigned)((((b * NH + h) * 128 + d) * LP + kc * 8) * 2); vdst[i] = (unsigned)(KBYTES + d * VPITCH + kc * 16); }
    const char* const Knb = (const char*)Kn; const char* const Vtb = (const char*)Vt;
    bf16x8 qf[12];
    { const bf16* qp = Q + ((size_t)(m0 + r32) * NH + h) * DQK + 8 * hi;
#pragma unroll
      for (int ks = 0; ks < 12; ++ks) qf[ks] = *(const bf16x8*)(qp + ks * 16); }
    f32x16 o[4];
#pragma unroll
    for (int d = 0; d < 4; ++d)
#pragma unroll
        for (int r = 0; r < 16; ++r) o[d][r] = 0.f;
    float mrow = -1.0e30f, lsum = 0.f;
    u32x4 kreg[3], vreg[2];
#pragma unroll
    for (int i = 0; i < 3; ++i) kreg[i] = *(const u32x4*)(Knb + (koff[i] + (unsigned)ta * kstr[i]));
#pragma unroll
    for (int i = 0; i < 2; ++i) vreg[i] = *(const u32x4*)(Vtb + (voff[i] + (unsigned)ta * 128u));
#pragma unroll
    for (int i = 0; i < 3; ++i) *(LAS u32x4*)(lds + kdst[i]) = kreg[i];
#pragma unroll
    for (int i = 0; i < 2; ++i) *(LAS u32x4*)(lds + vdst[i]) = vreg[i];
    __syncthreads();
    for (int t = ta; t < tb; ++t) {
        const bool more = t + 1 < tb; const int st = (t - ta) & 1;
        if (more) {
#pragma unroll
            for (int i = 0; i < 3; ++i) kreg[i] = *(const u32x4*)(Knb + (koff[i] + (unsigned)(t + 1) * kstr[i]));
#pragma unroll
            for (int i = 0; i < 2; ++i) vreg[i] = *(const u32x4*)(Vtb + (voff[i] + (unsigned)(t + 1) * 128u));
        }
        const int kb = t * 64;
        if (kb <= wave_max_pos) {
            const LAS unsigned char* Kb = lds + st * STAGE; const LAS unsigned char* Vb = Kb + KBYTES;
            f32x16 p0, p1;
#pragma unroll
            for (int r = 0; r < 16; ++r) { p0[r] = 0.f; p1[r] = 0.f; }
            const LAS unsigned char* kp = Kb + r32 * KPITCH + hi * 16;
            __builtin_amdgcn_s_setprio(1);
#pragma unroll
            for (int ks = 0; ks < 12; ++ks) {
                const bf16x8 k0 = *(const LAS bf16x8*)(kp + ks * 32), k1 = *(const LAS bf16x8*)(kp + 32 * KPITCH + ks * 32);
                p0 = __builtin_amdgcn_mfma_f32_32x32x16_bf16(k0, qf[ks], p0, 0, 0, 0);
                p1 = __builtin_amdgcn_mfma_f32_32x32x16_bf16(k1, qf[ks], p1, 0, 0, 0);
            }
            __builtin_amdgcn_s_setprio(0);
            if (kb + 63 > wave_min_pos) {
                const int qpos = t0 + r32 + NMETA, kbase = kb + 8 * hi;
#pragma unroll
                for (int r = 0; r < 16; ++r) { const int key = kbase + 16 * (r >> 3) + (r & 7); if (key > qpos) p0[r] = -INFINITY; if (key + 32 > qpos) p1[r] = -INFINITY; }
            }
            float mx = fmaxf(p0[0], p1[0]);
#pragma unroll
            for (int r = 1; r < 16; ++r) mx = fmaxf(mx, fmaxf(p0[r], p1[r]));
            mx = fmaxf(mx, __shfl_xor(mx, 32));
            const float mnew = fmaxf(mrow, mx);
            const bool grew = __any((mnew - mrow) * SC > 8.0f);
            if (grew) {
                const float corr = __builtin_amdgcn_exp2f((mrow - mnew) * SC);
                lsum *= corr; mrow = mnew;
                if (hi == 0) wsf[r32] = corr;
                asm volatile("s_waitcnt lgkmcnt(0)" ::: "memory");
#pragma unroll
                for (int g = 0; g < 4; ++g) { const f32x4 f = *(const LAS f32x4*)(wsf + 8 * g + 4 * hi);
#pragma unroll
                    for (int d = 0; d < 4; ++d) { o[d][4 * g + 0] *= f.x; o[d][4 * g + 1] *= f.y; o[d][4 * g + 2] *= f.z; o[d][4 * g + 3] *= f.w; } }
            }
            const float nm = -mrow * SC;
            float ps = 0.f;
#pragma unroll
            for (int r = 0; r < 16; ++r) { p0[r] = __builtin_amdgcn_exp2f(__builtin_fmaf(p0[r], SC, nm)); p1[r] = __builtin_amdgcn_exp2f(__builtin_fmaf(p1[r], SC, nm)); ps += p0[r] + p1[r]; }
            lsum += ps;
            u32x4 pa[4];
            pa[0] = (u32x4){pg8::cvt_pk_bf16(p0[0], p0[1]), pg8::cvt_pk_bf16(p0[2], p0[3]), pg8::cvt_pk_bf16(p0[4], p0[5]), pg8::cvt_pk_bf16(p0[6], p0[7])};
            pa[1] = (u32x4){pg8::cvt_pk_bf16(p0[8], p0[9]), pg8::cvt_pk_bf16(p0[10], p0[11]), pg8::cvt_pk_bf16(p0[12], p0[13]), pg8::cvt_pk_bf16(p0[14], p0[15])};
            pa[2] = (u32x4){pg8::cvt_pk_bf16(p1[0], p1[1]), pg8::cvt_pk_bf16(p1[2], p1[3]), pg8::cvt_pk_bf16(p1[4], p1[5]), pg8::cvt_pk_bf16(p1[6], p1[7])};
            pa[3] = (u32x4){pg8::cvt_pk_bf16(p1[8], p1[9]), pg8::cvt_pk_bf16(p1[10], p1[11]), pg8::cvt_pk_bf16(p1[12], p1[13]), pg8::cvt_pk_bf16(p1[14], p1[15])};
            const LAS unsigned char* vp = Vb + r32 * VPITCH + hi * 16;
            __builtin_amdgcn_s_setprio(1);
#pragma unroll
            for (int d = 0; d < 4; ++d)
#pragma unroll
                for (int s = 0; s < 4; ++s) { const bf16x8 vf = *(const LAS bf16x8*)(vp + d * 32 * VPITCH + s * 32);
                    o[d] = __builtin_amdgcn_mfma_f32_32x32x16_bf16(__builtin_bit_cast(bf16x8, pa[s]), vf, o[d], 0, 0, 0); }
            __builtin_amdgcn_s_setprio(0);
        }
        if (more) {
            LAS unsigned char* nb = lds + (st ^ 1) * STAGE;
#pragma unroll
            for (int i = 0; i < 3; ++i) *(LAS u32x4*)(nb + kdst[i]) = kreg[i];
#pragma unroll
            for (int i = 0; i < 2; ++i) *(LAS u32x4*)(nb + vdst[i]) = vreg[i];
        }
        __syncthreads();
    }
    lsum += __shfl_xor(lsum, 32);
    {
        if (hi == 0) wsf[r32] = 1.0f / lsum;
        asm volatile("s_waitcnt lgkmcnt(0)" ::: "memory");
        float ss[16];
#pragma unroll
        for (int g = 0; g < 4; ++g) { const f32x4 f = *(const LAS f32x4*)(wsf + 8 * g + 4 * hi);
#pragma unroll
            for (int j = 0; j < 4; ++j) { const float il = j == 0 ? f.x : j == 1 ? f.y : j == 2 ? f.z : f.w; float a = 0.f;
#pragma unroll
                for (int d = 0; d < 4; ++d) { o[d][4 * g + j] *= il; a += o[d][4 * g + j] * o[d][4 * g + j]; }
                ss[4 * g + j] = a; } }
#pragma unroll
        for (int r = 0; r < 16; ++r) {
#pragma unroll
            for (int of = 1; of < 32; of <<= 1) ss[r] += __shfl_xor(ss[r], of);
            ss[r] = rsqrtf(ss[r] * (1.f / 128.f) + EPS);
        }
        float gv[4];
#pragma unroll
        for (int d = 0; d < 4; ++d) gv[d] = g_attn[h * DV + d * 32 + r32];
#pragma unroll
        for (int r = 0; r < 16; ++r) { bf16* dst = mixed + (size_t)(m0 + crow(r, hi)) * D + DCONV + h * DV + r32;
#pragma unroll
            for (int d = 0; d < 4; ++d) dst[d * 32] = f2bf(o[d][r] * ss[r] * gv[d]); }
    }
    __syncthreads();
}
}

struct Ctx { int lane, wave, tid, gw, NGW, wg, G; LAS unsigned char* lds; };

template <int MODE> __device__ __forceinline__ int drow_of(int n) {
    if (MODE == 1) { const int bj = n / 2048, c = n % 2048; return 256 * (c / 128) + 128 * bj + (c % 128); }
    if (MODE == 2) { const int k64 = n >> 6, w = n & 63; if (k64 % 3 != 2) return n; const int part = w >> 5, i = w & 31; return (k64 << 6) + 32 * (i >> 4) + 8 * ((i & 15) >> 2) + 4 * part + (i & 3); }
    if (MODE == 3) { return (n & 128) ? -1 : (n >> 8) * 128 + (n & 127); }
    if (MODE == 4) { return (n & 128) ? (n >> 8) * 128 + (n & 127) : -1; }
    return n;
}
__device__ __forceinline__ void transpose_load(const float* W, int K, int N, int item, int lane, f32x4 (&v)[8]) {
    const int nblk = N / 32, kb = item / nblk, nb = item % nblk, k0 = 64 * kb, n0 = 32 * nb;
#pragma unroll
    for (int i = 0; i < 8; ++i) v[i] = __builtin_nontemporal_load((const f32x4*)(W + (size_t)(k0 + 8 * (lane >> 3) + i) * N + n0 + (lane & 7) * 4));
}
template <int MODE, bool FP8OUT>
__device__ __forceinline__ void transpose_store(const f32x4 (&v)[8], int K, int N, void* WTv, LAS float* scr, int item, int lane) {
    const int nblk = N / 32, kb = item / nblk, nb = item % nblk, k0 = 64 * kb, n0 = 32 * nb, kr = lane >> 3, c4 = lane & 7;
    static_assert(!FP8OUT, "the fp8 items use t128_store");
#pragma unroll
    for (int e = 0; e < 4; ++e) { const int dr = drow_of<MODE>(n0 + 4 * c4 + e);
        u32x4 o; o.x = pg8::cvt_pk_bf16(v[0][e], v[1][e]); o.y = pg8::cvt_pk_bf16(v[2][e], v[3][e]); o.z = pg8::cvt_pk_bf16(v[4][e], v[5][e]); o.w = pg8::cvt_pk_bf16(v[6][e], v[7][e]);
        if (dr >= 0) *(u32x4*)((bf16*)WTv + (size_t)dr * K + k0 + 8 * kr) = o; }
}
template <int MODE, bool FP8OUT>
__device__ __forceinline__ void transpose_item(const Ctx& c, const float* W, int K, int N, void* WT, int item) {
    LAS float* scr = (LAS float*)(c.lds + c.wave * 16384);
    f32x4 v[8]; transpose_load(W, K, N, item, c.lane, v);
    transpose_store<MODE, FP8OUT>(v, K, N, WT, scr, item, c.lane);
}
template <int MODE, bool FP8OUT>
__device__ __forceinline__ void transpose_item2(const Ctx& c, const float* W, int K, int N, void* WT, int item) {
    LAS float* scr0 = (LAS float*)(c.lds + c.wave * 16896); LAS float* scr1 = scr0 + 64 * 33;
    f32x4 v0[8], v1[8]; transpose_load(W, K, N, 2 * item, c.lane, v0); transpose_load(W, K, N, 2 * item + 1, c.lane, v1);
    transpose_store<MODE, FP8OUT>(v0, K, N, WT, scr0, 2 * item, c.lane);
    transpose_store<MODE, FP8OUT>(v1, K, N, WT, scr1, 2 * item + 1, c.lane);
}
__device__ __forceinline__ void transpose_item_kv2(const Ctx& c, const float* W, bf16* Wkv, bf16* WkvK, bf16* WkvV, int item) {
    LAS float* scr0 = (LAS float*)(c.lds + c.wave * 16896); LAS float* scr1 = scr0 + 64 * 33;
    f32x4 v0[8], v1[8]; transpose_load(W, KVL, 2048, 2 * item, c.lane, v0); transpose_load(W, KVL, 2048, 2 * item + 1, c.lane, v1);
    transpose_store<0, false>(v0, KVL, 2048, Wkv, scr0, 2 * item, c.lane); transpose_store<3, false>(v0, KVL, 2048, WkvK, scr0, 2 * item, c.lane); transpose_store<4, false>(v0, KVL, 2048, WkvV, scr0, 2 * item, c.lane);
    transpose_store<0, false>(v1, KVL, 2048, Wkv, scr1, 2 * item + 1, c.lane); transpose_store<3, false>(v1, KVL, 2048, WkvK, scr1, 2 * item + 1, c.lane); transpose_store<4, false>(v1, KVL, 2048, WkvV, scr1, 2 * item + 1, c.lane);
}
static_assert(8 * 16896 <= MISC_OFF, "transpose tiles vs LDS control words");
__device__ __forceinline__ void transpose_item_kv(const Ctx& c, const float* W, bf16* Wkv, bf16* WkvK, bf16* WkvV, int item) {
    LAS float* scr = (LAS float*)(c.lds + c.wave * 16384);
    f32x4 v[8]; transpose_load(W, KVL, 2048, item, c.lane, v);
    transpose_store<0, false>(v, KVL, 2048, Wkv, scr, item, c.lane);
    transpose_store<3, false>(v, KVL, 2048, WkvK, scr, item, c.lane);
    transpose_store<4, false>(v, KVL, 2048, WkvV, scr, item, c.lane);
}

constexpr int CONV_SCR = 128 * 33 * 4;
__device__ __forceinline__ void t128_load(const float* W, int N, int item, int lane, f32x4 (&v)[16]) {
    const int nblk = N / 32, kb = item / nblk, nb = item % nblk, k0 = 128 * kb, n0 = 32 * nb;
#pragma unroll
    for (int i = 0; i < 16; ++i) v[i] = __builtin_nontemporal_load((const f32x4*)(W + (size_t)(k0 + i * 8 + (lane >> 3)) * N + n0 + (lane & 7) * 4));
}
template <int MODE>
__device__ __forceinline__ void t128_store(const Ctx& c, const f32x4 (&v)[16], int K, int N, unsigned char* WT, int item) {
    LAS float* scr = (LAS float*)(c.lds + c.wave * CONV_SCR);
    const int nblk = N / 32, kb = item / nblk, nb = item % nblk, k0 = 128 * kb, n0 = 32 * nb, lane = c.lane;
#pragma unroll
    for (int i = 0; i < 16; ++i) { LAS float* d = scr + (i * 8 + (lane >> 3)) * 33 + (lane & 7) * 4; d[0] = v[i].x; d[1] = v[i].y; d[2] = v[i].z; d[3] = v[i].w; }
    LDS_WAIT(); asm volatile("" ::: "memory");
    const int cc = lane & 7;
#pragma unroll
    for (int j = 0; j < 4; ++j) { const int n = (lane >> 3) + 8 * j; const LAS float* s = scr + (16 * cc) * 33 + n; int w[4];
#pragma unroll
        for (int q = 0; q < 4; ++q) { int t = 0; t = __builtin_amdgcn_cvt_pk_fp8_f32(s[(4 * q) * 33] * WSCALE, s[(4 * q + 1) * 33] * WSCALE, t, false);
            t = __builtin_amdgcn_cvt_pk_fp8_f32(s[(4 * q + 2) * 33] * WSCALE, s[(4 * q + 3) * 33] * WSCALE, t, true); w[q] = t; }
        const int dr = drow_of<MODE>(n0 + n);
        __builtin_nontemporal_store((u32x4){(unsigned)w[0], (unsigned)w[1], (unsigned)w[2], (unsigned)w[3]}, (u32x4*)(WT + (size_t)dr * K + k0 + 16 * cc)); }
    LDS_WAIT(); asm volatile("" ::: "memory");
}
static_assert(8 * CONV_SCR <= MISC_OFF, "conversion tiles vs LDS control words");

constexpr int I_GU = NE * (D / 128) * (4096 / 32), I_D = NE * (DFF / 128) * (D / 32);
constexpr int CONV_TOTAL = I_D + I_GU, CONV_SLOTS = 1024;
constexpr int STOPW_OFF = MISC_OFF + 1536;
constexpr unsigned STOP_AT = 96u;
__device__ __forceinline__ unsigned stop_poll(const Ctx& c, const unsigned* p) {
    volatile LAS unsigned* w = (volatile LAS unsigned*)(c.lds + STOPW_OFF);
    if (c.wave == 0) { const unsigned v = __hip_atomic_load(p, __ATOMIC_RELAXED, __HIP_MEMORY_SCOPE_AGENT); if (c.lane == 0) *w = v; return (unsigned)__builtin_amdgcn_readfirstlane((int)v); }
    return *w;
}
__device__ __forceinline__ void cs_load(int it, int lane, const float* w_gu, const float* w_d, f32x4 (&v)[16]) {
    if (it < I_D) { constexpr int per = (DFF / 128) * (D / 32); t128_load(w_d + (size_t)(it / per) * DFF * D, D, it % per, lane, v); }
    else { const int r = it - I_D; constexpr int per = (D / 128) * (4096 / 32); t128_load(w_gu + (size_t)(r / per) * D * 4096, 4096, r % per, lane, v); }
}
__device__ __forceinline__ void cs_store(const Ctx& c, int it, const f32x4 (&v)[16], unsigned char* Wgu, unsigned char* Wd) {
    if (it < I_D) { constexpr int per = (DFF / 128) * (D / 32); t128_store<0>(c, v, DFF, D, Wd + (size_t)(it / per) * D * DFF, it % per); }
    else { const int r = it - I_D; constexpr int per = (D / 128) * (4096 / 32); t128_store<1>(c, v, D, 4096, Wgu + (size_t)(r / per) * 4096 * D, r % per); }
}
__device__ __forceinline__ int conv_stream(const Ctx& c, int j, int first, int step, const unsigned* stop, const float* w_gu, const float* w_d, unsigned char* Wgu, unsigned char* Wd) {
    int i = first;
    if (j + CONV_SLOTS * i >= CONV_TOTAL) return i;
    if (stop && stop_poll(c, stop) >= STOP_AT) return i;
    f32x4 va[16], vb[16];
    cs_load(j + CONV_SLOTS * i, c.lane, w_gu, w_d, va);
    for (;;) {
        { const int i2 = i + step; const bool more = j + CONV_SLOTS * i2 < CONV_TOTAL && !(stop && stop_poll(c, stop) >= STOP_AT);
          cs_load(j + CONV_SLOTS * (more ? i2 : i), c.lane, w_gu, w_d, vb);
          cs_store(c, j + CONV_SLOTS * i, va, Wgu, Wd); i = i2; if (!more) break; }
        { const int i2 = i + step; const bool more = j + CONV_SLOTS * i2 < CONV_TOTAL && !(stop && stop_poll(c, stop) >= STOP_AT);
          cs_load(j + CONV_SLOTS * (more ? i2 : i), c.lane, w_gu, w_d, va);
          cs_store(c, j + CONV_SLOTS * i, vb, Wgu, Wd); i = i2; if (!more) break; }
    }
    return i;
}

__device__ __forceinline__ void norm1_rows2(int R0, int lane, const float* x, const float* meta, const float* g, bf16* hn) {
    f32x4 v[2][8]; float ss[2] = {0.f, 0.f};
#pragma unroll
    for (int q = 0; q < 2; ++q) { const int R = R0 + q; const float* src = R < M ? x + (size_t)R * D : meta + (size_t)(R - M) * D;
#pragma unroll
        for (int j = 0; j < 8; ++j) v[q][j] = __builtin_nontemporal_load((const f32x4*)(src + j * 256 + lane * 4)); }
#pragma unroll
    for (int q = 0; q < 2; ++q)
#pragma unroll
        for (int j = 0; j < 8; ++j) ss[q] += v[q][j].x * v[q][j].x + v[q][j].y * v[q][j].y + v[q][j].z * v[q][j].z + v[q][j].w * v[q][j].w;
#pragma unroll
    for (int q = 0; q < 2; ++q) { const float rstd = rsqrtf(wave_sum(ss[q]) * (1.f / D) + EPS);
#pragma unroll
        for (int j = 0; j < 8; ++j) { const f32x4 gg = *(const f32x4*)(g + j * 256 + lane * 4);
            u32x2 o; o.x = pk2(v[q][j].x * rstd * gg.x, v[q][j].y * rstd * gg.y); o.y = pk2(v[q][j].z * rstd * gg.z, v[q][j].w * rstd * gg.w);
            *(u32x2*)(hn + (size_t)(R0 + q) * D + j * 256 + lane * 4) = o; } }
}
constexpr int META_WGS = DIN / 64;
__device__ __forceinline__ void meta_proj(const Ctx& c, const float* __restrict__ meta, const float* __restrict__ g_mix, const float* __restrict__ w_in, bf16* __restrict__ proj) {
    constexpr int HQP = 68;
    LAS float* hmq = (LAS float*)c.lds;
    {
        f32x4 v[2][8];
#pragma unroll
        for (int q = 0; q < 2; ++q)
#pragma unroll
            for (int j = 0; j < 8; ++j) v[q][j] = *(const f32x4*)(meta + (size_t)(c.wave + 8 * q) * D + j * 256 + c.lane * 4);
#pragma unroll
        for (int q = 0; q < 2; ++q) { const int r = c.wave + 8 * q; float ss = 0.f;
#pragma unroll
            for (int j = 0; j < 8; ++j) ss += v[q][j].x * v[q][j].x + v[q][j].y * v[q][j].y + v[q][j].z * v[q][j].z + v[q][j].w * v[q][j].w;
            const float rstd = rsqrtf(wave_sum(ss) * (1.f / D) + EPS);
#pragma unroll
            for (int j = 0; j < 8; ++j) { const f32x4 gg = *(const f32x4*)(g_mix + j * 256 + c.lane * 4);
                *(LAS f32x4*)(hmq + (j * 64 + c.lane) * HQP + r * 4) = (f32x4){v[q][j].x * rstd * gg.x, v[q][j].y * rstd * gg.y, v[q][j].z * rstd * gg.z, v[q][j].w * rstd * gg.w}; } }
    }
    typedef float f32x2 __attribute__((ext_vector_type(2)));
    const int cg = c.lane & 15, kq = c.lane >> 4, ks = c.wave;
    f32x2 acc[16][2];
#pragma unroll
    for (int r = 0; r < 16; ++r) { acc[r][0] = (f32x2){0.f, 0.f}; acc[r][1] = (f32x2){0.f, 0.f}; }
    __syncthreads();
    const float* wp = w_in + (size_t)(ks * 256 + 4 * kq) * DIN + c.wg * 64 + 4 * cg;
#pragma unroll 1
    for (int sb = 0; sb < 4; ++sb) {
        f32x4 w[4][4];
#pragma unroll
        for (int s = 0; s < 4; ++s)
#pragma unroll
            for (int i = 0; i < 4; ++i) w[s][i] = __builtin_nontemporal_load((const f32x4*)(wp + (size_t)((sb * 4 + s) * 16 + i) * DIN));
#pragma unroll
        for (int s = 0; s < 4; ++s) { const LAS float* hp = hmq + (ks * 64 + (sb * 4 + s) * 4 + kq) * HQP; __builtin_amdgcn_sched_barrier(0);
#pragma unroll
            for (int r = 0; r < 16; ++r) { const f32x4 h = *(const LAS f32x4*)(hp + r * 4);
#pragma unroll
                for (int i = 0; i < 4; ++i) { const f32x2 hh = (f32x2){h[i], h[i]};
                    acc[r][0] = __builtin_elementwise_fma(hh, (f32x2){w[s][i].x, w[s][i].y}, acc[r][0]); acc[r][1] = __builtin_elementwise_fma(hh, (f32x2){w[s][i].z, w[s][i].w}, acc[r][1]); } } }
    }
    __syncthreads();
    LAS float* part = (LAS float*)c.lds;
#pragma unroll
    for (int r = 0; r < 16; ++r) *(LAS f32x4*)(part + ((ks * 4 + kq) * 16 + r) * 64 + 4 * cg) = (f32x4){acc[r][0].x, acc[r][0].y, acc[r][1].x, acc[r][1].y};
    __syncthreads();
    for (int o = c.tid; o < 16 * 64; o += NWAVES * 64) { const int r = o >> 6, cc = o & 63; float s = 0.f;
#pragma unroll
        for (int q = 0; q < 32; ++q) s += part[(q * 16 + r) * 64 + cc];
        proj[(size_t)(M + r) * DINP + c.wg * 64 + cc] = f2bf(s); }
    __syncthreads();
}

struct EpiKV {
    bf16* kn; bf16* vv; int roff;
    __device__ void operator()(int r, int n, float v) const {
        const int R = r + roff; if (R < M || R >= MR) return;
        const int h = n >> 8, part = (n >> 7) & 1, d = n & 127, pos = R - M; const bf16 o = f2bf(v);
        for (int b = 0; b < NB; ++b) {
            if (part) vv[((size_t)(b * NH + h) * 128 + d) * LP + pos] = o;
            else kn[((size_t)(b * LP + pos) * NH + h) * 128 + d] = o;
        }
    }
};
struct EpiMeta {
    bf16* proj;
    __device__ void operator()(int r, int n, float v) const { if (r < NMETA) proj[(size_t)(M + r) * DINP + n] = f2bf(v); }
};
template <class Epi, int UNR = 2>
__device__ __forceinline__ void gemm_simple(const Ctx& c, const bf16* __restrict__ A, int lda, const bf16* __restrict__ Bt, int ldb, int K, int nMt, int nNt, const Epi& epi) {
    const int r = c.lane & 15, q = c.lane >> 4;
    for (int wt = c.gw; wt < nMt * nNt; wt += c.NGW) {
        const int m0 = (wt / nNt) * 32, n0 = (wt % nNt) * 32;
        f32x4 acc[2][2];
#pragma unroll
        for (int i = 0; i < 2; ++i)
#pragma unroll
            for (int j = 0; j < 2; ++j) acc[i][j] = (f32x4){0.f, 0.f, 0.f, 0.f};
        const bf16* a0 = A + (size_t)(m0 + r) * lda + 8 * q; const bf16* b0 = Bt + (size_t)(n0 + r) * ldb + 8 * q;
#pragma unroll UNR
        for (int k0 = 0; k0 < K; k0 += 32) {
            bf16x8 a[2], b[2];
#pragma unroll
            for (int i = 0; i < 2; ++i) { a[i] = *(const bf16x8*)(a0 + (size_t)i * 16 * lda + k0); b[i] = *(const bf16x8*)(b0 + (size_t)i * 16 * ldb + k0); }
#pragma unroll
            for (int i = 0; i < 2; ++i)
#pragma unroll
                for (int j = 0; j < 2; ++j) acc[i][j] = __builtin_amdgcn_mfma_f32_16x16x32_bf16(a[i], b[j], acc[i][j], 0, 0, 0);
        }
#pragma unroll
        for (int i = 0; i < 2; ++i)
#pragma unroll
            for (int j = 0; j < 2; ++j)
#pragma unroll
                for (int t = 0; t < 4; ++t) epi(m0 + i * 16 + q * 4 + t, n0 + j * 16 + r, acc[i][j][t]);
    }
}

__device__ __forceinline__ float inv_freq(int i) { return powf(10000.0f, -(float)i / 32.0f); }

__device__ __forceinline__ void postproj_row(int R, int lane, const bf16* __restrict__ proj, const float* __restrict__ conv_w, const float* __restrict__ g_conv,
                                             const float* __restrict__ g_q, const float* __restrict__ g_kv,
                                             bf16* __restrict__ mixed, bf16* __restrict__ qn, bf16* __restrict__ kvn, bf16* __restrict__ kpe, const float* __restrict__ cosT, const float* __restrict__ sinT) {
    const bf16* pr = proj + (size_t)R * DINP;
    const bool meta = R >= M; const int b = meta ? 0 : R / S, t = meta ? 0 : R % S, pos = meta ? R - M : t + NMETA;
    {
        const u32x2 w = *(const u32x2*)(pr + O_KV + lane * 4);
        float f[4] = {__uint_as_float(w.x << 16), __uint_as_float(w.x & 0xffff0000u), __uint_as_float(w.y << 16), __uint_as_float(w.y & 0xffff0000u)};
        const float ss = wave_sum(f[0] * f[0] + f[1] * f[1] + f[2] * f[2] + f[3] * f[3]);
        const float rstd = rsqrtf(ss * (1.f / KVL) + EPS);
        const f32x4 g = *(const f32x4*)(g_kv + lane * 4);
        u32x2 o; o.x = pk2(f[0] * rstd * g.x, f[1] * rstd * g.y); o.y = pk2(f[2] * rstd * g.z, f[3] * rstd * g.w);
        *(u32x2*)(kvn + (size_t)R * KVL + lane * 4) = o;
    }
    if (lane < 32) {
        const float x1 = bf2f(pr[O_R + lane]), x2 = bf2f(pr[O_R + 32 + lane]);
        const float cs = cosT[pos * 32 + lane], sn = sinT[pos * 32 + lane];
        const bf16 o1 = f2bf(x1 * cs - x2 * sn), o2 = f2bf(x1 * sn + x2 * cs);
        if (!meta) { bf16* d = kpe + (size_t)(b * LP + pos) * ROPE; d[lane] = o1; d[32 + lane] = o2; }
        else { bf16* d0 = kpe + (size_t)(0 * LP + pos) * ROPE; bf16* d1 = kpe + (size_t)(1 * LP + pos) * ROPE; d0[lane] = o1; d0[32 + lane] = o2; d1[lane] = o1; d1[32 + lane] = o2; }
    }
    if (meta) return;
    {
        float f[8]; unpack8(*(const u32x4*)(pr + O_Q + lane * 8), f);
        float ss = 0.f;
#pragma unroll
        for (int i = 0; i < 8; ++i) ss += f[i] * f[i];
        const float rstd = rsqrtf(wave_sum(ss) * (1.f / QL) + EPS);
        const f32x4 g0 = *(const f32x4*)(g_q + lane * 8), g1 = *(const f32x4*)(g_q + lane * 8 + 4);
        u32x4 o; o.x = pk2(f[0] * rstd * g0.x, f[1] * rstd * g0.y); o.y = pk2(f[2] * rstd * g0.z, f[3] * rstd * g0.w);
        o.z = pk2(f[4] * rstd * g1.x, f[5] * rstd * g1.y); o.w = pk2(f[6] * rstd * g1.z, f[7] * rstd * g1.w);
        *(u32x4*)(qn + (size_t)R * QL + lane * 8) = o;
    }
    {
        const int r1 = (t >= 1) ? R - 1 : M + 15, r2 = (t >= 2) ? R - 2 : (t == 1 ? M + 15 : M + 14);
        const bf16* p1 = proj + (size_t)r1 * DINP; const bf16* p2 = proj + (size_t)r2 * DINP;
        const int c0 = lane * 16;
        float v[16]; float ss = 0.f;
#pragma unroll
        for (int hh = 0; hh < 2; ++hh) {
            const int c = c0 + hh * 8;
            float bg[8], cg0[8], ui0[8], cg1[8], ui1[8], cg2[8], ui2[8];
            unpack8(*(const u32x4*)(pr + c), bg); unpack8(*(const u32x4*)(pr + O_C + c), cg0); unpack8(*(const u32x4*)(pr + O_U + c), ui0);
            unpack8(*(const u32x4*)(p1 + O_C + c), cg1); unpack8(*(const u32x4*)(p1 + O_U + c), ui1);
            unpack8(*(const u32x4*)(p2 + O_C + c), cg2); unpack8(*(const u32x4*)(p2 + O_U + c), ui2);
#pragma unroll
            for (int i = 0; i < 8; ++i) {
                const float y = conv_w[2 * DCONV + c + i] * (cg0[i] * ui0[i]) + conv_w[1 * DCONV + c + i] * (cg1[i] * ui1[i]) + conv_w[0 * DCONV + c + i] * (cg2[i] * ui2[i]);
                const float o = bg[i] * y; v[hh * 8 + i] = o; ss += o * o;
            }
        }
        ss += __shfl_xor(ss, 1); ss += __shfl_xor(ss, 2);
        const float rstd = rsqrtf(ss * (1.f / 64.f) + EPS);
#pragma unroll
        for (int hh = 0; hh < 2; ++hh) {
            const int c = c0 + hh * 8;
            const f32x4 g0 = *(const f32x4*)(g_conv + c), g1 = *(const f32x4*)(g_conv + c + 4);
            u32x4 o; o.x = pk2(v[hh * 8 + 0] * rstd * g0.x, v[hh * 8 + 1] * rstd * g0.y); o.y = pk2(v[hh * 8 + 2] * rstd * g0.z, v[hh * 8 + 3] * rstd * g0.w);
            o.z = pk2(v[hh * 8 + 4] * rstd * g1.x, v[hh * 8 + 5] * rstd * g1.y); o.w = pk2(v[hh * 8 + 6] * rstd * g1.z, v[hh * 8 + 7] * rstd * g1.w);
            *(u32x4*)(mixed + (size_t)R * D + c) = o;
        }
    }
}

constexpr int RPITCH = 516;
constexpr int RA_OFF = 0, RB_OFF = 32 * RPITCH * 4, RC_OFF = 2 * 32 * RPITCH * 4;
static_assert(RC_OFF + 3 * 32 * 4 <= MISC_OFF, "router LDS");
__device__ __forceinline__ void router_block(const Ctx& c, int blk, const float* __restrict__ h1, const float* __restrict__ g_ffn, const float* __restrict__ Wrt, const float* __restrict__ b_r,
                                             bf16* __restrict__ xn, unsigned* __restrict__ cnt, int* __restrict__ rowtok, int* __restrict__ tok_e, int* __restrict__ tok_p, float* __restrict__ gate) {
    LAS float* As = (LAS float*)(c.lds + RA_OFF); LAS float* Bs = (LAS float*)(c.lds + RB_OFF); LAS float* srstd = (LAS float*)(c.lds + RC_OFF);
    LAS float* part = As;
    const int lane = c.lane, m0 = blk * 32;
    f32x4 v[4][8];
#pragma unroll
    for (int r = 0; r < 4; ++r) { const float* src = h1 + (size_t)(m0 + c.wave * 4 + r) * D;
#pragma unroll
        for (int j = 0; j < 8; ++j) v[r][j] = *(const f32x4*)(src + j * 256 + lane * 4); }
    {
        f32x4 gg[8]; float ss[4];
#pragma unroll
        for (int j = 0; j < 8; ++j) gg[j] = *(const f32x4*)(g_ffn + j * 256 + lane * 4);
#pragma unroll
        for (int r = 0; r < 4; ++r) { ss[r] = 0.f;
#pragma unroll
            for (int j = 0; j < 8; ++j) ss[r] += v[r][j].x * v[r][j].x + v[r][j].y * v[r][j].y + v[r][j].z * v[r][j].z + v[r][j].w * v[r][j].w; }
#pragma unroll
        for (int r = 0; r < 4; ++r) { const int m = m0 + c.wave * 4 + r;
            const float rstd = rsqrtf(wave_sum(ss[r]) * (1.f / D) + EPS);
#pragma unroll
            for (int j = 0; j < 8; ++j) {
                int w = 0; w = __builtin_amdgcn_cvt_pk_fp8_f32(v[r][j].x * rstd * gg[j].x, v[r][j].y * rstd * gg[j].y, w, false); w = __builtin_amdgcn_cvt_pk_fp8_f32(v[r][j].z * rstd * gg[j].z, v[r][j].w * rstd * gg[j].w, w, true);
                *(int*)((unsigned char*)xn + (size_t)m * D + j * 256 + lane * 4) = w; }
            if (lane == 0) srstd[c.wave * 4 + r] = rstd; }
    }
    f32x4 wb[4][2];
#pragma unroll
    for (int r = 0; r < 4; ++r)
#pragma unroll
        for (int jj = 0; jj < 2; ++jj) wb[r][jj] = *(const f32x4*)(Wrt + (size_t)(c.wave * 4 + r) * D + jj * 256 + lane * 4);
    f32x4 acc[2][2];
#pragma unroll
    for (int a = 0; a < 2; ++a)
#pragma unroll
        for (int b = 0; b < 2; ++b) acc[a][b] = (f32x4){0.f, 0.f, 0.f, 0.f};
    const int row = lane & 15, kq = lane >> 4;
#pragma unroll
    for (int q = 0; q < 4; ++q) {
#pragma unroll
        for (int r = 0; r < 4; ++r)
#pragma unroll
            for (int jj = 0; jj < 2; ++jj) { *(LAS f32x4*)(As + (c.wave * 4 + r) * RPITCH + jj * 256 + lane * 4) = v[r][2 * q + jj]; *(LAS f32x4*)(Bs + (c.wave * 4 + r) * RPITCH + jj * 256 + lane * 4) = wb[r][jj]; }
        if (q < 3) {
#pragma unroll
            for (int r = 0; r < 4; ++r)
#pragma unroll
                for (int jj = 0; jj < 2; ++jj) wb[r][jj] = *(const f32x4*)(Wrt + (size_t)(c.wave * 4 + r) * D + (q + 1) * 512 + jj * 256 + lane * 4);
        }
        __syncthreads();
#pragma unroll
        for (int g = 0; g < 4; ++g) { const int k0 = 64 * c.wave + 16 * g + 4 * kq;
            const f32x4 a0 = *(const LAS f32x4*)(As + row * RPITCH + k0), a1 = *(const LAS f32x4*)(As + (16 + row) * RPITCH + k0);
            const f32x4 b0 = *(const LAS f32x4*)(Bs + row * RPITCH + k0), b1 = *(const LAS f32x4*)(Bs + (16 + row) * RPITCH + k0);
#pragma unroll
            for (int i = 0; i < 4; ++i) {
                acc[0][0] = __builtin_amdgcn_mfma_f32_16x16x4f32(a0[i], b0[i], acc[0][0], 0, 0, 0); acc[0][1] = __builtin_amdgcn_mfma_f32_16x16x4f32(a0[i], b1[i], acc[0][1], 0, 0, 0);
                acc[1][0] = __builtin_amdgcn_mfma_f32_16x16x4f32(a1[i], b0[i], acc[1][0], 0, 0, 0); acc[1][1] = __builtin_amdgcn_mfma_f32_16x16x4f32(a1[i], b1[i], acc[1][1], 0, 0, 0); } }
        __syncthreads();
    }
#pragma unroll
    for (int rt = 0; rt < 2; ++rt)
#pragma unroll
        for (int et = 0; et < 2; ++et)
#pragma unroll
            for (int t = 0; t < 4; ++t) part[(c.wave * 32 + rt * 16 + kq * 4 + t) * 32 + et * 16 + row] = acc[rt][et][t];
    __syncthreads();
    LAS unsigned* lhist = (LAS unsigned*)(srstd + 32); LAS unsigned* lbase = lhist + 32;
    if (c.tid < 32) lhist[c.tid] = 0u;
    __syncthreads();
    int se[4][4]; unsigned sr[4][4]; float sg[4][4];
#pragma unroll
    for (int r = 0; r < 4; ++r) {
        const int lr = c.wave * 4 + r;
        float logit = -INFINITY;
        if (lane < NE) { float s = 0.f;
#pragma unroll
            for (int w = 0; w < 8; ++w) s += part[(w * 32 + lr) * 32 + lane];
            logit = s * srstd[lr] + b_r[lane]; }
        float tv[4];
#pragma unroll
        for (int k = 0; k < 4; ++k) {
            const float mxv = wave_max(logit);
            const unsigned long long mask = __ballot(logit == mxv);
            const int idx = __ffsll((long long)mask) - 1;
            tv[k] = mxv; se[r][k] = idx;
            if (lane == idx) logit = -INFINITY;
        }
        float es = 0.f;
#pragma unroll
        for (int k = 0; k < 4; ++k) { sg[r][k] = expf(tv[k] - tv[0]); es += sg[r][k]; }
        const float inv = 1.0f / es;
#pragma unroll
        for (int k = 0; k < 4; ++k) { sg[r][k] *= inv; sr[r][k] = 0u; if (lane == 0) sr[r][k] = __hip_atomic_fetch_add(&lhist[se[r][k]], 1u, __ATOMIC_RELAXED, __HIP_MEMORY_SCOPE_WORKGROUP); }
    }
    __syncthreads();
    if (c.tid < NE) lbase[c.tid] = atomicAdd(&cnt[c.tid * CNT_STRIDE], lhist[c.tid]);
    __syncthreads();
    if (lane == 0) {
#pragma unroll
        for (int r = 0; r < 4; ++r) { const int m = m0 + c.wave * 4 + r;
#pragma unroll
            for (int k = 0; k < 4; ++k) { const int e = se[r][k]; const unsigned p = lbase[e] + sr[r][k];
                rowtok[e * M + p] = m; tok_e[m * 4 + k] = e; tok_p[m * 4 + k] = (int)p; gate[m * 4 + k] = sg[r][k]; } }
    }
    __syncthreads();
}

__device__ __forceinline__ void combine_row(int m, int lane, const float* __restrict__ h1, const bf16* __restrict__ y, const unsigned* __restrict__ cnt, const int* __restrict__ tok_e, const int* __restrict__ tok_p,
                                            const float* __restrict__ gate, const float* __restrict__ g_final, float* __restrict__ out) {
    size_t yrow[4]; float gk[4];
#pragma unroll
    for (int k = 0; k < 4; ++k) {
        const int e = tok_e[m * 4 + k]; const int off = (int)cnt[e];
        yrow[k] = (size_t)(off + tok_p[m * 4 + k]) * D; gk[k] = gate[m * 4 + k];
    }
    f32x4 v[8]; float ss = 0.f;
#pragma unroll
    for (int j = 0; j < 8; ++j) {
        const int idx = j * 256 + lane * 4;
        f32x4 a = *(const f32x4*)(h1 + (size_t)m * D + idx);
#pragma unroll
        for (int k = 0; k < 4; ++k) { const u32x2 w = *(const u32x2*)(y + yrow[k] + idx);
            a.x += gk[k] * __uint_as_float(w.x << 16); a.y += gk[k] * __uint_as_float(w.x & 0xffff0000u); a.z += gk[k] * __uint_as_float(w.y << 16); a.w += gk[k] * __uint_as_float(w.y & 0xffff0000u); }
        v[j] = a; ss += a.x * a.x + a.y * a.y + a.z * a.z + a.w * a.w;
    }
    const float rstd = rsqrtf(wave_sum(ss) * (1.f / D) + EPS);
#pragma unroll
    for (int j = 0; j < 8; ++j) { const int idx = j * 256 + lane * 4; const f32x4 gg = *(const f32x4*)(g_final + idx);
        *(f32x4*)(out + (size_t)m * D + idx) = (f32x4){v[j].x * rstd * gg.x, v[j].y * rstd * gg.y, v[j].z * rstd * gg.z, v[j].w * rstd * gg.w}; }
}


constexpr int TAB_OFF = MISC_OFF + 128, FTAB_OFF = MISC_OFF + 384  , HTAB_OFF = MISC_OFF + 520, TMAP_OFF = MISC_OFF + 656, TMAP_MAX = 160;
static_assert(TMAP_OFF + TMAP_MAX * 4 <= MISC_OFF + 1536, "tile map vs stop word");
static_assert((TMAP_OFF - TAB_OFF) / 4 == pg8::TMAP_REL, "tile map offset");
__device__ __forceinline__ const LAS int* build_expert_table(const Ctx& c, const unsigned* cnt) {
    LAS int* tab = (LAS int*)(c.lds + TAB_OFF); LAS int* ftab = (LAS int*)(c.lds + FTAB_OFF); LAS int* htab = (LAS int*)(c.lds + HTAB_OFF); LAS int* tmap = (LAS int*)(c.lds + TMAP_OFF);
    if (c.tid < 64) {
        const int n = c.lane < NE ? (int)cnt[c.lane * CNT_STRIDE] : 0; const int t = (n + 255) / 256, hf = (t > 0 && n - (t - 1) * 256 <= 128) ? 1 : 0, fl = t - hf;
        int it = t, ifl = fl, ih = hf;
#pragma unroll
        for (int o = 1; o < 32; o <<= 1) { const int v = __shfl_up(it, o), vf = __shfl_up(ifl, o), vh = __shfl_up(ih, o); if (c.lane >= o) { it += v; ifl += vf; ih += vh; } }
        if (c.lane < NE) { tab[c.lane + 1] = it; ftab[c.lane] = ifl - fl; htab[c.lane] = ih - hf; }
        if (c.lane == NE - 1) ftab[NE] = ifl;
        if (c.lane == 0) tab[0] = 0;
    }
    __syncthreads();
    if (c.tid < tab[NE]) { const int p = c.tid; int e = 0;
#pragma unroll
        for (int j = 1; j < NE; ++j) e += (p >= tab[j]) ? 1 : 0;
        const int lt = p - tab[e], nr = (int)cnt[e * CNT_STRIDE] - lt * 256, pos = nr <= 128 ? ftab[NE] + htab[e] : ftab[e] + lt;
        tmap[pos] = p | e << 8 | (nr < 256 ? nr : 256) << 16; }
    __syncthreads();
    return tab;
}

__device__ __forceinline__ Ctx make_ctx() {
    extern __shared__ __attribute__((aligned(16))) unsigned char lds_raw[];
    Ctx c; int t = threadIdx.x; asm volatile("" : "+v"(t));
    c.lds = (LAS unsigned char*)lds_raw; c.tid = t; c.lane = t & 63; c.wave = __builtin_amdgcn_readfirstlane(t >> 6);
    c.G = gridDim.x; c.wg = blockIdx.x; c.gw = c.wg * NWAVES + c.wave; c.NGW = c.G * NWAVES;
    return c;
}
constexpr int DR_OFF = 8 * CONV_SCR;
static_assert(DR_OFF + (1025 + 1024 + 8) * 4 <= MISC_OFF && CONV_SLOTS == 2 * NWAVES * 64, "drain tables vs LDS control words");
__device__ __forceinline__ void drain_balanced(const Ctx& c, const unsigned* ctl, const float* w_gu, const float* w_d, unsigned char* Wgu, unsigned char* Wd) {
    LAS int* pre = (LAS int*)(c.lds + DR_OFF); LAS int* prog = pre + 1025; LAS int* wt = prog + 1024;
    __syncthreads();
    int n0 = (int)ctl[CW_PROG + 2 * c.tid], n1 = (int)ctl[CW_PROG + 2 * c.tid + 1];
    const int N0 = (CONV_TOTAL - 2 * c.tid + CONV_SLOTS - 1) / CONV_SLOTS, N1 = (CONV_TOTAL - (2 * c.tid + 1) + CONV_SLOTS - 1) / CONV_SLOTS;
    const int l0 = N0 > n0 ? N0 - n0 : 0, l1 = N1 > n1 ? N1 - n1 : 0;
    int incl = l0 + l1;
#pragma unroll
    for (int o = 1; o < 64; o <<= 1) { const int v = __shfl_up(incl, o); if (c.lane >= o) incl += v; }
    if (c.lane == 63) wt[c.wave] = incl;
    prog[2 * c.tid] = n0; prog[2 * c.tid + 1] = n1;
    __syncthreads();
    int base = 0, total = 0;
#pragma unroll
    for (int w = 0; w < NWAVES; ++w) { const int t = wt[w]; base += (w < c.wave) ? t : 0; total += t; }
    const int excl = base + incl - (l0 + l1);
    pre[2 * c.tid] = excl; pre[2 * c.tid + 1] = excl + l0;
    if (c.tid == 0) pre[1024] = total;
    __syncthreads();
    const int lo = __builtin_amdgcn_readfirstlane((int)((long long)c.gw * total / c.NGW)), hi = __builtin_amdgcn_readfirstlane((int)((long long)(c.gw + 1) * total / c.NGW));
    if (lo < hi) {
        int s = 0;
#pragma unroll
        for (int b = 512; b >= 1; b >>= 1) { if (pre[s + b] <= lo) s += b; }
        s = __builtin_amdgcn_readfirstlane(s);
        auto item_of = [&](int v) -> int { while (v >= pre[s + 1]) ++s; return s + CONV_SLOTS * (prog[s] + (v - pre[s])); };
        int v = lo; int it = __builtin_amdgcn_readfirstlane(item_of(v));
        f32x4 va[16], vb[16];
        cs_load(it, c.lane, w_gu, w_d, va);
        for (;;) {
            { const int v2 = v + 1; const bool more = v2 < hi; const int it2 = more ? __builtin_amdgcn_readfirstlane(item_of(v2)) : it;
              cs_load(it2, c.lane, w_gu, w_d, vb); cs_store(c, it, va, Wgu, Wd); v = v2; it = it2; if (!more) break; }
            { const int v2 = v + 1; const bool more = v2 < hi; const int it2 = more ? __builtin_amdgcn_readfirstlane(item_of(v2)) : it;
              cs_load(it2, c.lane, w_gu, w_d, va); cs_store(c, it, vb, Wgu, Wd); v = v2; it = it2; if (!more) break; }
        }
    }
    __syncthreads();
}
constexpr bool SPLIT_P1 = true, SPLIT_P3 = true;
struct Args { const float* in[20]; float* out; unsigned char* ws; int ph_lo, ph_hi; };
#define KA() ({ const __attribute__((address_space(4))) Args* _p = (const __attribute__((address_space(4))) Args*)__builtin_amdgcn_kernarg_segment_ptr(); asm volatile("" : "+s"(_p)); _p; })
#define WSP(T, off) ((T*)(ws + (off)))
#define PHASE_PTRS \
    const auto ka = KA(); unsigned char* const ws = ka->ws; unsigned* const cnt = (unsigned*)(ws + WS_CTL) + CW_CNT; (void)cnt; \
    bf16* const Win = WSP(bf16, WS_WIN); bf16* const Wq = WSP(bf16, WS_WQ); bf16* const Wkv = WSP(bf16, WS_WKV); bf16* const Wout = WSP(bf16, WS_WOUT); bf16* const Wgu = WSP(bf16, WS_WGU); bf16* const Wd = WSP(bf16, WS_WD); \
    bf16* const hn = WSP(bf16, WS_HN); bf16* const proj = WSP(bf16, WS_PROJ); bf16* const mixed = WSP(bf16, WS_MIXED); bf16* const qn = WSP(bf16, WS_QN); bf16* const kvn = WSP(bf16, WS_KVN); \
    bf16* const WkvK = WSP(bf16, WS_WKVK); bf16* const WkvV = WSP(bf16, WS_WKVV); float* const cosT = WSP(float, WS_COS); float* const sinT = WSP(float, WS_SIN); float* const Wrt = WSP(float, WS_WRT); (void)Wrt; bf16* const Q = WSP(bf16, WS_Q); \
    bf16* const Kn = WSP(bf16, WS_KN); bf16* const V = WSP(bf16, WS_V); bf16* const Kpe = WSP(bf16, WS_KPE); float* const h1 = WSP(float, WS_H1); bf16* const xn = WSP(bf16, WS_XN); \
    int* const tok_e = WSP(int, WS_TOKE); int* const tok_p = WSP(int, WS_TOKP); float* const gate = WSP(float, WS_GATE); int* const rowtok = WSP(int, WS_ROWTOK); bf16* const act = WSP(bf16, WS_ACT); bf16* const y = WSP(bf16, WS_Y); \
    (void)Win; (void)Wq; (void)Wkv; (void)Wout; (void)Wgu; (void)Wd; (void)hn; (void)proj; (void)mixed; (void)qn; (void)kvn; (void)WkvK; (void)WkvV; (void)cosT; (void)sinT; (void)Q; (void)Kn; (void)V; (void)Kpe; \
    (void)h1; (void)xn; (void)tok_e; (void)tok_p; (void)gate; (void)rowtok; (void)act; (void)y
#define INP(k) (ka->in[k])
__device__ __forceinline__ void phase0() { const Ctx c = make_ctx(); PHASE_PTRS;
        constexpr bool splitp0 = false;
        const int lgw = splitp0 ? c.gw - META_WGS * NWAVES : c.gw, lngw = splitp0 ? c.NGW - META_WGS * NWAVES : c.NGW;
        constexpr int I_IN = (D / 64) * (DIN / 64), I_OUT = (D / 64) * (D / 64), I_Q = (QL / 64) * (1536 / 64), I_KV = (KVL / 64) * (2048 / 64);
        constexpr int I_ROWS = MR / 2, I_ZERO = (DINP - DIN) * D / 8 / 64, I_ROPE = (S + NMETA) * 32 / 64, I_WRT = NE * D / 64;
        constexpr int E1 = 0, E2 = E1 + I_IN, E3 = E2 + I_OUT, E4 = E3 + I_Q, E5 = E4 + I_KV, E6 = E5 + I_ROWS, E7 = E6 + I_ZERO, E8 = E7 + I_ROPE, E9 = E8 + I_WRT;
        for (int it = lgw; it < E9; it += lngw) {
            if (false) {}
            else if (it < E2) transpose_item2<0, false>(c, INP(3), D, DIN, Win, it - E1);
            else if (it < E3) transpose_item2<0, false>(c, INP(11), D, D, Wout, it - E2);
            else if (it < E4) transpose_item2<2, false>(c, INP(6), QL, 1536, Wq, it - E3);
            else if (it < E5) transpose_item_kv2(c, INP(8), Wkv, WkvK, WkvV, it - E4);
            else if (it < E6) { const int R = 2 * (it - E5); norm1_rows2(R, c.lane, INP(0), INP(1), INP(2), hn); }
            else if (it < E7) { const int i = (it - E6) * 64 + c.lane; ((u32x4*)(Win + (size_t)DIN * D))[i] = (u32x4){0u, 0u, 0u, 0u}; }
            else if (it < E8) { const int i = (it - E7) * 64 + c.lane; const float ang = (float)(i >> 5) * inv_freq(i & 31); cosT[i] = cosf(ang); sinT[i] = sinf(ang); }
            else { const int i = (it - E8) * 64 + c.lane; const int e = i >> 11, k = i & (D - 1); Wrt[i] = INP(12)[k] * INP(13)[k * NE + e]; }
        }
    }
__device__ __forceinline__ void phase1() { const Ctx c = make_ctx(); PHASE_PTRS;
        unsigned* ctl = (unsigned*)(ws + WS_CTL);
        if (c.G != 256 || !SPLIT_P1) {
            pg8::Gemm g{hn, D * 2}; pg8::PlainSched Sc; Sc.init(Win, M, DINP, D, c.G, c.wg);
            pg8::gemm_phase<pg8::EpiStoreBf16, pg8::PlainSched, true>(c.lds, g, Sc, pg8::EpiStoreBf16{proj, DINP});
            { const Ctx c2 = make_ctx(); gemm_simple<EpiMeta, 8>(c2, hn + (size_t)M * D, D, Win, D, D, 1, DIN / 32, EpiMeta{proj}); }
        } else if ((c.wg >> 3) < 16) {
            pg8::Gemm g{hn, D * 2}; pg8::PlainSched Sc; Sc.init(Win, M, DINP, D, 128, (c.wg >> 3) * 8 + (c.wg & 7));
            pg8::gemm_phase<pg8::EpiStoreBf16, pg8::PlainSched, true>(c.lds, g, Sc, pg8::EpiStoreBf16{proj, DINP});
            const Ctx c3 = make_ctx(); if (c3.tid == 0) __hip_atomic_fetch_add(ctl + CW_PDONE, 1u, __ATOMIC_RELAXED, __HIP_MEMORY_SCOPE_AGENT);
        } else {
            const int j = (((c.wg >> 3) - 16) * 8 + (c.wg & 7)) * NWAVES + c.wave;
            if (c.wave == 0) { Ctx c2 = c; c2.gw = j / NWAVES; c2.NGW = 128;
                gemm_simple<EpiMeta, 8>(c2, hn + (size_t)M * D, D, Win, D, D, 1, DIN / 32, EpiMeta{proj}); }
            const int n = conv_stream(c, j, 0, 1, ctl + CW_PDONE, INP(15), INP(17), (unsigned char*)Wgu, (unsigned char*)Wd);
            if (c.lane == 0) ctl[CW_PROG + j] = (unsigned)n;
        }
    }
__device__ __forceinline__ void phase2() { const Ctx c = make_ctx(); PHASE_PTRS;
    const bool half = false; const int g0 = half ? ((c.wg >> 3) * 8 + (c.wg & 7)) * NWAVES + c.wave : c.gw, gs = half ? 128 * NWAVES : c.NGW;
    for (int R = g0; R < MR; R += gs) postproj_row(R, c.lane, proj, INP(4), INP(9), INP(5), INP(7), mixed, qn, kvn, Kpe, cosT, sinT); }
__device__ __forceinline__ void phase3() { const Ctx c = make_ctx(); PHASE_PTRS;
        unsigned* ctl = (unsigned*)(ws + WS_CTL);
        if (c.G != 256 || !SPLIT_P3) {
            { pg8::Gemm g{qn, QL * 2}; pg8::PlainSched Sc; Sc.init(Wq, M, 1536, QL, c.G, c.wg);
              pg8::gemm_phase<pg8::EpiQ, pg8::PlainSched, true>(c.lds, g, Sc, pg8::EpiQ{Q, cosT, sinT}); }
            { pg8::Gemm g{kvn, KVL * 2}; pg8::PlainSched Sc; Sc.init(WkvK, M, 1024, KVL, c.G, c.wg);
              pg8::gemm_phase<pg8::EpiKn, pg8::PlainSched, true>(c.lds, g, Sc, pg8::EpiKn{Kn}); }
            { pg8::Gemm g{WkvV, KVL * 2}; pg8::PlainSched Sc; Sc.init(kvn, 1024, M, KVL, c.G, (c.wg + c.G / 2) % c.G);
              pg8::gemm_phase<pg8::EpiVt, pg8::PlainSched, true>(c.lds, g, Sc, pg8::EpiVt{V}); }
            gemm_simple(c, kvn + (size_t)M * KVL, KVL, Wkv, KVL, KVL, 1, 2048 / 32, EpiKV{Kn, V, M});
        } else if ((c.wg >> 3) < 16) {
            const int cw = (c.wg >> 3) * 8 + (c.wg & 7);
            { pg8::Gemm g{qn, QL * 2}; pg8::PlainSched Sc; Sc.init(Wq, M, 1536, QL, 128, cw);
              pg8::gemm_phase<pg8::EpiQ, pg8::PlainSched, true>(c.lds, g, Sc, pg8::EpiQ{Q, cosT, sinT}); }
            if (cw >= 64) { pg8::Gemm g{kvn, KVL * 2}; pg8::PlainSched Sc; Sc.init(WkvK, M, 1024, KVL, 64, cw - 64);
              pg8::gemm_phase<pg8::EpiKn, pg8::PlainSched, true>(c.lds, g, Sc, pg8::EpiKn{Kn}); }
            { pg8::Gemm g{WkvV, KVL * 2}; pg8::PlainSched Sc; Sc.init(kvn, 1024, M, KVL, 128, cw < 64 ? cw + 64 : cw - 64);
              pg8::gemm_phase<pg8::EpiVt, pg8::PlainSched, true>(c.lds, g, Sc, pg8::EpiVt{V}); }
            { Ctx c2 = make_ctx(); c2.gw = cw * NWAVES + c2.wave; c2.NGW = 128 * NWAVES;
              gemm_simple(c2, kvn + (size_t)M * KVL, KVL, Wkv, KVL, KVL, 1, 2048 / 32, EpiKV{Kn, V, M});
              if (c2.tid == 0) __hip_atomic_fetch_add(ctl + CW_QDONE, 1u, __ATOMIC_RELAXED, __HIP_MEMORY_SCOPE_AGENT); }
        } else {
            const int j = (((c.wg >> 3) - 16) * 8 + (c.wg & 7)) * NWAVES + c.wave;
            *(volatile LAS unsigned*)(c.lds + STOPW_OFF) = 0u;
            const int n = conv_stream(c, j, (int)ctl[CW_PROG + j], 1, ctl + CW_ADONE, INP(15), INP(17), (unsigned char*)Wgu, (unsigned char*)Wd);
            if (c.lane == 0) ctl[CW_PROG + j] = (unsigned)n;
        }
    }
__device__ __forceinline__ void phase5() { const Ctx c = make_ctx(); PHASE_PTRS;
        unsigned* ctl = (unsigned*)(ws + WS_CTL);
        if (c.G != 256) {
            for (int u = c.wg; u < NB * NH * 16; u += c.G) { const int bh = u >> 4, qb = u & 15; att::attn_unit(c.lds, bh >> 3, bh & 7, qb, 0, 4 * qb + 5, Q, Kn, Kpe, V, INP(10), mixed); }
        } else if ((c.wg >> 3) < 16) {
            const int x = c.wg & 7, i = c.wg >> 3;
#pragma unroll 1
            for (int k = 0; k < 2; ++k) { const int bh = 2 * x + k, qb = k == 0 ? i : 15 - i;
                att::attn_unit(c.lds, bh >> 3, bh & 7, qb, 0, 4 * qb + 5, Q, Kn, Kpe, V, INP(10), mixed); }
            const Ctx c3 = make_ctx(); if (c3.tid == 0) __hip_atomic_fetch_add(ctl + CW_ADONE, 1u, __ATOMIC_RELAXED, __HIP_MEMORY_SCOPE_AGENT);
        }
    }
__device__ __forceinline__ void phase6() { const Ctx c = make_ctx(); PHASE_PTRS;
        pg8::Gemm g{mixed, D * 2}; pg8::PlainSched Sc; Sc.init(Wout, M, D, D, c.G, c.wg);
        pg8::gemm_phase<pg8::EpiResF32, pg8::PlainSched, true>(c.lds, g, Sc, pg8::EpiResF32{INP(0), h1, D});
    }
__device__ __forceinline__ void phase7() { const Ctx c = make_ctx(); PHASE_PTRS;
    const bool drain_first = ((c.wg >> 3) & 1) != 0;
    const unsigned* const ctl7 = (const unsigned*)(ws + WS_CTL);
    if (drain_first) drain_balanced(c, ctl7, INP(15), INP(17), (unsigned char*)Wgu, (unsigned char*)Wd);
    for (int blk = c.wg; blk < M / 32; blk += c.G) router_block(c, blk, h1, INP(12), Wrt, INP(14), xn, cnt, rowtok, tok_e, tok_p, gate);
    if (!drain_first) drain_balanced(c, ctl7, INP(15), INP(17), (unsigned char*)Wgu, (unsigned char*)Wd);
}
__device__ __forceinline__ int moe_deal_index(int G, int wg) { if (G != 256) return wg; const int x = wg & 7, k = wg >> 3; return (4 * (x & 3) + (k & 3)) * 16 + 2 * (k >> 2) + (x >> 2); }
__device__ __forceinline__ void phase8() { const Ctx c = make_ctx(); PHASE_PTRS;
        const LAS int* tab = build_expert_table(c, cnt);
        if (c.wg == 0 && c.tid < NE) ((unsigned*)(ws + WS_CTL))[CW_OFFT + c.tid] = (unsigned)tab[c.tid] * 256u;
        pg8::Gemm g{xn, D}; pg8::MoeSched<true> Sc{Wgu, (size_t)4096 * D, cnt, rowtok, tab, D, 16, c.G, moe_deal_index(c.G, c.wg), INP(16), (unsigned*)(ws + WS_CTL) + CW_TILE};
        pg8::gemm_phase<pg8::EpiMoe1, pg8::MoeSched<true>, true, true>(c.lds, g, Sc, pg8::EpiMoe1{(unsigned char*)act, INP(16)});
    }
__device__ __forceinline__ void phase9() { const Ctx c = make_ctx(); PHASE_PTRS;
        const LAS int* tab = (const LAS int*)(c.lds + TAB_OFF);
        const int c0 = (moe_deal_index(c.G, c.wg) + c.G - (tab[NE] * 16) % c.G) % c.G;
        pg8::Gemm g{act, DFF}; pg8::MoeSched<false> Sc{Wd, (size_t)D * DFF, cnt, rowtok, tab, DFF, 8, c.G, c0, INP(18), (unsigned*)(ws + WS_CTL) + CW_TILE};
        pg8::gemm_phase<pg8::EpiMoe2, pg8::MoeSched<false>, true, true>(c.lds, g, Sc, pg8::EpiMoe2{y, INP(18)});
    }
__device__ __forceinline__ void phase10() { const Ctx c = make_ctx(); PHASE_PTRS; for (int m = c.gw; m < M; m += c.NGW) combine_row(m, c.lane, h1, y, (const unsigned*)(ws + WS_CTL) + CW_OFFT, tok_e, tok_p, gate, INP(19), ka->out); }
#undef KA
#undef WSP
#undef PHASE_PTRS
#undef INP

constexpr int NPHASE = 10;
constexpr int REP_PHASE = -1, REP_N = 1;
constexpr int STAMP_PHASE = -1, STAMP_AMP = 4;
__global__ void __launch_bounds__(NWAVES * 64, 2) mk_fwd(Args a) {
    extern __shared__ __attribute__((aligned(16))) unsigned char lds_raw[];
    volatile LAS unsigned* MISC = (volatile LAS unsigned*)((LAS unsigned char*)lds_raw + MISC_OFF);
    if (threadIdx.x < 32) MISC[threadIdx.x] = 0u;
    if (threadIdx.x == 32) *(volatile LAS unsigned*)((LAS unsigned char*)lds_raw + STOPW_OFF) = 0u;
    __syncthreads();
    XcdBarrier bar = xcd_barrier_post((unsigned*)(a.ws + WS_CTL) + CW_BAR, MISC + 8, gridDim.x);
    const bool hosted = gridDim.x == 256, conv = hosted && (blockIdx.x >> 3) >= 16;
    XcdBarrier sub = xcd_barrier_post((unsigned*)(a.ws + WS_CTL) + CW_BAR2, MISC + 12, 128u, hosted && !conv);
    const int lo = a.ph_lo, hi = a.ph_hi;
#define IN(k) (lo <= (k) && (k) < hi)
#define SEAM(k) do { if (IN(k) && IN((k) + 1)) xcd_barrier(bar); } while (0)
#define RUN(k) do { if constexpr (STAMP_PHASE == k) { if (threadIdx.x == 0) *(volatile LAS unsigned long long*)(MISC + 16) = __builtin_amdgcn_s_memrealtime(); } if (IN(k)) { phase##k(); if constexpr (REP_PHASE == k) { for (int r_ = 1; r_ < REP_N; ++r_) phase##k(); } } } while (0)
#define STAMP_END(k) do { if constexpr (STAMP_PHASE == k) { if (threadIdx.x == 0) *(volatile LAS unsigned long long*)(MISC + 18) = __builtin_amdgcn_s_memrealtime(); } } while (0)
    RUN(0);
    SEAM(0); STAMP_END(0);
    RUN(1);
    SEAM(1); STAMP_END(1);
    RUN(2);
    SEAM(2); STAMP_END(2);
    RUN(3);
    if (!conv) {
        if (hosted) xcd_barrier(sub); else SEAM(3);
        STAMP_END(3);
        RUN(5);
    }
    SEAM(5); STAMP_END(5);
    RUN(6);
    SEAM(6); STAMP_END(6);
    RUN(7);
    SEAM(7); STAMP_END(7);
    RUN(8);
    STAMP_END(8);
    RUN(9);
    SEAM(9); STAMP_END(9);
    RUN(10); STAMP_END(10);
    if constexpr (STAMP_PHASE >= 0) { if (blockIdx.x == 0 && threadIdx.x == 0) { const unsigned long long t0 = __builtin_amdgcn_s_memrealtime(), want = (*(volatile LAS unsigned long long*)(MISC + 18) - *(volatile LAS unsigned long long*)(MISC + 16)) * STAMP_AMP;
        while (__builtin_amdgcn_s_memrealtime() - t0 < want) __builtin_amdgcn_s_sleep(8); } }
#undef IN
#undef SEAM
#undef RUN
#undef STAMP_END
}

extern "C" void kernel_launch(void* const* d_in, const int* in_sizes, int n_in, void* d_out, int out_size, void* d_ws, size_t ws_size, hipStream_t stream) {
    static int grid = 0;
    if (grid == 0) {
        if (n_in != 20 || ws_size < WS_END) { fprintf(stderr, "kernel_launch: unexpected n_in %d / ws %zu (need %zu)\n", n_in, ws_size, (size_t)WS_END); grid = -1; return; }
        int dev = 0, cus = 0, per_cu = 0;
        if (hipGetDevice(&dev) != hipSuccess || hipDeviceGetAttribute(&cus, hipDeviceAttributeMultiprocessorCount, dev) != hipSuccess) { grid = -1; return; }
        if (hipFuncSetAttribute((const void*)mk_fwd, hipFuncAttributeMaxDynamicSharedMemorySize, LDS_BYTES) != hipSuccess) { fprintf(stderr, "kernel_launch: hipFuncSetAttribute failed\n"); grid = -1; return; }
        if (hipOccupancyMaxActiveBlocksPerMultiprocessor(&per_cu, (const void*)mk_fwd, NWAVES * 64, LDS_BYTES) != hipSuccess || per_cu < 1) { fprintf(stderr, "kernel_launch: occupancy query says %d\n", per_cu); (void)hipGetLastError(); grid = -1; return; }
        grid = cus;
    }
    if (grid < 0) return;
    if (hipMemsetAsync((char*)d_ws + WS_CTL, 0, CTL_BYTES, stream) != hipSuccess) return;
    Args a{};
    for (int i = 0; i < 20; ++i) a.in[i] = (const float*)d_in[i];
    a.out = (float*)d_out; a.ws = (unsigned char*)d_ws; a.ph_lo = 0; a.ph_hi = NPHASE + 1;
    hipLaunchKernelGGL(mk_fwd, dim3(grid), dim3(NWAVES * 64), LDS_BYTES, stream, a);
}
```
